# Optimizing an MI355X kernel written in HIP

```python
import math
import jax, jax.numpy as jnp
from jax import lax
import numpy as np

D_MODEL = 1024
BATCH = 4
SEQ = 8192
DEPTH = 1
DEC_BATCH = 8
DEC_SEQ = 2048
PAST_LEN = 128

MIX_WIDTH = D_MODEL
ATTN_WIDTH = MIX_WIDTH // 2
RET_WIDTH = MIX_WIDTH - ATTN_WIDTH
ATTN_HEAD_DIM = 64
N_ATTN_HEADS = ATTN_WIDTH // ATTN_HEAD_DIM
N_KV_HEADS = 2
GQA_GROUP = N_ATTN_HEADS // N_KV_HEADS
WINDOW = 128
ATTN_BLOCK = 128
ROT_DIM = ATTN_HEAD_DIM // 4
ROPE_THETA = 500000.0
RET_HEAD_DIM = 128
N_RET_HEADS = RET_WIDTH // RET_HEAD_DIM
RET_CHUNK = 128
RET_ROT_THETA = 10000.0
D_FF = 2816
EPS = 1e-6
NEG_BIG = -1e30
D_IN = (N_ATTN_HEADS * ATTN_HEAD_DIM + 2 * N_KV_HEADS * ATTN_HEAD_DIM
        + 4 * RET_WIDTH)

kernel_name = "hymba_swa_retention_macaron_encoder"


def _rmsnorm(x, g):
    xf = x.astype(jnp.float32)
    y = xf * lax.rsqrt(jnp.mean(xf * xf, axis=-1, keepdims=True) + EPS)
    return (y * g.astype(jnp.float32)).astype(x.dtype)


def _swiglu(x, w_gate, w_up, w_down):
    return (jax.nn.silu(x @ w_gate) * (x @ w_up)) @ w_down


def _rotate(x, cos, sin):
    half = x.shape[-1] // 2
    x1, x2 = x[..., :half], x[..., half:]
    return jnp.concatenate([x1 * cos - x2 * sin, x2 * cos + x1 * sin], axis=-1)


def _banded_sink_attention(q, k, v, sink):
    B, S = q.shape[0], q.shape[1]
    C = ATTN_BLOCK
    NB = S // C
    d = ATTN_HEAD_DIM
    qb = q.reshape(B, NB, C, N_KV_HEADS, GQA_GROUP, d) * (d ** -0.5)
    pad = ((0, 0), (C, C), (0, 0), (0, 0))
    kp = jnp.pad(k, pad).reshape(B, NB + 2, C, N_KV_HEADS, d)
    vp = jnp.pad(v, pad).reshape(B, NB + 2, C, N_KV_HEADS, d)
    kw = jnp.concatenate([kp[:, :-2], kp[:, 1:-1], kp[:, 2:]], axis=2)
    vw = jnp.concatenate([vp[:, :-2], vp[:, 1:-1], vp[:, 2:]], axis=2)
    scores = jnp.einsum('bnqhgd,bnkhd->bnhgqk', qb, kw,
                        preferred_element_type=jnp.float32)
    qpos = jnp.arange(NB)[:, None] * C + jnp.arange(C)[None, :]
    kpos = jnp.arange(NB)[:, None] * C - C + jnp.arange(3 * C)[None, :]
    rel = kpos[:, None, :] - qpos[:, :, None]
    valid = (jnp.abs(rel) <= WINDOW) & (kpos >= 0)[:, None, :] & (kpos < S)[:, None, :]
    scores = jnp.where(valid[None, :, None, None], scores, NEG_BIG)
    sink_l = sink.astype(jnp.float32).reshape(N_KV_HEADS, GQA_GROUP)[None, None, :, :, None, None]
    m = jnp.maximum(jnp.max(scores, axis=-1, keepdims=True), sink_l)
    p = jnp.exp(scores - m)
    p = p / (jnp.sum(p, axis=-1, keepdims=True) + jnp.exp(sink_l - m))
    out = jnp.einsum('bnhgqk,bnkhd->bnqhgd', p.astype(v.dtype), vw)
    return out.reshape(B, S, N_ATTN_HEADS * d)


def _retention_one_direction(q, k, v, log_decay):
    B, H, S, dk = q.shape
    dv = v.shape[-1]
    C = RET_CHUNK
    NC = S // C
    ld = log_decay.astype(jnp.float32)
    qc = q.astype(jnp.float32).reshape(B, H, NC, C, dk)
    kc = k.astype(jnp.float32).reshape(B, H, NC, C, dk)
    vc = v.astype(jnp.float32).reshape(B, H, NC, C, dv)
    idx = jnp.arange(C, dtype=jnp.float32)
    diff = idx[:, None] - idx[None, :]
    D = jnp.where(diff >= 0, jnp.exp(ld[:, None, None] * jnp.maximum(diff, 0.0)), 0.0)
    inner = jnp.einsum('bhnid,bhnjd->bhnij', qc, kc) * D[None, :, None]
    o_inner = jnp.einsum('bhnij,bhnje->bhnie', inner, vc)
    k_to_end = kc * jnp.exp(ld[:, None] * (C - 1.0 - idx))[None, :, None, :, None]
    kv_chunk = jnp.einsum('bhnjd,bhnje->nbhde', k_to_end, vc)
    chunk_decay = jnp.exp(ld * C)[None, :, None, None]

    def step(state, kv_n):
        return state * chunk_decay + kv_n, state

    _, states_prev = lax.scan(step, jnp.zeros((B, H, dk, dv), jnp.float32), kv_chunk)
    q_from_start = qc * jnp.exp(ld[:, None] * (idx + 1.0))[None, :, None, :, None]
    o_cross = jnp.einsum('bhnid,nbhde->bhnie', q_from_start, states_prev)
    return (o_inner + o_cross).reshape(B, H, S, dv)


def _layer(x, ffn1_norm, ffn1_w_gate, ffn1_w_up, ffn1_w_down, mix_norm, w_in,
           attn_sink, attn_out_norm, ret_log_decay_fwd, ret_log_decay_bwd, w_out,
           ffn2_norm, ffn2_w_gate, ffn2_w_up, ffn2_w_down):
    B, S, _ = x.shape
    h = x + 0.5 * _swiglu(_rmsnorm(x, ffn1_norm), ffn1_w_gate, ffn1_w_up, ffn1_w_down)

    u = _rmsnorm(h, mix_norm)
    proj = u @ w_in
    o1 = N_ATTN_HEADS * ATTN_HEAD_DIM
    o2 = o1 + N_KV_HEADS * ATTN_HEAD_DIM
    o3 = o2 + N_KV_HEADS * ATTN_HEAD_DIM
    o4 = o3 + RET_WIDTH
    o5 = o4 + RET_WIDTH
    o6 = o5 + RET_WIDTH
    aq, ak, av, rq, rk, rv, rg = jnp.split(proj, [o1, o2, o3, o4, o5, o6], axis=-1)

    pos = jnp.arange(S, dtype=jnp.float32)

    inv_a = ROPE_THETA ** (-jnp.arange(0, ROT_DIM, 2, dtype=jnp.float32) / ROT_DIM)
    ang_a = pos[:, None] * inv_a[None, :]
    cos_a = jnp.cos(ang_a)[None, :, None, :].astype(x.dtype)
    sin_a = jnp.sin(ang_a)[None, :, None, :].astype(x.dtype)
    aq = aq.reshape(B, S, N_ATTN_HEADS, ATTN_HEAD_DIM)
    ak = ak.reshape(B, S, N_KV_HEADS, ATTN_HEAD_DIM)
    av = av.reshape(B, S, N_KV_HEADS, ATTN_HEAD_DIM)
    aq = jnp.concatenate([_rotate(aq[..., :ROT_DIM], cos_a, sin_a), aq[..., ROT_DIM:]], axis=-1)
    ak = jnp.concatenate([_rotate(ak[..., :ROT_DIM], cos_a, sin_a), ak[..., ROT_DIM:]], axis=-1)
    attn_out = _rmsnorm(_banded_sink_attention(aq, ak, av, attn_sink), attn_out_norm)

    inv_r = RET_ROT_THETA ** (-jnp.linspace(0.0, 1.0, RET_HEAD_DIM // 2, dtype=jnp.float32))
    ang_r = pos[:, None] * inv_r[None, :]
    cos_r = jnp.cos(ang_r)[None, None].astype(x.dtype)
    sin_r = jnp.sin(ang_r)[None, None].astype(x.dtype)
    rq = rq.reshape(B, S, N_RET_HEADS, RET_HEAD_DIM).transpose(0, 2, 1, 3)
    rk = rk.reshape(B, S, N_RET_HEADS, RET_HEAD_DIM).transpose(0, 2, 1, 3)
    rv = rv.reshape(B, S, N_RET_HEADS, RET_HEAD_DIM).transpose(0, 2, 1, 3)
    rq = _rotate(rq, cos_r, sin_r)
    rk = _rotate(rk, cos_r, sin_r) * (RET_HEAD_DIM ** -0.5)
    ret_f = _retention_one_direction(rq, rk, rv, ret_log_decay_fwd)
    ret_b = jnp.flip(_retention_one_direction(jnp.flip(rq, 2), jnp.flip(rk, 2), jnp.flip(rv, 2),
                                              ret_log_decay_bwd), 2)
    ret = ret_f + ret_b
    mu = jnp.mean(ret, axis=-1, keepdims=True)
    var = jnp.mean(jnp.square(ret - mu), axis=-1, keepdims=True)
    ret = ((ret - mu) * lax.rsqrt(var + EPS)).astype(x.dtype)
    ret = ret.transpose(0, 2, 1, 3).reshape(B, S, RET_WIDTH)
    ret_out = jax.nn.silu(rg) * ret

    h = h + jnp.concatenate([attn_out, ret_out], axis=-1) @ w_out

    h = h + 0.5 * _swiglu(_rmsnorm(h, ffn2_norm), ffn2_w_gate, ffn2_w_up, ffn2_w_down)
    return h


def _trunk(x, ffn1_norm, ffn1_w_gate, ffn1_w_up, ffn1_w_down, mix_norm, w_in,
           attn_sink, attn_out_norm, ret_log_decay_fwd, ret_log_decay_bwd, w_out,
           ffn2_norm, ffn2_w_gate, ffn2_w_up, ffn2_w_down, final_norm):
    h = x
    for l in range(DEPTH):
        h = _layer(h, ffn1_norm[l], ffn1_w_gate[l], ffn1_w_up[l], ffn1_w_down[l],
                   mix_norm[l], w_in[l], attn_sink[l], attn_out_norm[l],
                   ret_log_decay_fwd[l], ret_log_decay_bwd[l], w_out[l],
                   ffn2_norm[l], ffn2_w_gate[l], ffn2_w_up[l], ffn2_w_down[l])
    return _rmsnorm(h, final_norm)


def setup_inputs(seed: int = 0) -> dict:
    key = jax.random.key(seed)
    ks = jax.random.split(key, 20)
    f32 = jnp.float32

    def w(k, shape, fan_in):
        return jax.random.normal(k, shape, f32) * (fan_in ** -0.5)

    def gain(k, shape):
        return 1.0 + 0.05 * jax.random.normal(k, shape, f32)

    base_decay = jnp.log1p(-jnp.exp2(-5.0 - jnp.arange(N_RET_HEADS, dtype=f32)))
    return {
        "x_prompt": jax.random.normal(ks[0], (BATCH, SEQ, D_MODEL), f32),
        "x_sample": jax.random.normal(ks[1], (DEC_BATCH, DEC_SEQ, D_MODEL), f32),
        "ffn1_norm": gain(ks[2], (DEPTH, D_MODEL)),
        "ffn1_w_gate": w(ks[3], (DEPTH, D_MODEL, D_FF), D_MODEL),
        "ffn1_w_up": w(ks[4], (DEPTH, D_MODEL, D_FF), D_MODEL),
        "ffn1_w_down": w(ks[5], (DEPTH, D_FF, D_MODEL), D_FF),
        "mix_norm": gain(ks[6], (DEPTH, D_MODEL)),
        "w_in": w(ks[7], (DEPTH, D_MODEL, D_IN), D_MODEL),
        "attn_sink": 0.5 * jax.random.normal(ks[8], (DEPTH, N_ATTN_HEADS), f32),
        "attn_out_norm": gain(ks[9], (DEPTH, ATTN_WIDTH)),
        "ret_log_decay_fwd": base_decay[None, :] * (1.0 + 0.05 * jax.random.normal(ks[10], (DEPTH, N_RET_HEADS), f32)),
        "ret_log_decay_bwd": base_decay[None, :] * (1.0 + 0.05 * jax.random.normal(ks[11], (DEPTH, N_RET_HEADS), f32)),
        "w_out": w(ks[12], (DEPTH, MIX_WIDTH, D_MODEL), MIX_WIDTH),
        "ffn2_norm": gain(ks[13], (DEPTH, D_MODEL)),
        "ffn2_w_gate": w(ks[14], (DEPTH, D_MODEL, D_FF), D_MODEL),
        "ffn2_w_up": w(ks[15], (DEPTH, D_MODEL, D_FF), D_MODEL),
        "ffn2_w_down": w(ks[16], (DEPTH, D_FF, D_MODEL), D_FF),
        "final_norm": gain(ks[17], (D_MODEL,)),
    }


def reference(x_prompt, x_sample, ffn1_norm, ffn1_w_gate, ffn1_w_up, ffn1_w_down,
              mix_norm, w_in, attn_sink, attn_out_norm, ret_log_decay_fwd,
              ret_log_decay_bwd, w_out, ffn2_norm, ffn2_w_gate, ffn2_w_up,
              ffn2_w_down, final_norm):
    y_prompt = _trunk(x_prompt, ffn1_norm, ffn1_w_gate, ffn1_w_up, ffn1_w_down, mix_norm,
                      w_in, attn_sink, attn_out_norm, ret_log_decay_fwd, ret_log_decay_bwd,
                      w_out, ffn2_norm, ffn2_w_gate, ffn2_w_up, ffn2_w_down, final_norm)
    y_sample = _trunk(x_sample, ffn1_norm, ffn1_w_gate, ffn1_w_up, ffn1_w_down, mix_norm,
                      w_in, attn_sink, attn_out_norm, ret_log_decay_fwd, ret_log_decay_bwd,
                      w_out, ffn2_norm, ffn2_w_gate, ffn2_w_up, ffn2_w_down, final_norm)
    return (y_prompt, y_sample)
```

```cpp
#include <hip/hip_runtime.h>
#include <hip/hip_cooperative_groups.h>
#include <cstdio>
#include <cstdint>
namespace cg = cooperative_groups;
#ifndef MK_ONE_LAUNCH
#define MK_ONE_LAUNCH 0
#endif
namespace pg8 {
#define PG8_LAS __attribute__((address_space(3)))
typedef unsigned short bf16_t;
typedef short bf16x8 __attribute__((ext_vector_type(8)));
typedef float f32x4 __attribute__((ext_vector_type(4)));
typedef unsigned u32x4 __attribute__((ext_vector_type(4)));
constexpr int BM = 256, BK = 64, HALF = 128, HTB = HALF * BK * 2  , STAGE_BYTES = 8 * HTB, NXCD = 8, WGM = 8;

__host__ __device__ __forceinline__ int lds_byte(int r, int c) { const int st = (r >> 4) * 2 + (c >> 5), rr = r & 15, cc = c & 31, ob = rr * 64 + cc * 2; return st * 1024 + (ob ^ (((ob >> 9) & 1) << 5)); }
__host__ __device__ __forceinline__ void stage_rc(int b, int& R, int& C) { const int st = b / 1024, sb = b % 1024, swz = sb ^ (((sb >> 9) & 1) << 5); R = (st >> 1) * 16 + swz / 64; C = (st & 1) * 32 + (swz % 64) / 2; }
__host__ __device__ __forceinline__ int perm32(int rho) { const int n = rho >> 4, i = rho & 15; return 8 * (i >> 2) + 4 * n + (i & 3); }

struct Unit { int pm, pn; };
struct Gemm { const bf16_t* A; const bf16_t* Bt; int M, N, K; };

struct StaticOrder {
    int nM, nN, nwg, G, c;
    __host__ __device__ void init(int M, int N, int G_, int c_) { nM = M / BM; nN = N / BM; nwg = nM * nN; G = G_; c = c_; }
    __host__ __device__ bool next(int i, Unit& u) const {
        const long L = (long)i * G + c; if (L >= nwg) return false;
        int wgid = (int)L; { const int q = nwg / NXCD, r = nwg % NXCD, xcd = wgid % NXCD, off = wgid / NXCD; wgid = (xcd < r ? xcd * (q + 1) : r * (q + 1) + (xcd - r) * q) + off; }
        const int nig = WGM * nN, gid = wgid / nig, fm = gid * WGM, gsz = (nM - fm) < WGM ? (nM - fm) : WGM;
        u.pm = fm + ((wgid % nig) % gsz); u.pn = (wgid % nig) / gsz; return true;
    }
    __device__ __forceinline__ void a_ready(const Unit&) const {}
    __device__ __forceinline__ void done(const Unit&) const {}
};

__device__ __forceinline__ unsigned cvt_pk_bf16(float lo, float hi) { unsigned r; asm volatile("v_cvt_pk_bf16_f32 %0, %1, %2" : "=v"(r) : "v"(lo), "v"(hi)); return r; }
typedef float f32x2 __attribute__((ext_vector_type(2)));
template <class Epi, class Sched, bool ALIGN_EPI = false, bool SP2 = false>
__device__ __forceinline__ void gemm_phase(PG8_LAS unsigned char* lds, const Gemm g, const Sched& S, const Epi& E) {
    const int tid = threadIdx.x, wid = __builtin_amdgcn_readfirstlane(tid >> 6), lane = tid & 63, wr = wid >> 2, wc = wid & 3, fr = lane & 15, fq = lane >> 4;
    const int K = g.K, nt = K / BK;
    unsigned voffA[2], voffB[2];
#pragma unroll
    for (int i = 0; i < 2; ++i) { int R, C; stage_rc(tid * 16 + i * 8192, R, C); const int Rb = Epi::PERM ? ((R & ~31) + perm32(R & 31)) : R;
        voffA[i] = (unsigned)(R * K + C) * 2u; voffB[i] = (unsigned)(Rb * K + C) * 2u; }
    const size_t kstep = (size_t)(BK * 2);
    const size_t hstep = (size_t)HALF * K * 2;
    const size_t tstep = 2 * hstep;
    const unsigned ldsw = (unsigned)wid * 1024u;
    const int aoff = lds_byte(wr * 64 + fr, fq * 8), boff = lds_byte(wc * 32 + fr, fq * 8);
#define PG8_SA(b, h) (((b) * 2 + (h)) * HTB)
#define PG8_SB(b, h) ((4 + (b) * 2 + (h)) * HTB)
#define PG8_STAGE(bufoff, gbase, voff) do { _Pragma("unroll") for (int _i = 0; _i < 2; ++_i) \
        __builtin_amdgcn_global_load_lds((const unsigned*)((const char*)(gbase) + (voff)[_i]), (PG8_LAS unsigned*)(lds + (bufoff) + ldsw + _i * 8192), 16, 0, 0); } while (0)
#define PG8_LDA(dst, b, h) do { _Pragma("unroll") for (int m = 0; m < 4; ++m) _Pragma("unroll") for (int k = 0; k < 2; ++k) dst[m][k] = *(const PG8_LAS bf16x8*)(lds + PG8_SA(b, h) + aoff + m * 2048 + k * 1024); } while (0)
#define PG8_LDB(dst, b, h) do { _Pragma("unroll") for (int n = 0; n < 2; ++n) _Pragma("unroll") for (int k = 0; k < 2; ++k) dst[n][k] = *(const PG8_LAS bf16x8*)(lds + PG8_SB(b, h) + boff + n * 2048 + k * 1024); } while (0)
#define PG8_MMA(ai, bj, At, Bt) do { __builtin_amdgcn_s_setprio(1); _Pragma("unroll") for (int m = 0; m < 4; ++m) _Pragma("unroll") for (int n = 0; n < 2; ++n) _Pragma("unroll") for (int k = 0; k < 2; ++k) \
        acc[ai][bj][m][n] = __builtin_amdgcn_mfma_f32_16x16x32_bf16(Bt[n][k], At[m][k], acc[ai][bj][m][n], 0, 0, 0); __builtin_amdgcn_s_setprio(0); } while (0)
#define PG8_WAIT_V(n) asm volatile("s_waitcnt vmcnt(" #n ")" ::: "memory")
#define PG8_WAIT_L(n) asm volatile("s_waitcnt lgkmcnt(" #n ")" ::: "memory")
#define PG8_BAR __builtin_amdgcn_s_barrier()
#define PG8_SCHED __builtin_amdgcn_sched_barrier(0)
    Unit cur, nxt; int ui = 0;
    if (!S.next(0, cur)) return;
    f32x4 acc[2][2][4][2];
#pragma unroll
    for (int a = 0; a < 2; ++a)
#pragma unroll
        for (int b = 0; b < 2; ++b)
#pragma unroll
            for (int m = 0; m < 4; ++m)
#pragma unroll
                for (int n = 0; n < 2; ++n) acc[a][b][m][n] = (f32x4){0.f, 0.f, 0.f, 0.f};
    bf16x8 At[4][2], B0[2][2], B1[2][2];
    const char* cA = (const char*)g.A + (size_t)cur.pm * tstep; const char* cB = (const char*)g.Bt + (size_t)cur.pn * tstep;
    S.a_ready(cur);
    if constexpr (SP2) {
        PG8_STAGE(PG8_SB(0, 0), cB, voffB); PG8_STAGE(PG8_SB(0, 1), cB + hstep, voffB); PG8_STAGE(PG8_SA(0, 0), cA, voffA); PG8_STAGE(PG8_SA(0, 1), cA + hstep, voffA);
        if (wr == 1) PG8_BAR;
        PG8_WAIT_V(2); PG8_BAR;
        PG8_STAGE(PG8_SB(1, 0), cB + kstep, voffB); PG8_STAGE(PG8_SA(1, 0), cA + kstep, voffA); PG8_STAGE(PG8_SB(1, 1), cB + hstep + kstep, voffB);
        PG8_WAIT_V(6); PG8_BAR;
    } else {
        PG8_STAGE(PG8_SB(0, 0), cB, voffB); PG8_STAGE(PG8_SA(0, 0), cA, voffA); PG8_STAGE(PG8_SB(0, 1), cB + hstep, voffB); PG8_STAGE(PG8_SA(0, 1), cA + hstep, voffA);
        if (wr == 1) PG8_BAR;
        PG8_WAIT_V(4); PG8_BAR;
        PG8_STAGE(PG8_SB(1, 0), cB + kstep, voffB); PG8_STAGE(PG8_SA(1, 0), cA + kstep, voffA); PG8_STAGE(PG8_SB(1, 1), cB + hstep + kstep, voffB);
        PG8_WAIT_V(6); PG8_BAR;
    }
    for (;;) {
        const bool has_next = S.next(ui + 1, nxt);
        const char* nA = has_next ? (const char*)g.A + (size_t)nxt.pm * tstep : cA; const char* nB = has_next ? (const char*)g.Bt + (size_t)nxt.pn * tstep : cB;
        for (int t = 0; t < nt; t += 2) {
            const bool last = (t == nt - 2);
            const char* a1 = cA + (size_t)(t + 1) * kstep;
            const char* a2 = last ? nA : cA + (size_t)(t + 2) * kstep; const char* b2 = last ? nB : cB + (size_t)(t + 2) * kstep;
            const char* a3 = a2 + kstep; const char* b3 = b2 + kstep;
            if (last && has_next) S.a_ready(nxt);
            if constexpr (SP2) {
            PG8_LDB(B0, 0, 0); PG8_LDB(B1, 0, 1); PG8_SCHED; PG8_LDA(At, 0, 0); PG8_STAGE(PG8_SA(1, 1), a1 + hstep, voffA);
            PG8_WAIT_V(8); PG8_WAIT_L(0); PG8_BAR; PG8_MMA(0, 0, At, B0); PG8_MMA(0, 1, At, B1); PG8_BAR; PG8_SCHED;
            PG8_LDA(At, 0, 1); PG8_STAGE(PG8_SB(0, 0), b2, voffB); PG8_STAGE(PG8_SB(0, 1), b2 + hstep, voffB); PG8_STAGE(PG8_SA(0, 0), a2, voffA);
            PG8_WAIT_V(8); PG8_WAIT_L(0); PG8_BAR; PG8_MMA(1, 0, At, B0); PG8_MMA(1, 1, At, B1); PG8_BAR; PG8_SCHED;
            PG8_LDB(B0, 1, 0); PG8_LDB(B1, 1, 1); PG8_SCHED; PG8_LDA(At, 1, 0); PG8_STAGE(PG8_SA(0, 1), a2 + hstep, voffA);
            PG8_WAIT_V(8); PG8_WAIT_L(0); PG8_BAR; PG8_MMA(0, 0, At, B0); PG8_MMA(0, 1, At, B1); PG8_BAR; PG8_SCHED;
            PG8_LDA(At, 1, 1); PG8_STAGE(PG8_SB(1, 0), b3, voffB); PG8_STAGE(PG8_SB(1, 1), b3 + hstep, voffB); PG8_STAGE(PG8_SA(1, 0), a3, voffA);
            PG8_WAIT_V(8); PG8_WAIT_L(0); PG8_BAR; PG8_MMA(1, 0, At, B0); PG8_MMA(1, 1, At, B1); PG8_BAR; PG8_SCHED;
            } else {
            PG8_LDB(B0, 0, 0); PG8_SCHED; PG8_LDA(At, 0, 0); PG8_STAGE(PG8_SA(1, 1), a1 + hstep, voffA);
            PG8_WAIT_L(8); PG8_BAR; PG8_WAIT_L(0); PG8_MMA(0, 0, At, B0); PG8_BAR; PG8_SCHED;
            PG8_LDB(B1, 0, 1); PG8_STAGE(PG8_SB(0, 0), b2, voffB);
            PG8_BAR; PG8_WAIT_L(0); PG8_MMA(0, 1, At, B1); PG8_BAR;
            PG8_LDA(At, 0, 1); PG8_STAGE(PG8_SA(0, 0), a2, voffA);
            PG8_BAR; PG8_WAIT_L(0); PG8_MMA(1, 0, At, B0); PG8_BAR; PG8_SCHED;
            PG8_STAGE(PG8_SB(0, 1), b2 + hstep, voffB);
            PG8_WAIT_V(6); PG8_BAR; PG8_MMA(1, 1, At, B1); PG8_BAR;
            PG8_LDB(B0, 1, 0); PG8_SCHED; PG8_LDA(At, 1, 0); PG8_STAGE(PG8_SA(0, 1), a2 + hstep, voffA);
            PG8_WAIT_L(8); PG8_BAR; PG8_WAIT_L(0); PG8_MMA(0, 0, At, B0); PG8_BAR; PG8_SCHED;
            PG8_LDB(B1, 1, 1); PG8_STAGE(PG8_SB(1, 0), b3, voffB);
            PG8_BAR; PG8_WAIT_L(0); PG8_MMA(0, 1, At, B1); PG8_BAR;
            PG8_LDA(At, 1, 1); PG8_STAGE(PG8_SA(1, 0), a3, voffA);
            PG8_BAR; PG8_WAIT_L(0); PG8_MMA(1, 0, At, B0); PG8_BAR; PG8_SCHED;
            PG8_STAGE(PG8_SB(1, 1), b3 + hstep, voffB);
            PG8_WAIT_V(6); PG8_BAR; PG8_MMA(1, 1, At, B1); PG8_BAR;
            }
        }
        if constexpr (ALIGN_EPI) { if (wr == 0) PG8_BAR; }
        if constexpr (!Epi::AFTER_DRAIN) { E(acc, cur, wr, wc, fr, fq); S.done(cur); }
        if (!has_next) break;
#pragma unroll
        for (int a = 0; a < 2; ++a)
#pragma unroll
            for (int b = 0; b < 2; ++b)
#pragma unroll
                for (int m = 0; m < 4; ++m)
#pragma unroll
                    for (int n = 0; n < 2; ++n) acc[a][b][m][n] = (f32x4){0.f, 0.f, 0.f, 0.f};
        cur = nxt; cA = nA; cB = nB; ++ui;
        if constexpr (ALIGN_EPI) { if (wr == 1) PG8_BAR; }
    }
    PG8_WAIT_V(0);
    if constexpr (!ALIGN_EPI) { if (wr == 0) PG8_BAR; }
    PG8_BAR;
    if constexpr (Epi::AFTER_DRAIN) { E.fused(acc, cur, wr, wc, fr, fq, lds, wid, lane); S.done(cur); }
#undef PG8_SA
#undef PG8_SB
#undef PG8_STAGE
#undef PG8_LDA
#undef PG8_LDB
#undef PG8_MMA
#undef PG8_WAIT_V
#undef PG8_WAIT_L
#undef PG8_BAR
#undef PG8_SCHED
}
}

#ifndef PG8_SP2
#define PG8_SP2 true
#endif
#ifndef PG8_ALIGN
#define PG8_ALIGN true
#endif

#define LAS __attribute__((address_space(3)))
using pg8::bf16_t; using pg8::bf16x8; using pg8::f32x4; using pg8::u32x4;
typedef float f32x2_t __attribute__((ext_vector_type(2)));
typedef __bf16 bf16x2_t __attribute__((ext_vector_type(2)));
__device__ __forceinline__ unsigned cvt_pk_bf16(float lo, float hi) { f32x2_t v = {lo, hi}; bf16x2_t b = __builtin_convertvector(v, bf16x2_t); return __builtin_bit_cast(unsigned, b); }
typedef unsigned u32x2 __attribute__((ext_vector_type(2)));
constexpr int T = 49152, TP = 32768, D = 1024, FF = 2816, DIN = 2816, NTHR = 512;
constexpr float EPS = 1e-6f;
constexpr size_t MiB = 1u << 20;
constexpr size_t WU = (size_t)2816 * 1024 * 2;
constexpr size_t WS_WGU1 = 0, WS_WD1 = 2 * WU, WS_WIN = 3 * WU, WS_WOUT = 4 * WU, WS_WGU2 = WS_WOUT + 2 * MiB, WS_WD2 = WS_WGU2 + 2 * WU;
constexpr size_t WS_TABR = WS_WD2 + WU, WS_TABA = WS_TABR + 8192 * 64 * 8, WS_SSQ = WS_TABA + 8192 * 8 * 8;
constexpr size_t WS_ACTA = 48 * MiB, WS_ACTB = 144 * MiB, WS_HID = 240 * MiB, WS_END = 504 * MiB;
static_assert(WS_SSQ + (size_t)T * 16 * 4 <= WS_ACTA, "ws map");
static_assert(WS_ACTA + (size_t)T * D * 2 <= WS_ACTB && WS_ACTB + (size_t)T * D * 2 <= WS_HID && WS_HID + (size_t)T * FF * 2 <= WS_END, "ws map");
constexpr int LDS_BYTES = 147456;

struct Params { const float* in[18]; float* out; unsigned char* ws; int ph_lo, ph_hi; };

__device__ __forceinline__ float silu_f(float x) { return x * __builtin_amdgcn_rcpf(1.0f + __builtin_amdgcn_exp2f(-1.4426950408889634f * x)); }
__device__ __forceinline__ float fexp(float x) { return __builtin_amdgcn_exp2f(1.4426950408889634f * x); }
__device__ __forceinline__ float bf2f(unsigned short b) { return __builtin_bit_cast(float, ((unsigned)b) << 16); }
__device__ __forceinline__ unsigned f2bf(float f) { unsigned u = __builtin_bit_cast(unsigned, f); return (u + 0x7fffu + ((u >> 16) & 1u)) >> 16; }
__device__ __forceinline__ unsigned pk2(float lo, float hi) { return f2bf(lo) | (f2bf(hi) << 16); }
__device__ __forceinline__ float wave_sum(float v) {
#pragma unroll
    for (int o = 1; o < 64; o <<= 1) v += __shfl_xor(v, o);
    return v;
}
__device__ __forceinline__ int row_pos(int row) { return row < TP ? (row & 8191) : (row & 2047); }
__device__ __forceinline__ float row_rstd(const float* ssq, int row, int fq) {
    const f32x4 p = *(const f32x4*)(ssq + (size_t)row * 16 + 4 * fq);
    float s = (p[0] + p[1]) + (p[2] + p[3]);
    s += __shfl_xor(s, 16); s += __shfl_xor(s, 32);
    return __builtin_amdgcn_rsqf(s * (1.0f / 1024.0f) + EPS);
}

template <bool SCALE> struct EpiSwiGLU {
    static constexpr bool PERM = true, AFTER_DRAIN = false;
    bf16_t* O; const float* ssq;
    __device__ __forceinline__ void operator()(const f32x4 (&acc)[2][2][4][2], const pg8::Unit& u, int wr, int wc, int fr, int fq) const {
        const int row0 = u.pm * 256 + wr * 64 + fr, col0 = u.pn * 128 + wc * 32 + 8 * fq;
#pragma unroll
        for (int ai = 0; ai < 2; ++ai)
#pragma unroll
            for (int m = 0; m < 4; ++m) {
                const int row = row0 + ai * 128 + m * 16;
                float r = 1.f; if (SCALE) r = row_rstd(ssq, row, fq);
                const f32x4 g0 = acc[ai][0][m][0] * r, g1 = acc[ai][0][m][1] * r, u0 = acc[ai][1][m][0] * r, u1 = acc[ai][1][m][1] * r;
                u32x4 w;
                w.x = cvt_pk_bf16(silu_f(g0[0]) * u0[0], silu_f(g0[1]) * u0[1]); w.y = cvt_pk_bf16(silu_f(g0[2]) * u0[2], silu_f(g0[3]) * u0[3]);
                w.z = cvt_pk_bf16(silu_f(g1[0]) * u1[0], silu_f(g1[1]) * u1[1]); w.w = cvt_pk_bf16(silu_f(g1[2]) * u1[2], silu_f(g1[3]) * u1[3]);
                *(u32x4*)(O + (size_t)row * FF + col0) = w;
            }
    }
};
template <bool WB, bool WS> struct EpiResid {
    static constexpr bool PERM = true, AFTER_DRAIN = false;
    const float* res0; const float* res1; float* out; bf16_t* outb; float* ssq; float scale;
    __device__ __forceinline__ void operator()(const f32x4 (&acc)[2][2][4][2], const pg8::Unit& u, int wr, int wc, int fr, int fq) const {
        const int row0 = u.pm * 256 + wr * 64 + fr, col0 = u.pn * 256 + wc * 32 + 8 * fq;
        const float* rb = (u.pm * 256 < TP) ? res0 : res1;
#pragma unroll
        for (int ai = 0; ai < 2; ++ai)
#pragma unroll
            for (int m = 0; m < 4; ++m) {
                const int row = row0 + ai * 128 + m * 16; float ss = 0.f;
#pragma unroll
                for (int bj = 0; bj < 2; ++bj) {
                    const size_t off = (size_t)row * D + col0 + bj * 128;
                    const f32x4 x0 = *(const f32x4*)(rb + off), x1 = *(const f32x4*)(rb + off + 4);
                    const f32x4 v0 = x0 + acc[ai][bj][m][0] * scale, v1 = x1 + acc[ai][bj][m][1] * scale;
                    *(f32x4*)(out + off) = v0; *(f32x4*)(out + off + 4) = v1;
                    if (WB) { u32x4 w; w.x = cvt_pk_bf16(v0[0], v0[1]); w.y = cvt_pk_bf16(v0[2], v0[3]); w.z = cvt_pk_bf16(v1[0], v1[1]); w.w = cvt_pk_bf16(v1[2], v1[3]); *(u32x4*)(outb + off) = w; }
                    if (WS) ss += ((v0[0] * v0[0] + v0[1] * v0[1]) + (v0[2] * v0[2] + v0[3] * v0[3])) + ((v1[0] * v1[0] + v1[1] * v1[1]) + (v1[2] * v1[2] + v1[3] * v1[3]));
                }
                if (WS) { ss += __shfl_xor(ss, 16); ss += __shfl_xor(ss, 32); if (fq == 0) ssq[(size_t)row * 16 + u.pn * 4 + wc] = ss; }
            }
    }
};
struct EpiProj {
    static constexpr bool PERM = true, AFTER_DRAIN = false;
    bf16_t* O; const float* ssq; const float* tabA; const float* tabR;
    __device__ __forceinline__ void operator()(const f32x4 (&acc)[2][2][4][2], const pg8::Unit& u, int wr, int wc, int fr, int fq) const {
        const int row0 = u.pm * 256 + wr * 64 + fr, col0 = u.pn * 256 + wc * 32 + 8 * fq;
#pragma unroll
        for (int ai = 0; ai < 2; ++ai)
#pragma unroll
            for (int m = 0; m < 4; ++m) {
                const int row = row0 + ai * 128 + m * 16; const int pos = row_pos(row);
                const float r = row_rstd(ssq, row, fq);
#pragma unroll
                for (int bj = 0; bj < 2; ++bj) {
                    const int seg = 2 * u.pn + bj;
                    float sc = r; if (seg < 4) sc = r * 0.125f; if (seg >= 10 && seg < 14) sc = r * 0.08838834764831845f;
                    f32x4 v0 = acc[ai][bj][m][0] * sc, v1 = acc[ai][bj][m][1] * sc;
                    const bool rotA = (seg <= 4) && ((wc & 1) == 0) && (fq < 2), rotR = (seg >= 6 && seg < 14);
                    if (rotA || rotR) {
                        const float* tp = rotA ? (tabA + ((size_t)pos * 8 + 4 * fq) * 2) : (tabR + ((size_t)pos * 64 + 16 * wc + 4 * fq) * 2);
                        const f32x4 t0 = *(const f32x4*)tp, t1 = *(const f32x4*)(tp + 4);
                        const float c[4] = {t0[0], t0[2], t1[0], t1[2]}, s[4] = {t0[1], t0[3], t1[1], t1[3]};
#pragma unroll
                        for (int j = 0; j < 4; ++j) { const float x1 = v0[j], x2 = v1[j]; v0[j] = x1 * c[j] - x2 * s[j]; v1[j] = x2 * c[j] + x1 * s[j]; }
                    }
                    u32x4 w; w.x = cvt_pk_bf16(v0[0], v0[1]); w.y = cvt_pk_bf16(v0[2], v0[3]); w.z = cvt_pk_bf16(v1[0], v1[1]); w.w = cvt_pk_bf16(v1[2], v1[3]);
                    *(u32x4*)(O + (size_t)row * DIN + col0 + bj * 128) = w;
                }
            }
    }
};

__device__ __forceinline__ void p0_item(const float* W, int ldw, int sc, const float* gain, int gain_lim, bf16_t* WT, int K, int n0, int k0, LAS float* scr, int lane) {
#pragma unroll 8
    for (int i = 0; i < 32; ++i) { const int kk = 2 * i + (lane >> 5), k = k0 + kk; float v = W[(size_t)k * ldw + sc]; if (gain && k < gain_lim) v *= gain[k]; scr[kk * 33 + (lane & 31)] = v; }
    asm volatile("s_waitcnt lgkmcnt(0)" ::: "memory");
    const int c = lane & 7;
#pragma unroll
    for (int j = 0; j < 4; ++j) { const int n = (lane >> 3) + 8 * j; const LAS float* s = scr + (8 * c) * 33 + n;
        u32x4 o; o.x = pk2(s[0 * 33], s[1 * 33]); o.y = pk2(s[2 * 33], s[3 * 33]); o.z = pk2(s[4 * 33], s[5 * 33]); o.w = pk2(s[6 * 33], s[7 * 33]);
        *(u32x4*)(WT + (size_t)(n0 + n) * K + k0 + 8 * c) = o; }
    asm volatile("s_waitcnt lgkmcnt(0)" ::: "memory");
}
__device__ __forceinline__ int win_srccol(int n) {
    if (n < 640) { const int p = n & 63; if (p < 16) return (n - p) + ((p & 3) | ((p & 4) << 1) | ((p & 8) >> 1)); return n; }
    if (n >= 768 && n < 1792) { const int p = (n - 768) & 127, q = p >> 3, nn = (p >> 2) & 1, j = p & 3; return (n - p) + nn * 64 + 4 * q + j; }
    return n;
}
__device__ __forceinline__ void p0_prologue(const Params& p, LAS unsigned char* lds, int G) {
    const int tid = threadIdx.x, lane = tid & 63, wave = tid >> 6;
    LAS float* scr = (LAS float*)(lds + wave * 16384);
    const int gw = blockIdx.x * 8 + wave, NGW = G * 8;
    constexpr int I_GU = 16 * 176, I_D = 44 * 32, I_IN = 16 * 88, I_OUT = 16 * 32;
    constexpr int NITEMS = 2 * I_GU + 2 * I_D + I_IN + I_OUT;
    for (int it = gw; it < NITEMS; it += NGW) {
        int r = it;
        if (r < 2 * I_GU) {
            const int which = r / I_GU; r -= which * I_GU; const int nb = r % 176, kb = r / 176, n0 = nb * 32;
            const int pn = n0 >> 8, q = n0 & 255, bj = q >> 7, hid = pn * 128 + (q & 127) + (lane & 31);
            const float* W = which == 0 ? (bj ? p.in[4] : p.in[3]) : (bj ? p.in[15] : p.in[14]);
            p0_item(W, FF, hid, which == 0 ? nullptr : p.in[13], 1 << 30, (bf16_t*)(p.ws + (which == 0 ? WS_WGU1 : WS_WGU2)), D, n0, kb * 64, scr, lane); continue; }
        r -= 2 * I_GU;
        if (r < 2 * I_D) {
            const int which = r / I_D; r -= which * I_D; const int nb = r % 32, kb = r / 32, n0 = nb * 32;
            p0_item(which == 0 ? p.in[5] : p.in[16], D, n0 + (lane & 31), nullptr, 0, (bf16_t*)(p.ws + (which == 0 ? WS_WD1 : WS_WD2)), FF, n0, kb * 64, scr, lane); continue; }
        r -= 2 * I_D;
        if (r < I_IN) { const int nb = r % 88, kb = r / 88, n0 = nb * 32;
            p0_item(p.in[7], DIN, win_srccol(n0 + (lane & 31)), p.in[6], 1 << 30, (bf16_t*)(p.ws + WS_WIN), D, n0, kb * 64, scr, lane); continue; }
        r -= I_IN;
        { const int nb = r % 32, kb = r / 32, n0 = nb * 32;
            p0_item(p.in[12], D, n0 + (lane & 31), p.in[9], 512, (bf16_t*)(p.ws + WS_WOUT), D, n0, kb * 64, scr, lane); }
    }
    bf16_t* XN = (bf16_t*)(p.ws + WS_ACTA);
    const f32x4* gp = (const f32x4*)p.in[2] + lane;
    for (int row = gw; row < T; row += NGW) {
        const float* xrow = row < TP ? p.in[0] + (size_t)row * D : p.in[1] + (size_t)(row - TP) * D;
        const f32x4* xr = (const f32x4*)xrow + lane; f32x4 v[4]; float s = 0.f;
#pragma unroll
        for (int j = 0; j < 4; ++j) { v[j] = xr[64 * j]; s += (v[j][0] * v[j][0] + v[j][1] * v[j][1]) + (v[j][2] * v[j][2] + v[j][3] * v[j][3]); }
        const float rstd = __builtin_amdgcn_rsqf(wave_sum(s) * (1.f / D) + EPS);
        u32x2* o8 = (u32x2*)(XN + (size_t)row * D) + lane;
#pragma unroll
        for (int j = 0; j < 4; ++j) { const f32x4 g = gp[64 * j]; u32x2 w; w.x = pk2(v[j][0] * rstd * g[0], v[j][1] * rstd * g[1]); w.y = pk2(v[j][2] * rstd * g[2], v[j][3] * rstd * g[3]); o8[64 * j] = w; }
    }
    float* tabR = (float*)(p.ws + WS_TABR); float* tabA = (float*)(p.ws + WS_TABA);
    for (int idx = blockIdx.x * NTHR + tid; idx < 8192 * 72; idx += G * NTHR) {
        const int pos = idx / 72, f = idx - pos * 72;
        const float inv = f < 64 ? exp2f(-13.287712379549449f * ((float)f * (1.0f / 63.0f))) : exp2f(-18.931568569324174f * ((float)(2 * (f - 64)) * (1.0f / 16.0f)));
        double rev = (double)pos * (double)inv * 0.15915494309189535; rev -= __builtin_rint(rev);
        const float frv = (float)rev, c = __builtin_amdgcn_cosf(frv), s = __builtin_amdgcn_sinf(frv);
        float* o = f < 64 ? tabR + ((size_t)pos * 64 + f) * 2 : tabA + ((size_t)pos * 8 + (f - 64)) * 2;
        o[0] = c; o[1] = s;
    }
}

#define MMA16(b, a, c) __builtin_amdgcn_mfma_f32_16x16x32_bf16((b), (a), (c), 0, 0, 0)
#define LDS16(ptr) (*(const LAS bf16x8*)(ptr))

__device__ __forceinline__ void attn_phase(const Params& p, LAS unsigned char* lds, int G) {
    const int tid = threadIdx.x, lane = tid & 63, wave = tid >> 6, fr = lane & 15, fq = lane >> 4;
    const bf16_t* proj = (const bf16_t*)(p.ws + WS_HID); bf16_t* mix = (bf16_t*)(p.ws + WS_ACTB);
    LAS bf16_t* Kl = (LAS bf16_t*)lds;
    LAS bf16_t* Vt = (LAS bf16_t*)(lds + 18432);
    LAS bf16_t* Pl = (LAS bf16_t*)(lds + 36864 + wave * 9216);
    LAS float* stat = (LAS float*)(lds + 110592);
    const int h = wave, kvh = h >> 2;
    const float sink = p.in[8][h];
    for (int unit = blockIdx.x; unit < T / 64; unit += G) {
        const int row0 = unit * 64;
        int sstart, send; if (row0 < TP) { sstart = row0 & ~8191; send = sstart + 8192; } else { sstart = TP + ((row0 - TP) & ~2047); send = sstart + 2048; }
        bf16x8 qf[4][2];
#pragma unroll
        for (int m = 0; m < 4; ++m)
#pragma unroll
            for (int k = 0; k < 2; ++k) qf[m][k] = *(const bf16x8*)(proj + (size_t)(row0 + 16 * m + fr) * DIN + h * 64 + 32 * k + 8 * fq);
        f32x4 o[4][4]; float mrow[4], lrow[4];
#pragma unroll
        for (int m = 0; m < 4; ++m) { mrow[m] = sink; lrow[m] = 1.f;
#pragma unroll
            for (int n = 0; n < 4; ++n) o[m][n] = (f32x4){0.f, 0.f, 0.f, 0.f}; }
        for (int kb = 0; kb < 5; ++kb) {
            const int kstart = row0 - 128 + 64 * kb;
            if (kstart < sstart || kstart >= send) continue;
            __syncthreads();
#pragma unroll
            for (int i = 0; i < 2; ++i) {
                const int id = tid + NTHR * i, kv = id >> 9, key = (id >> 3) & 63, dch = id & 7;
                const bf16_t* src = proj + (size_t)(kstart + key) * DIN + 512 + kv * 64 + dch * 8;
                const u32x4 kq = *(const u32x4*)src, vq = *(const u32x4*)(src + 128);
                *(LAS u32x4*)(Kl + (kv * 64 + key) * 72 + dch * 8) = kq;
                LAS bf16_t* vd = Vt + (kv * 64 + dch * 8) * 72 + key;
                vd[0 * 72] = (bf16_t)(vq.x & 0xffffu); vd[1 * 72] = (bf16_t)(vq.x >> 16); vd[2 * 72] = (bf16_t)(vq.y & 0xffffu); vd[3 * 72] = (bf16_t)(vq.y >> 16);
                vd[4 * 72] = (bf16_t)(vq.z & 0xffffu); vd[5 * 72] = (bf16_t)(vq.z >> 16); vd[6 * 72] = (bf16_t)(vq.w & 0xffffu); vd[7 * 72] = (bf16_t)(vq.w >> 16);
            }
            __syncthreads();
            f32x4 s[4][4];
#pragma unroll
            for (int n = 0; n < 4; ++n) {
                const bf16x8 b0 = LDS16(Kl + (kvh * 64 + 16 * n + fr) * 72 + 8 * fq), b1 = LDS16(Kl + (kvh * 64 + 16 * n + fr) * 72 + 32 + 8 * fq);
#pragma unroll
                for (int m = 0; m < 4; ++m) { f32x4 a = (f32x4){0.f, 0.f, 0.f, 0.f}; a = MMA16(b0, qf[m][0], a); a = MMA16(b1, qf[m][1], a); s[m][n] = a; }
            }
#pragma unroll
            for (int m = 0; m < 4; ++m) {
                const int i = row0 + 16 * m + fr; float mx = mrow[m];
#pragma unroll
                for (int n = 0; n < 4; ++n)
#pragma unroll
                    for (int e = 0; e < 4; ++e) { const int j = kstart + 16 * n + 4 * fq + e, dlt = i - j; const bool valid = (dlt <= 128) && (dlt >= -128); const float sv = valid ? s[m][n][e] : -1e30f; s[m][n][e] = sv; mx = fmaxf(mx, sv); }
                mx = fmaxf(mx, __shfl_xor(mx, 16)); mx = fmaxf(mx, __shfl_xor(mx, 32));
                const float alpha = fexp(mrow[m] - mx); mrow[m] = mx; float ps = 0.f;
#pragma unroll
                for (int n = 0; n < 4; ++n) {
                    f32x4 pv;
#pragma unroll
                    for (int e = 0; e < 4; ++e) { pv[e] = fexp(s[m][n][e] - mx); ps += pv[e]; }
                    u32x2 w; w.x = cvt_pk_bf16(pv[0], pv[1]); w.y = cvt_pk_bf16(pv[2], pv[3]);
                    *(LAS u32x2*)(Pl + (16 * m + fr) * 72 + 16 * n + 4 * fq) = w;
                    o[m][n] = o[m][n] * alpha;
                }
                ps += __shfl_xor(ps, 16); ps += __shfl_xor(ps, 32);
                lrow[m] = lrow[m] * alpha + ps;
            }
            asm volatile("s_waitcnt lgkmcnt(0)" ::: "memory");
#pragma unroll
            for (int n = 0; n < 4; ++n) {
                const bf16x8 b0 = LDS16(Vt + (kvh * 64 + 16 * n + fr) * 72 + 8 * fq), b1 = LDS16(Vt + (kvh * 64 + 16 * n + fr) * 72 + 32 + 8 * fq);
#pragma unroll
                for (int m = 0; m < 4; ++m) { const bf16x8 a0 = LDS16(Pl + (16 * m + fr) * 72 + 8 * fq), a1 = LDS16(Pl + (16 * m + fr) * 72 + 32 + 8 * fq);
                    o[m][n] = MMA16(b0, a0, o[m][n]); o[m][n] = MMA16(b1, a1, o[m][n]); }
            }
        }
#pragma unroll
        for (int m = 0; m < 4; ++m) { const float inv = 1.0f / lrow[m]; float ss = 0.f;
#pragma unroll
            for (int n = 0; n < 4; ++n) { o[m][n] = o[m][n] * inv; ss += (o[m][n][0] * o[m][n][0] + o[m][n][1] * o[m][n][1]) + (o[m][n][2] * o[m][n][2] + o[m][n][3] * o[m][n][3]); }
            ss += __shfl_xor(ss, 16); ss += __shfl_xor(ss, 32);
            if (fq == 0) stat[h * 64 + 16 * m + fr] = ss; }
        __syncthreads();
#pragma unroll
        for (int m = 0; m < 4; ++m) { float tot = 0.f;
#pragma unroll
            for (int hh = 0; hh < 8; ++hh) tot += stat[hh * 64 + 16 * m + fr];
            const float rn = __builtin_amdgcn_rsqf(tot * (1.0f / 512.0f) + EPS);
#pragma unroll
            for (int n = 0; n < 4; ++n) { const f32x4 v = o[m][n] * rn; u32x2 w; w.x = cvt_pk_bf16(v[0], v[1]); w.y = cvt_pk_bf16(v[2], v[3]);
                *(u32x2*)(mix + (size_t)(row0 + 16 * m + fr) * D + h * 64 + 16 * n + 4 * fq) = w; } }
        __syncthreads();
    }
}

__device__ __forceinline__ void ret_kv_phase(const Params& p, LAS unsigned char* lds, int G) {
    const int tid = threadIdx.x, lane = tid & 63, wave = tid >> 6, fr = lane & 15, fq = lane >> 4;
    const bf16_t* proj = (const bf16_t*)(p.ws + WS_HID); bf16_t* kvbuf = (bf16_t*)(p.ws + WS_ACTA);
    LAS bf16_t* Vt = (LAS bf16_t*)lds; LAS bf16_t* Ktf = (LAS bf16_t*)(lds + 34816); LAS bf16_t* Ktb = (LAS bf16_t*)(lds + 69632);
    for (int unit = blockIdx.x; unit < (T / 128) * 4; unit += G) {
        const int c = unit >> 2, h = unit & 3, row0 = c * 128;
        const float ldf = p.in[10][h], ldb = p.in[11][h];
        __syncthreads();
#pragma unroll
        for (int i = 0; i < 4; ++i) {
            const int id = tid + NTHR * i, tok = id >> 4, dch = id & 15;
            const bf16_t* src = proj + (size_t)(row0 + tok) * DIN + 1280 + h * 128 + dch * 8;
            const u32x4 kq = *(const u32x4*)src, vq = *(const u32x4*)(src + 512);
            const float wf = fexp(ldf * (float)(127 - tok)), wb = fexp(ldb * (float)tok);
            const unsigned kw[4] = {kq.x, kq.y, kq.z, kq.w}, vw[4] = {vq.x, vq.y, vq.z, vq.w};
#pragma unroll
            for (int jj = 0; jj < 8; ++jj) {
                const unsigned short kb16 = (unsigned short)((jj & 1) ? (kw[jj >> 1] >> 16) : (kw[jj >> 1] & 0xffffu)), vb16 = (unsigned short)((jj & 1) ? (vw[jj >> 1] >> 16) : (vw[jj >> 1] & 0xffffu));
                const float kf = bf2f(kb16); const int o = (dch * 8 + jj) * 136 + tok;
                Vt[o] = vb16; Ktf[o] = (bf16_t)f2bf(kf * wf); Ktb[o] = (bf16_t)f2bf(kf * wb);
            }
        }
        __syncthreads();
        const int dir = wave >> 2, mt0 = (wave & 3) * 2; LAS bf16_t* Kt = dir ? Ktb : Ktf;
        f32x4 acc[2][8];
#pragma unroll
        for (int mi = 0; mi < 2; ++mi)
#pragma unroll
            for (int n = 0; n < 8; ++n) acc[mi][n] = (f32x4){0.f, 0.f, 0.f, 0.f};
#pragma unroll
        for (int k = 0; k < 4; ++k) {
            const bf16x8 a0 = LDS16(Vt + ((mt0 + 0) * 16 + fr) * 136 + 32 * k + 8 * fq), a1 = LDS16(Vt + ((mt0 + 1) * 16 + fr) * 136 + 32 * k + 8 * fq);
#pragma unroll
            for (int n = 0; n < 8; ++n) { const bf16x8 b = LDS16(Kt + (16 * n + fr) * 136 + 32 * k + 8 * fq); acc[0][n] = MMA16(b, a0, acc[0][n]); acc[1][n] = MMA16(b, a1, acc[1][n]); }
        }
        bf16_t* dst = kvbuf + ((size_t)(c * 4 + h) * 2 + dir) * 16384;
#pragma unroll
        for (int mi = 0; mi < 2; ++mi)
#pragma unroll
            for (int n = 0; n < 8; ++n) { u32x2 w; w.x = cvt_pk_bf16(acc[mi][n][0], acc[mi][n][1]); w.y = cvt_pk_bf16(acc[mi][n][2], acc[mi][n][3]);
                *(u32x2*)(dst + ((mt0 + mi) * 16 + fr) * 128 + 16 * n + 4 * fq) = w; }
    }
}

__device__ __forceinline__ void ret_scan_phase(const Params& p, int G) {
    bf16_t* kvbuf = (bf16_t*)(p.ws + WS_ACTA);
    const int nthr = G * NTHR;
    for (int t = blockIdx.x * NTHR + threadIdx.x; t < 131072; t += nthr) {
        {
            const int e4 = t & 4095, sdh = t >> 12, dir = sdh & 1, h = (sdh >> 1) & 3, b = sdh >> 3, c0 = 64 * b;
            const float Dk = fexp((dir ? p.in[11][h] : p.in[10][h]) * 128.0f);
            float st[4] = {0.f, 0.f, 0.f, 0.f};
#pragma unroll 8
            for (int step = 0; step < 64; ++step) {
                const int c = dir ? (c0 + 63 - step) : (c0 + step);
                u32x2* ptr = (u32x2*)(kvbuf + ((size_t)(c * 4 + h) * 2 + dir) * 16384 + e4 * 4);
                const u32x2 v = *ptr; u32x2 w; w.x = pk2(st[0], st[1]); w.y = pk2(st[2], st[3]); *ptr = w;
                st[0] = st[0] * Dk + bf2f((unsigned short)(v.x & 0xffffu)); st[1] = st[1] * Dk + bf2f((unsigned short)(v.x >> 16));
                st[2] = st[2] * Dk + bf2f((unsigned short)(v.y & 0xffffu)); st[3] = st[3] * Dk + bf2f((unsigned short)(v.y >> 16));
            }
        }
        {
            const int e8 = t & 2047, sdh = t >> 11, dir = sdh & 1, h = (sdh >> 1) & 3, b = sdh >> 3, c0 = 256 + 16 * b;
            const float Dk = fexp((dir ? p.in[11][h] : p.in[10][h]) * 128.0f);
            float st[8] = {0.f, 0.f, 0.f, 0.f, 0.f, 0.f, 0.f, 0.f};
#pragma unroll 4
            for (int step = 0; step < 16; ++step) {
                const int c = dir ? (c0 + 15 - step) : (c0 + step);
                u32x4* ptr = (u32x4*)(kvbuf + ((size_t)(c * 4 + h) * 2 + dir) * 16384 + e8 * 8);
                const u32x4 v = *ptr; u32x4 w; w.x = pk2(st[0], st[1]); w.y = pk2(st[2], st[3]); w.z = pk2(st[4], st[5]); w.w = pk2(st[6], st[7]); *ptr = w;
                const unsigned vv[4] = {v.x, v.y, v.z, v.w};
#pragma unroll
                for (int q = 0; q < 4; ++q) { st[2 * q] = st[2 * q] * Dk + bf2f((unsigned short)(vv[q] & 0xffffu)); st[2 * q + 1] = st[2 * q + 1] * Dk + bf2f((unsigned short)(vv[q] >> 16)); }
            }
        }
    }
}

__device__ __forceinline__ void ret_out_phase(const Params& p, LAS unsigned char* lds, int G) {
    const int tid = threadIdx.x, lane = tid & 63, wave = tid >> 6, fr = lane & 15, fq = lane >> 4;
    const bf16_t* proj = (const bf16_t*)(p.ws + WS_HID); const bf16_t* kvbuf = (const bf16_t*)(p.ws + WS_ACTA); bf16_t* mix = (bf16_t*)(p.ws + WS_ACTB);
    LAS bf16_t* Ql = (LAS bf16_t*)lds; LAS bf16_t* Kl = (LAS bf16_t*)(lds + 34816); LAS bf16_t* Vt = (LAS bf16_t*)(lds + 69632); LAS bf16_t* Pl = (LAS bf16_t*)(lds + 104448);
    for (int unit = blockIdx.x; unit < (T / 128) * 4; unit += G) {
        const int c = unit >> 2, h = unit & 3, row0 = c * 128;
        const float ldf = p.in[10][h], ldb = p.in[11][h];
        __syncthreads();
#pragma unroll
        for (int i = 0; i < 4; ++i) {
            const int id = tid + NTHR * i, tok = id >> 4, dch = id & 15;
            const bf16_t* src = proj + (size_t)(row0 + tok) * DIN + 768 + h * 128 + dch * 8;
            const u32x4 qq = *(const u32x4*)src, kq = *(const u32x4*)(src + 512), vq = *(const u32x4*)(src + 1024);
            *(LAS u32x4*)(Ql + tok * 136 + dch * 8) = qq; *(LAS u32x4*)(Kl + tok * 136 + dch * 8) = kq;
            LAS bf16_t* vd = Vt + (dch * 8) * 136 + tok;
            vd[0 * 136] = (bf16_t)(vq.x & 0xffffu); vd[1 * 136] = (bf16_t)(vq.x >> 16); vd[2 * 136] = (bf16_t)(vq.y & 0xffffu); vd[3 * 136] = (bf16_t)(vq.y >> 16);
            vd[4 * 136] = (bf16_t)(vq.z & 0xffffu); vd[5 * 136] = (bf16_t)(vq.z >> 16); vd[6 * 136] = (bf16_t)(vq.w & 0xffffu); vd[7 * 136] = (bf16_t)(vq.w >> 16);
        }
        __syncthreads();
        const int il = 16 * wave + fr;
        bf16x8 qa[4];
#pragma unroll
        for (int k = 0; k < 4; ++k) qa[k] = LDS16(Ql + il * 136 + 32 * k + 8 * fq);
        f32x4 o1[8];
        {
            f32x4 s[8];
#pragma unroll
            for (int n = 0; n < 8; ++n) { s[n] = (f32x4){0.f, 0.f, 0.f, 0.f};
#pragma unroll
                for (int k = 0; k < 4; ++k) s[n] = MMA16(LDS16(Kl + (16 * n + fr) * 136 + 32 * k + 8 * fq), qa[k], s[n]); }
#pragma unroll
            for (int n = 0; n < 8; ++n) { f32x4 pv;
#pragma unroll
                for (int e = 0; e < 4; ++e) { const int j = 16 * n + 4 * fq + e, dlt = il - j; const float mk = dlt > 0 ? fexp(ldf * (float)dlt) : (dlt < 0 ? fexp(ldb * (float)(-dlt)) : 2.0f); pv[e] = s[n][e] * mk; }
                u32x2 w; w.x = cvt_pk_bf16(pv[0], pv[1]); w.y = cvt_pk_bf16(pv[2], pv[3]);
                *(LAS u32x2*)(Pl + il * 136 + 16 * n + 4 * fq) = w; }
            asm volatile("s_waitcnt lgkmcnt(0)" ::: "memory");
            bf16x8 pa[4];
#pragma unroll
            for (int k = 0; k < 4; ++k) pa[k] = LDS16(Pl + il * 136 + 32 * k + 8 * fq);
#pragma unroll
            for (int n = 0; n < 8; ++n) { o1[n] = (f32x4){0.f, 0.f, 0.f, 0.f};
#pragma unroll
                for (int k = 0; k < 4; ++k) o1[n] = MMA16(LDS16(Vt + (16 * n + fr) * 136 + 32 * k + 8 * fq), pa[k], o1[n]); }
        }
        __syncthreads();
        {
            const bf16_t* sf = kvbuf + ((size_t)(c * 4 + h) * 2) * 16384;
#pragma unroll
            for (int i = 0; i < 4; ++i) { const int id = tid + NTHR * i, dv = id >> 4, dch = id & 15;
                *(LAS u32x4*)(Kl + dv * 136 + dch * 8) = *(const u32x4*)(sf + dv * 128 + dch * 8);
                *(LAS u32x4*)(Pl + dv * 136 + dch * 8) = *(const u32x4*)(sf + 16384 + dv * 128 + dch * 8); }
        }
        __syncthreads();
        {
            const float ef = fexp(ldf * (float)(il + 1)), eb = fexp(ldb * (float)(128 - il));
#pragma unroll
            for (int n = 0; n < 8; ++n) { f32x4 a = (f32x4){0.f, 0.f, 0.f, 0.f}, b = (f32x4){0.f, 0.f, 0.f, 0.f};
#pragma unroll
                for (int k = 0; k < 4; ++k) { a = MMA16(LDS16(Kl + (16 * n + fr) * 136 + 32 * k + 8 * fq), qa[k], a); b = MMA16(LDS16(Pl + (16 * n + fr) * 136 + 32 * k + 8 * fq), qa[k], b); }
                o1[n] = o1[n] + a * ef + b * eb; }
        }
        float sm = 0.f;
#pragma unroll
        for (int n = 0; n < 8; ++n) sm += (o1[n][0] + o1[n][1]) + (o1[n][2] + o1[n][3]);
        sm += __shfl_xor(sm, 16); sm += __shfl_xor(sm, 32);
        const float mu = sm * (1.0f / 128.0f); float sq = 0.f;
#pragma unroll
        for (int n = 0; n < 8; ++n) { o1[n] = o1[n] - mu; sq += (o1[n][0] * o1[n][0] + o1[n][1] * o1[n][1]) + (o1[n][2] * o1[n][2] + o1[n][3] * o1[n][3]); }
        sq += __shfl_xor(sq, 16); sq += __shfl_xor(sq, 32);
        const float rs = __builtin_amdgcn_rsqf(sq * (1.0f / 128.0f) + EPS);
        const bf16_t* gsrc = proj + (size_t)(row0 + il) * DIN + 2304 + h * 128 + 4 * fq;
        bf16_t* dst = mix + (size_t)(row0 + il) * D + 512 + h * 128 + 4 * fq;
#pragma unroll
        for (int n = 0; n < 8; ++n) { const u32x2 g = *(const u32x2*)(gsrc + 16 * n);
            const float g0 = bf2f((unsigned short)(g.x & 0xffffu)), g1 = bf2f((unsigned short)(g.x >> 16)), g2 = bf2f((unsigned short)(g.y & 0xffffu)), g3 = bf2f((unsigned short)(g.y >> 16));
            u32x2 w; w.x = cvt_pk_bf16(silu_f(g0) * o1[n][0] * rs, silu_f(g1) * o1[n][1] * rs); w.y = cvt_pk_bf16(silu_f(g2) * o1[n][2] * rs, silu_f(g3) * o1[n][3] * rs);
            *(u32x2*)(dst + 16 * n) = w; }
    }
}

__device__ __forceinline__ void final_norm_phase(const Params& p, int G) {
    const int lane = threadIdx.x & 63, wave = threadIdx.x >> 6; const int gw = blockIdx.x * 8 + wave, NGW = G * 8;
    const f32x4* gp = (const f32x4*)p.in[17] + lane;
    for (int row = gw; row < T; row += NGW) {
        f32x4* xr = (f32x4*)(p.out + (size_t)row * D) + lane; f32x4 v[4]; float s = 0.f;
#pragma unroll
        for (int j = 0; j < 4; ++j) { v[j] = xr[64 * j]; s += (v[j][0] * v[j][0] + v[j][1] * v[j][1]) + (v[j][2] * v[j][2] + v[j][3] * v[j][3]); }
        const float rstd = __builtin_amdgcn_rsqf(wave_sum(s) * (1.f / D) + EPS);
#pragma unroll
        for (int j = 0; j < 4; ++j) xr[64 * j] = v[j] * rstd * gp[64 * j];
    }
}

constexpr int NPHASE = 11;
__global__ void __launch_bounds__(NTHR, 2) mk_fwd(Params p) {
    extern __shared__ __attribute__((aligned(16))) unsigned char lds_raw[];
    LAS unsigned char* lds = (LAS unsigned char*)lds_raw;
    const int G = gridDim.x, lo = p.ph_lo, hi = p.ph_hi;
    cg::grid_group grid = cg::this_grid();
#define IN(k) (lo <= (k) && (k) < hi)
#define SEAM(k) do { if (IN(k) && IN((k) + 1)) grid.sync(); } while (0)
    bf16_t* ACTA = (bf16_t*)(p.ws + WS_ACTA); bf16_t* ACTB = (bf16_t*)(p.ws + WS_ACTB); bf16_t* HID = (bf16_t*)(p.ws + WS_HID);
    float* SSQ = (float*)(p.ws + WS_SSQ);
    if (IN(0)) { p0_prologue(p, lds, G); }
    SEAM(0);
    if (IN(1)) {
        pg8::Gemm g{ACTA, (const bf16_t*)(p.ws + WS_WGU1), T, 2 * FF, D}; pg8::StaticOrder S; S.init(T, 2 * FF, G, (int)blockIdx.x);
        EpiSwiGLU<false> E{HID, nullptr};
        pg8::gemm_phase<EpiSwiGLU<false>, pg8::StaticOrder, PG8_ALIGN, PG8_SP2>(lds, g, S, E);
    }
    SEAM(1);
    if (IN(2)) {
        pg8::Gemm g{HID, (const bf16_t*)(p.ws + WS_WD1), T, D, FF}; pg8::StaticOrder S; S.init(T, D, G, (int)blockIdx.x);
        EpiResid<true, true> E{p.in[0], p.in[1] - (size_t)TP * D, p.out, ACTA, SSQ, 0.5f};
        pg8::gemm_phase<EpiResid<true, true>, pg8::StaticOrder, PG8_ALIGN, PG8_SP2>(lds, g, S, E);
    }
    SEAM(2);
    if (IN(3)) {
        pg8::Gemm g{ACTA, (const bf16_t*)(p.ws + WS_WIN), T, DIN, D}; pg8::StaticOrder S; S.init(T, DIN, G, (int)blockIdx.x);
        EpiProj E{HID, SSQ, (const float*)(p.ws + WS_TABA), (const float*)(p.ws + WS_TABR)};
        pg8::gemm_phase<EpiProj, pg8::StaticOrder, PG8_ALIGN, PG8_SP2>(lds, g, S, E);
    }
    SEAM(3);
    if (IN(4)) { attn_phase(p, lds, G); ret_kv_phase(p, lds, G); }
    SEAM(4);
    if (IN(5)) { ret_scan_phase(p, G); }
    SEAM(5);
    if (IN(6)) { ret_out_phase(p, lds, G); }
    SEAM(6);
    if (IN(7)) {
        __syncthreads();
        pg8::Gemm g{ACTB, (const bf16_t*)(p.ws + WS_WOUT), T, D, D}; pg8::StaticOrder S; S.init(T, D, G, (int)blockIdx.x);
        EpiResid<true, true> E{p.out, p.out, p.out, ACTA, SSQ, 1.0f};
        pg8::gemm_phase<EpiResid<true, true>, pg8::StaticOrder, PG8_ALIGN, PG8_SP2>(lds, g, S, E);
    }
    SEAM(7);
    if (IN(8)) {
        pg8::Gemm g{ACTA, (const bf16_t*)(p.ws + WS_WGU2), T, 2 * FF, D}; pg8::StaticOrder S; S.init(T, 2 * FF, G, (int)blockIdx.x);
        EpiSwiGLU<true> E{HID, SSQ};
        pg8::gemm_phase<EpiSwiGLU<true>, pg8::StaticOrder, PG8_ALIGN, PG8_SP2>(lds, g, S, E);
    }
    SEAM(8);
    if (IN(9)) {
        pg8::Gemm g{HID, (const bf16_t*)(p.ws + WS_WD2), T, D, FF}; pg8::StaticOrder S; S.init(T, D, G, (int)blockIdx.x);
        EpiResid<false, false> E{p.out, p.out, p.out, nullptr, nullptr, 0.5f};
        pg8::gemm_phase<EpiResid<false, false>, pg8::StaticOrder, PG8_ALIGN, PG8_SP2>(lds, g, S, E);
    }
    SEAM(9);
    if (IN(10)) { final_norm_phase(p, G); }
#undef IN
#undef SEAM
}

extern "C" void kernel_launch(void* const* d_in, const int* in_sizes, int n_in, void* d_out, int out_size, void* d_ws, size_t ws_size, hipStream_t stream) {
    static int grid = 0;
    if (grid == 0) {
        if (n_in != 18 || out_size != T * D || ws_size < WS_END) { fprintf(stderr, "kernel_launch: unexpected shapes (n_in %d, out %d, ws %zu)\n", n_in, out_size, ws_size); grid = -1; return; }
        int dev = 0, cus = 0, per_cu = 0;
        if (hipGetDevice(&dev) != hipSuccess || hipDeviceGetAttribute(&cus, hipDeviceAttributeMultiprocessorCount, dev) != hipSuccess) { grid = -1; return; }
        if (hipFuncSetAttribute((const void*)mk_fwd, hipFuncAttributeMaxDynamicSharedMemorySize, LDS_BYTES) != hipSuccess) { fprintf(stderr, "kernel_launch: hipFuncSetAttribute failed\n"); grid = -1; return; }
        if (hipOccupancyMaxActiveBlocksPerMultiprocessor(&per_cu, (const void*)mk_fwd, NTHR, LDS_BYTES) != hipSuccess || per_cu < 1) { fprintf(stderr, "kernel_launch: occupancy query says %d\n", per_cu); per_cu = 1; }
        (void)hipGetLastError();
        grid = cus;
    }
    if (grid < 0) return;
    Params a{};
    for (int i = 0; i < 18; ++i) a.in[i] = (const float*)d_in[i];
    a.out = (float*)d_out; a.ws = (unsigned char*)d_ws;
#if MK_ONE_LAUNCH
    a.ph_lo = 0; a.ph_hi = NPHASE;
    void* args[] = {&a};
    hipError_t e = hipLaunchCooperativeKernel((const void*)mk_fwd, dim3(grid), dim3(NTHR), args, LDS_BYTES, stream);
    if (e != hipSuccess) fprintf(stderr, "kernel_launch: cooperative launch failed: %s (grid %d)\n", hipGetErrorString(e), grid);
#else
    for (int ph = 0; ph < NPHASE; ++ph) { a.ph_lo = ph; a.ph_hi = ph + 1; hipLaunchKernelGGL(mk_fwd, dim3(grid), dim3(NTHR), LDS_BYTES, stream, a); }
#endif
}
```

```cpp
#include <hip/hip_runtime.h>
#include <hip/hip_cooperative_groups.h>
#include <cstdio>
#include <cstdint>
namespace cg = cooperative_groups;
#ifndef DUP
#define DUP 0
#endif
#ifndef MK_CHAIN
#define MK_CHAIN 1
#endif
#ifndef MK_ONE_LAUNCH
#define MK_ONE_LAUNCH 1
#endif
namespace pg8 {
#define PG8_LAS __attribute__((address_space(3)))
typedef unsigned short bf16_t;
typedef short bf16x8 __attribute__((ext_vector_type(8)));
typedef float f32x4 __attribute__((ext_vector_type(4)));
typedef unsigned u32x4 __attribute__((ext_vector_type(4)));
constexpr int BM = 256, BK = 64, HALF = 128, HTB = HALF * BK * 2  , STAGE_BYTES = 8 * HTB, NXCD = 8, WGM = 8;

__host__ __device__ __forceinline__ int lds_byte(int r, int c) { const int st = (r >> 4) * 2 + (c >> 5), rr = r & 15, cc = c & 31, ob = rr * 64 + cc * 2; return st * 1024 + (ob ^ (((ob >> 9) & 1) << 5)); }
__host__ __device__ __forceinline__ void stage_rc(int b, int& R, int& C) { const int st = b / 1024, sb = b % 1024, swz = sb ^ (((sb >> 9) & 1) << 5); R = (st >> 1) * 16 + swz / 64; C = (st & 1) * 32 + (swz % 64) / 2; }
__host__ __device__ __forceinline__ int perm32(int rho) { const int n = rho >> 4, i = rho & 15; return 8 * (i >> 2) + 4 * n + (i & 3); }

struct Unit { int pm, pn; };
struct Gemm { const bf16_t* A; const bf16_t* Bt; int M, N, K; };

struct StaticOrder {
    int nM, nN, nwg, G, c;
    __host__ __device__ void init(int M, int N, int G_, int c_) { nM = M / BM; nN = N / BM; nwg = nM * nN; G = G_; c = c_; }
    __host__ __device__ bool next(int i, Unit& u) const {
        const long L = (long)i * G + c; if (L >= nwg) return false;
        int wgid = (int)L; { const int q = nwg / NXCD, r = nwg % NXCD, xcd = wgid % NXCD, off = wgid / NXCD; wgid = (xcd < r ? xcd * (q + 1) : r * (q + 1) + (xcd - r) * q) + off; }
        const int nig = WGM * nN, gid = wgid / nig, fm = gid * WGM, gsz = (nM - fm) < WGM ? (nM - fm) : WGM;
        u.pm = fm + ((wgid % nig) % gsz); u.pn = (wgid % nig) / gsz; return true;
    }
    __device__ __forceinline__ void a_ready(const Unit&) const {}
    __device__ __forceinline__ void done(const Unit&) const {}
};

__device__ __forceinline__ unsigned cvt_pk_bf16(float lo, float hi) { unsigned r; asm volatile("v_cvt_pk_bf16_f32 %0, %1, %2" : "=v"(r) : "v"(lo), "v"(hi)); return r; }
typedef float f32x2 __attribute__((ext_vector_type(2)));
template <class Epi, class Sched, bool ALIGN_EPI = false, bool SP2 = false>
__device__ __forceinline__ void gemm_phase(PG8_LAS unsigned char* lds, const Gemm g, const Sched& S, const Epi& E) {
    const int tid = threadIdx.x, wid = __builtin_amdgcn_readfirstlane(tid >> 6), lane = tid & 63, wr = wid >> 2, wc = wid & 3, fr = lane & 15, fq = lane >> 4;
    const int K = g.K, nt = K / BK;
    unsigned voffA[2], voffB[2];
#pragma unroll
    for (int i = 0; i < 2; ++i) { int R, C; stage_rc(tid * 16 + i * 8192, R, C); const int Rb = Epi::PERM ? ((R & ~31) + perm32(R & 31)) : R;
        voffA[i] = (unsigned)(R * K + C) * 2u; voffB[i] = (unsigned)(Rb * K + C) * 2u; }
    const size_t kstep = (size_t)(BK * 2);
    const size_t hstep = (size_t)HALF * K * 2;
    const size_t tstep = 2 * hstep;
    const unsigned ldsw = (unsigned)wid * 1024u;
    const int aoff = lds_byte(wr * 64 + fr, fq * 8), boff = lds_byte(wc * 32 + fr, fq * 8);
#define PG8_SA(b, h) (((b) * 2 + (h)) * HTB)
#define PG8_SB(b, h) ((4 + (b) * 2 + (h)) * HTB)
#define PG8_STAGE(bufoff, gbase, voff) do { _Pragma("unroll") for (int _i = 0; _i < 2; ++_i) \
        __builtin_amdgcn_global_load_lds((const unsigned*)((const char*)(gbase) + (voff)[_i]), (PG8_LAS unsigned*)(lds + (bufoff) + ldsw + _i * 8192), 16, 0, 0); } while (0)
#define PG8_LDA(dst, b, h) do { _Pragma("unroll") for (int m = 0; m < 4; ++m) _Pragma("unroll") for (int k = 0; k < 2; ++k) dst[m][k] = *(const PG8_LAS bf16x8*)(lds + PG8_SA(b, h) + aoff + m * 2048 + k * 1024); } while (0)
#define PG8_LDB(dst, b, h) do { _Pragma("unroll") for (int n = 0; n < 2; ++n) _Pragma("unroll") for (int k = 0; k < 2; ++k) dst[n][k] = *(const PG8_LAS bf16x8*)(lds + PG8_SB(b, h) + boff + n * 2048 + k * 1024); } while (0)
#define PG8_MMA(ai, bj, At, Bt) do { __builtin_amdgcn_s_setprio(1); _Pragma("unroll") for (int m = 0; m < 4; ++m) _Pragma("unroll") for (int n = 0; n < 2; ++n) _Pragma("unroll") for (int k = 0; k < 2; ++k) \
        acc[ai][bj][m][n] = __builtin_amdgcn_mfma_f32_16x16x32_bf16(Bt[n][k], At[m][k], acc[ai][bj][m][n], 0, 0, 0); __builtin_amdgcn_s_setprio(0); } while (0)
#define PG8_WAIT_V(n) asm volatile("s_waitcnt vmcnt(" #n ")" ::: "memory")
#define PG8_WAIT_L(n) asm volatile("s_waitcnt lgkmcnt(" #n ")" ::: "memory")
#define PG8_BAR __builtin_amdgcn_s_barrier()
#define PG8_SCHED __builtin_amdgcn_sched_barrier(0)
    Unit cur, nxt; int ui = 0;
    if (!S.next(0, cur)) return;
    f32x4 acc[2][2][4][2];
#pragma unroll
    for (int a = 0; a < 2; ++a)
#pragma unroll
        for (int b = 0; b < 2; ++b)
#pragma unroll
            for (int m = 0; m < 4; ++m)
#pragma unroll
                for (int n = 0; n < 2; ++n) acc[a][b][m][n] = (f32x4){0.f, 0.f, 0.f, 0.f};
    bf16x8 At[4][2], B0[2][2], B1[2][2];
    const char* cA = (const char*)g.A + (size_t)cur.pm * tstep; const char* cB = (const char*)g.Bt + (size_t)cur.pn * tstep;
    S.a_ready(cur);
    if constexpr (SP2) {
        PG8_STAGE(PG8_SB(0, 0), cB, voffB); PG8_STAGE(PG8_SB(0, 1), cB + hstep, voffB); PG8_STAGE(PG8_SA(0, 0), cA, voffA); PG8_STAGE(PG8_SA(0, 1), cA + hstep, voffA);
        if (wr == 1) PG8_BAR;
        PG8_WAIT_V(2); PG8_BAR;
        PG8_STAGE(PG8_SB(1, 0), cB + kstep, voffB); PG8_STAGE(PG8_SA(1, 0), cA + kstep, voffA); PG8_STAGE(PG8_SB(1, 1), cB + hstep + kstep, voffB);
        PG8_WAIT_V(6); PG8_BAR;
    } else {
        PG8_STAGE(PG8_SB(0, 0), cB, voffB); PG8_STAGE(PG8_SA(0, 0), cA, voffA); PG8_STAGE(PG8_SB(0, 1), cB + hstep, voffB); PG8_STAGE(PG8_SA(0, 1), cA + hstep, voffA);
        if (wr == 1) PG8_BAR;
        PG8_WAIT_V(4); PG8_BAR;
        PG8_STAGE(PG8_SB(1, 0), cB + kstep, voffB); PG8_STAGE(PG8_SA(1, 0), cA + kstep, voffA); PG8_STAGE(PG8_SB(1, 1), cB + hstep + kstep, voffB);
        PG8_WAIT_V(6); PG8_BAR;
    }
    for (;;) {
        const bool has_next = S.next(ui + 1, nxt);
        const char* nA = has_next ? (const char*)g.A + (size_t)nxt.pm * tstep : cA; const char* nB = has_next ? (const char*)g.Bt + (size_t)nxt.pn * tstep : cB;
        for (int t = 0; t < nt; t += 2) {
            const bool last = (t == nt - 2);
            const char* a1 = cA + (size_t)(t + 1) * kstep;
            const char* a2 = last ? nA : cA + (size_t)(t + 2) * kstep; const char* b2 = last ? nB : cB + (size_t)(t + 2) * kstep;
            const char* a3 = a2 + kstep; const char* b3 = b2 + kstep;
            if (last && has_next) S.a_ready(nxt);
            if constexpr (SP2) {
            PG8_LDB(B0, 0, 0); PG8_LDB(B1, 0, 1); PG8_SCHED; PG8_LDA(At, 0, 0); PG8_STAGE(PG8_SA(1, 1), a1 + hstep, voffA);
            PG8_WAIT_V(8); PG8_WAIT_L(0); PG8_BAR; PG8_MMA(0, 0, At, B0); PG8_MMA(0, 1, At, B1); PG8_BAR; PG8_SCHED;
            PG8_LDA(At, 0, 1); PG8_STAGE(PG8_SB(0, 0), b2, voffB); PG8_STAGE(PG8_SB(0, 1), b2 + hstep, voffB); PG8_STAGE(PG8_SA(0, 0), a2, voffA);
            PG8_WAIT_V(8); PG8_WAIT_L(0); PG8_BAR; PG8_MMA(1, 0, At, B0); PG8_MMA(1, 1, At, B1); PG8_BAR; PG8_SCHED;
            PG8_LDB(B0, 1, 0); PG8_LDB(B1, 1, 1); PG8_SCHED; PG8_LDA(At, 1, 0); PG8_STAGE(PG8_SA(0, 1), a2 + hstep, voffA);
            PG8_WAIT_V(8); PG8_WAIT_L(0); PG8_BAR; PG8_MMA(0, 0, At, B0); PG8_MMA(0, 1, At, B1); PG8_BAR; PG8_SCHED;
            PG8_LDA(At, 1, 1); PG8_STAGE(PG8_SB(1, 0), b3, voffB); PG8_STAGE(PG8_SB(1, 1), b3 + hstep, voffB); PG8_STAGE(PG8_SA(1, 0), a3, voffA);
            PG8_WAIT_V(8); PG8_WAIT_L(0); PG8_BAR; PG8_MMA(1, 0, At, B0); PG8_MMA(1, 1, At, B1); PG8_BAR; PG8_SCHED;
            } else {
            PG8_LDB(B0, 0, 0); PG8_SCHED; PG8_LDA(At, 0, 0); PG8_STAGE(PG8_SA(1, 1), a1 + hstep, voffA);
            PG8_WAIT_L(8); PG8_BAR; PG8_WAIT_L(0); PG8_MMA(0, 0, At, B0); PG8_BAR; PG8_SCHED;
            PG8_LDB(B1, 0, 1); PG8_STAGE(PG8_SB(0, 0), b2, voffB);
            PG8_BAR; PG8_WAIT_L(0); PG8_MMA(0, 1, At, B1); PG8_BAR;
            PG8_LDA(At, 0, 1); PG8_STAGE(PG8_SA(0, 0), a2, voffA);
            PG8_BAR; PG8_WAIT_L(0); PG8_MMA(1, 0, At, B0); PG8_BAR; PG8_SCHED;
            PG8_STAGE(PG8_SB(0, 1), b2 + hstep, voffB);
            PG8_WAIT_V(6); PG8_BAR; PG8_MMA(1, 1, At, B1); PG8_BAR;
            PG8_LDB(B0, 1, 0); PG8_SCHED; PG8_LDA(At, 1, 0); PG8_STAGE(PG8_SA(0, 1), a2 + hstep, voffA);
            PG8_WAIT_L(8); PG8_BAR; PG8_WAIT_L(0); PG8_MMA(0, 0, At, B0); PG8_BAR; PG8_SCHED;
            PG8_LDB(B1, 1, 1); PG8_STAGE(PG8_SB(1, 0), b3, voffB);
            PG8_BAR; PG8_WAIT_L(0); PG8_MMA(0, 1, At, B1); PG8_BAR;
            PG8_LDA(At, 1, 1); PG8_STAGE(PG8_SA(1, 0), a3, voffA);
            PG8_BAR; PG8_WAIT_L(0); PG8_MMA(1, 0, At, B0); PG8_BAR; PG8_SCHED;
            PG8_STAGE(PG8_SB(1, 1), b3 + hstep, voffB);
            PG8_WAIT_V(6); PG8_BAR; PG8_MMA(1, 1, At, B1); PG8_BAR;
            }
        }
        if constexpr (ALIGN_EPI) { if (wr == 0) PG8_BAR; }
        if constexpr (!Epi::AFTER_DRAIN) { E(acc, cur, wr, wc, fr, fq); S.done(cur); }
        if (!has_next) break;
#pragma unroll
        for (int a = 0; a < 2; ++a)
#pragma unroll
            for (int b = 0; b < 2; ++b)
#pragma unroll
                for (int m = 0; m < 4; ++m)
#pragma unroll
                    for (int n = 0; n < 2; ++n) acc[a][b][m][n] = (f32x4){0.f, 0.f, 0.f, 0.f};
        cur = nxt; cA = nA; cB = nB; ++ui;
        if constexpr (ALIGN_EPI) { if (wr == 1) PG8_BAR; }
    }
    PG8_WAIT_V(0);
    if constexpr (!ALIGN_EPI) { if (wr == 0) PG8_BAR; }
    PG8_BAR;
    if constexpr (Epi::AFTER_DRAIN) { E.fused(acc, cur, wr, wc, fr, fq, lds, wid, lane); S.done(cur); }
#undef PG8_SA
#undef PG8_SB
#undef PG8_STAGE
#undef PG8_LDA
#undef PG8_LDB
#undef PG8_MMA
#undef PG8_WAIT_V
#undef PG8_WAIT_L
#undef PG8_BAR
#undef PG8_SCHED
}
}

#ifndef PG8_SP2
#define PG8_SP2 true
#endif
#ifndef PG8_ALIGN
#define PG8_ALIGN true
#endif

#define LAS __attribute__((address_space(3)))
using pg8::bf16_t; using pg8::bf16x8; using pg8::f32x4; using pg8::u32x4;
typedef float f32x2_t __attribute__((ext_vector_type(2)));
typedef __bf16 bf16x2_t __attribute__((ext_vector_type(2)));
__device__ __forceinline__ unsigned cvt_pk_bf16(float lo, float hi) { f32x2_t v = {lo, hi}; bf16x2_t b = __builtin_convertvector(v, bf16x2_t); return __builtin_bit_cast(unsigned, b); }
typedef unsigned u32x2 __attribute__((ext_vector_type(2)));
constexpr int T = 49152, TP = 32768, D = 1024, FF = 2816, DIN = 2816, NTHR = 512;
constexpr float EPS = 1e-6f;
constexpr size_t MiB = 1u << 20;
constexpr size_t WU = (size_t)2816 * 1024 * 2;
constexpr size_t WS_WGU1 = 0, WS_WD1 = 2 * WU, WS_WIN = 3 * WU, WS_WOUT = 4 * WU, WS_WGU2 = WS_WOUT + 2 * MiB, WS_WD2 = WS_WGU2 + 2 * WU;
constexpr size_t WS_TABR = WS_WD2 + WU, WS_TABA = WS_TABR + 8192 * 64 * 8, WS_SSQ = WS_TABA + 8192 * 8 * 8;
constexpr size_t WS_ACTA = 48 * MiB, WS_ACTB = 144 * MiB, WS_HID = 240 * MiB, WS_END = 504 * MiB;
static_assert(WS_SSQ + (size_t)T * 16 * 4 <= WS_ACTA, "ws map");
static_assert(WS_ACTA + (size_t)T * D * 2 <= WS_ACTB && WS_ACTB + (size_t)T * D * 2 <= WS_HID && WS_HID + (size_t)T * FF * 2 <= WS_END, "ws map");
constexpr int LDS_BYTES = 147456;

struct Params { const float* in[18]; float* out; unsigned char* ws; int ph_lo, ph_hi; };

__device__ __forceinline__ float silu_f(float x) { return x * __builtin_amdgcn_rcpf(1.0f + __builtin_amdgcn_exp2f(-1.4426950408889634f * x)); }
__device__ __forceinline__ float fexp(float x) { return __builtin_amdgcn_exp2f(1.4426950408889634f * x); }
__device__ __forceinline__ float bf2f(unsigned short b) { return __builtin_bit_cast(float, ((unsigned)b) << 16); }
__device__ __forceinline__ unsigned f2bf(float f) { unsigned u = __builtin_bit_cast(unsigned, f); return (u + 0x7fffu + ((u >> 16) & 1u)) >> 16; }
__device__ __forceinline__ unsigned pk2(float lo, float hi) { return f2bf(lo) | (f2bf(hi) << 16); }
__device__ __forceinline__ float wave_sum(float v) {
#pragma unroll
    for (int o = 1; o < 64; o <<= 1) v += __shfl_xor(v, o);
    return v;
}
__device__ __forceinline__ int row_pos(int row) { return row < TP ? (row & 8191) : (row & 2047); }
__device__ __forceinline__ float row_rstd(const float* ssq, int row, int fq) {
    const f32x4 p = *(const f32x4*)(ssq + (size_t)row * 16 + 4 * fq);
    float s = (p[0] + p[1]) + (p[2] + p[3]);
    s += __shfl_xor(s, 16); s += __shfl_xor(s, 32);
    return __builtin_amdgcn_rsqf(s * (1.0f / 1024.0f) + EPS);
}

__device__ __forceinline__ void row_rstd8(const float* ssq, int row0, int fq, float (&r)[8]) {
    f32x4 pp[8];
#pragma unroll
    for (int q = 0; q < 8; ++q) pp[q] = *(const f32x4*)(ssq + (size_t)(row0 + (q >> 2) * 128 + (q & 3) * 16) * 16 + 4 * fq);
#pragma unroll
    for (int q = 0; q < 8; ++q) { float s = (pp[q][0] + pp[q][1]) + (pp[q][2] + pp[q][3]); s += __shfl_xor(s, 16); s += __shfl_xor(s, 32); r[q] = __builtin_amdgcn_rsqf(s * (1.0f / 1024.0f) + EPS); }
}
template <bool SCALE> struct EpiSwiGLU {
    static constexpr bool PERM = true, AFTER_DRAIN = false;
    bf16_t* O; const float* ssq;
    __device__ __forceinline__ void operator()(const f32x4 (&acc)[2][2][4][2], const pg8::Unit& u, int wr, int wc, int fr, int fq) const {
        const int row0 = u.pm * 256 + wr * 64 + fr, col0 = u.pn * 128 + wc * 32 + 8 * fq;
        float rr[8]; if (SCALE) row_rstd8(ssq, row0, fq, rr);
#pragma unroll
        for (int ai = 0; ai < 2; ++ai)
#pragma unroll
            for (int m = 0; m < 4; ++m) {
                const int row = row0 + ai * 128 + m * 16;
                float r = 1.f; if (SCALE) r = rr[ai * 4 + m];
                const f32x4 g0 = acc[ai][0][m][0] * r, g1 = acc[ai][0][m][1] * r, u0 = acc[ai][1][m][0] * r, u1 = acc[ai][1][m][1] * r;
                u32x4 w;
                w.x = cvt_pk_bf16(silu_f(g0[0]) * u0[0], silu_f(g0[1]) * u0[1]); w.y = cvt_pk_bf16(silu_f(g0[2]) * u0[2], silu_f(g0[3]) * u0[3]);
                w.z = cvt_pk_bf16(silu_f(g1[0]) * u1[0], silu_f(g1[1]) * u1[1]); w.w = cvt_pk_bf16(silu_f(g1[2]) * u1[2], silu_f(g1[3]) * u1[3]);
                *(u32x4*)(O + (size_t)row * FF + col0) = w;
            }
    }
};
template <bool RB, bool OF, bool OB, bool WS> struct EpiResid {
    static constexpr bool PERM = true, AFTER_DRAIN = false;
    const float* res0; const float* res1; const bf16_t* resb; float* out; bf16_t* outb; float* ssq; float scale;
    __device__ __forceinline__ void operator()(const f32x4 (&acc)[2][2][4][2], const pg8::Unit& u, int wr, int wc, int fr, int fq) const {
        const int row0 = u.pm * 256 + wr * 64 + fr, col0 = u.pn * 256 + wc * 32 + 8 * fq;
        const float* rb = (u.pm * 256 < TP) ? res0 : res1;
#pragma unroll
        for (int ai = 0; ai < 2; ++ai)
#pragma unroll
            for (int mp = 0; mp < 2; ++mp) {
                f32x4 x[2][2][2];
#pragma unroll
                for (int mq = 0; mq < 2; ++mq)
#pragma unroll
                    for (int bj = 0; bj < 2; ++bj) { const size_t off = (size_t)(row0 + ai * 128 + (2 * mp + mq) * 16) * D + col0 + bj * 128;
                        if (RB) { const u32x4 r = *(const u32x4*)(resb + off);
                            x[mq][bj][0] = (f32x4){__builtin_bit_cast(float, r.x << 16), __builtin_bit_cast(float, r.x & 0xffff0000u), __builtin_bit_cast(float, r.y << 16), __builtin_bit_cast(float, r.y & 0xffff0000u)};
                            x[mq][bj][1] = (f32x4){__builtin_bit_cast(float, r.z << 16), __builtin_bit_cast(float, r.z & 0xffff0000u), __builtin_bit_cast(float, r.w << 16), __builtin_bit_cast(float, r.w & 0xffff0000u)}; }
                        else { x[mq][bj][0] = *(const f32x4*)(rb + off); x[mq][bj][1] = *(const f32x4*)(rb + off + 4); } }
#pragma unroll
                for (int mq = 0; mq < 2; ++mq) { const int m = 2 * mp + mq, row = row0 + ai * 128 + m * 16; float ss = 0.f;
#pragma unroll
                    for (int bj = 0; bj < 2; ++bj) { const size_t off = (size_t)row * D + col0 + bj * 128;
                        const f32x4 v0 = x[mq][bj][0] + acc[ai][bj][m][0] * scale, v1 = x[mq][bj][1] + acc[ai][bj][m][1] * scale;
                        if (OF) { *(f32x4*)(out + off) = v0; *(f32x4*)(out + off + 4) = v1; }
                        if (OB) { u32x4 w; w.x = cvt_pk_bf16(v0[0], v0[1]); w.y = cvt_pk_bf16(v0[2], v0[3]); w.z = cvt_pk_bf16(v1[0], v1[1]); w.w = cvt_pk_bf16(v1[2], v1[3]); *(u32x4*)(outb + off) = w; }
                        if (WS) ss += ((v0[0] * v0[0] + v0[1] * v0[1]) + (v0[2] * v0[2] + v0[3] * v0[3])) + ((v1[0] * v1[0] + v1[1] * v1[1]) + (v1[2] * v1[2] + v1[3] * v1[3])); }
                    if (WS) { ss += __shfl_xor(ss, 16); ss += __shfl_xor(ss, 32); if (fq == 0) ssq[(size_t)row * 16 + u.pn * 4 + wc] = ss; } }
            }
    }
};
struct EpiProj {
    static constexpr bool PERM = true, AFTER_DRAIN = false;
    bf16_t* O; const float* ssq;
    __device__ __forceinline__ void operator()(const f32x4 (&acc)[2][2][4][2], const pg8::Unit& u, int wr, int wc, int fr, int fq) const {
        const int row0 = u.pm * 256 + wr * 64 + fr, col0 = u.pn * 256 + wc * 32 + 8 * fq;
        float rr[8]; row_rstd8(ssq, row0, fq, rr);
        float fa[4], fr4[4];
#pragma unroll
        for (int j = 0; j < 4; ++j) { fa[j] = 0.15915494309189535f * exp2f(-18.931568569324174f * ((float)(2 * (4 * fq + j)) * (1.0f / 16.0f)));
                                      fr4[j] = 0.15915494309189535f * exp2f(-13.287712379549449f * ((float)(16 * wc + 4 * fq + j) * (1.0f / 63.0f))); }
#pragma unroll
        for (int ai = 0; ai < 2; ++ai)
#pragma unroll
            for (int m = 0; m < 4; ++m) {
                const int row = row0 + ai * 128 + m * 16; const float pos = (float)row_pos(row);
                const float r = rr[ai * 4 + m];
#pragma unroll
                for (int bj = 0; bj < 2; ++bj) {
                    const int seg = 2 * u.pn + bj;
                    float sc = r; if (seg < 4) sc = r * 0.125f; if (seg >= 10 && seg < 14) sc = r * 0.08838834764831845f;
                    f32x4 v0 = acc[ai][bj][m][0] * sc, v1 = acc[ai][bj][m][1] * sc;
                    const bool rotA = (seg <= 4) && ((wc & 1) == 0) && (fq < 2), rotR = (seg >= 6 && seg < 14);
                    if (seg <= 4 || rotR) {
#pragma unroll
                        for (int j = 0; j < 4; ++j) { const float rev = pos * (rotR ? fr4[j] : fa[j]), fv = rev - __builtin_floorf(rev);
                            const float c = (rotA || rotR) ? __builtin_amdgcn_cosf(fv) : 1.0f, sn = (rotA || rotR) ? __builtin_amdgcn_sinf(fv) : 0.0f;
                            const float x1 = v0[j], x2 = v1[j]; v0[j] = x1 * c - x2 * sn; v1[j] = x2 * c + x1 * sn; }
                    }
                    u32x4 w; w.x = cvt_pk_bf16(v0[0], v0[1]); w.y = cvt_pk_bf16(v0[2], v0[3]); w.z = cvt_pk_bf16(v1[0], v1[1]); w.w = cvt_pk_bf16(v1[2], v1[3]);
                    *(u32x4*)(O + (size_t)row * DIN + col0 + bj * 128) = w;
                }
            }
    }
};

struct EpiFinal {
    static constexpr bool PERM = true, AFTER_DRAIN = false;
    const bf16_t* resb; float* out; float* xch; unsigned* cnt; const float* gain;
    __device__ __forceinline__ void operator()(const f32x4 (&acc_)[2][2][4][2], const pg8::Unit& u, int wr, int wc, int fr, int fq) const {
        f32x4 (&A)[2][2][4][2] = const_cast<f32x4 (&)[2][2][4][2]>(acc_);
        const int row0 = u.pm * 256 + wr * 64 + fr, col0 = u.pn * 256 + wc * 32 + 8 * fq, lane = threadIdx.x & 63;
#pragma unroll
        for (int ai = 0; ai < 2; ++ai)
#pragma unroll
            for (int m = 0; m < 4; ++m) {
                const int row = row0 + ai * 128 + m * 16; float ss = 0.f;
#pragma unroll
                for (int bj = 0; bj < 2; ++bj) {
                    const size_t off = (size_t)row * D + col0 + bj * 128;
                    const u32x4 r = *(const u32x4*)(resb + off);
                    const f32x4 x0 = (f32x4){__builtin_bit_cast(float, r.x << 16), __builtin_bit_cast(float, r.x & 0xffff0000u), __builtin_bit_cast(float, r.y << 16), __builtin_bit_cast(float, r.y & 0xffff0000u)};
                    const f32x4 x1 = (f32x4){__builtin_bit_cast(float, r.z << 16), __builtin_bit_cast(float, r.z & 0xffff0000u), __builtin_bit_cast(float, r.w << 16), __builtin_bit_cast(float, r.w & 0xffff0000u)};
                    const f32x4 v0 = x0 + A[ai][bj][m][0] * 0.5f, v1 = x1 + A[ai][bj][m][1] * 0.5f;
                    A[ai][bj][m][0] = v0; A[ai][bj][m][1] = v1;
                    ss += ((v0[0] * v0[0] + v0[1] * v0[1]) + (v0[2] * v0[2] + v0[3] * v0[3])) + ((v1[0] * v1[0] + v1[1] * v1[1]) + (v1[2] * v1[2] + v1[3] * v1[3]));
                }
                ss += __shfl_xor(ss, 16); ss += __shfl_xor(ss, 32);
                if (fq == 0) __hip_atomic_store(xch + (size_t)row * 16 + u.pn * 4 + wc, ss, __ATOMIC_RELAXED, __HIP_MEMORY_SCOPE_AGENT);
            }
        asm volatile("s_waitcnt vmcnt(0)" ::: "memory");
        unsigned* cw = cnt + 64 * u.pm;
        if (lane == 0) __hip_atomic_fetch_add(cw, 1u, __ATOMIC_RELAXED, __HIP_MEMORY_SCOPE_AGENT);
        { unsigned spins = 0;
          while ((unsigned)__builtin_amdgcn_readfirstlane(__hip_atomic_load(cw, __ATOMIC_RELAXED, __HIP_MEMORY_SCOPE_AGENT)) < 32u) { if (++spins > (1u << 22)) break; __builtin_amdgcn_s_sleep(2); } }
        __builtin_amdgcn_fence(__ATOMIC_ACQUIRE, "agent");
        asm volatile("s_waitcnt vmcnt(0)" ::: "memory");
        f32x4 g[2][2];
#pragma unroll
        for (int bj = 0; bj < 2; ++bj) { g[bj][0] = *(const f32x4*)(gain + col0 + bj * 128); g[bj][1] = *(const f32x4*)(gain + col0 + bj * 128 + 4); }
#pragma unroll
        for (int ai = 0; ai < 2; ++ai)
#pragma unroll
            for (int m = 0; m < 4; ++m) {
                const int row = row0 + ai * 128 + m * 16; const float* xp = xch + (size_t)row * 16 + 4 * fq;
                float s = (__hip_atomic_load(xp + 0, __ATOMIC_RELAXED, __HIP_MEMORY_SCOPE_AGENT) + __hip_atomic_load(xp + 1, __ATOMIC_RELAXED, __HIP_MEMORY_SCOPE_AGENT))
                        + (__hip_atomic_load(xp + 2, __ATOMIC_RELAXED, __HIP_MEMORY_SCOPE_AGENT) + __hip_atomic_load(xp + 3, __ATOMIC_RELAXED, __HIP_MEMORY_SCOPE_AGENT));
                s += __shfl_xor(s, 16); s += __shfl_xor(s, 32);
                const float rstd = __builtin_amdgcn_rsqf(s * (1.0f / 1024.0f) + EPS);
#pragma unroll
                for (int bj = 0; bj < 2; ++bj) { const size_t off = (size_t)row * D + col0 + bj * 128;
                    *(f32x4*)(out + off) = A[ai][bj][m][0] * rstd * g[bj][0]; *(f32x4*)(out + off + 4) = A[ai][bj][m][1] * rstd * g[bj][1]; }
            }
    }
};

__device__ __forceinline__ void p0_item(const float* W, int ldw, int sc, const float* gain, int gain_lim, bf16_t* WT, int K, int n0, int k0, LAS float* scr, int lane) {
    float wv[32];
#pragma unroll
    for (int i = 0; i < 32; ++i) { const int k = k0 + 2 * i + (lane >> 5); wv[i] = W[(size_t)k * ldw + sc]; }
#pragma unroll
    for (int i = 0; i < 32; ++i) { const int kk = 2 * i + (lane >> 5), k = k0 + kk; float v = wv[i]; if (gain && k < gain_lim) v *= gain[k]; scr[kk * 33 + (lane & 31)] = v; }
    asm volatile("s_waitcnt lgkmcnt(0)" ::: "memory");
    const int c = lane & 7;
#pragma unroll
    for (int j = 0; j < 4; ++j) { const int n = (lane >> 3) + 8 * j; const LAS float* s = scr + (8 * c) * 33 + n;
        u32x4 o; o.x = pk2(s[0 * 33], s[1 * 33]); o.y = pk2(s[2 * 33], s[3 * 33]); o.z = pk2(s[4 * 33], s[5 * 33]); o.w = pk2(s[6 * 33], s[7 * 33]);
        *(u32x4*)(WT + (size_t)(n0 + n) * K + k0 + 8 * c) = o; }
    asm volatile("s_waitcnt lgkmcnt(0)" ::: "memory");
}
__device__ __forceinline__ int win_srccol(int n) {
    if (n < 640) { const int p = n & 63; if (p < 16) return (n - p) + ((p & 3) | ((p & 4) << 1) | ((p & 8) >> 1)); return n; }
    if (n >= 768 && n < 1792) { const int p = (n - 768) & 127, q = p >> 3, nn = (p >> 2) & 1, j = p & 3; return (n - p) + nn * 64 + 4 * q + j; }
    return n;
}
__device__ __forceinline__ void p0_prologue(const Params& p, LAS unsigned char* lds, int G) {
    const int tid = threadIdx.x, lane = tid & 63, wave = tid >> 6;
    LAS float* scr = (LAS float*)(lds + wave * 16384);
    const int gw = blockIdx.x * 8 + wave, NGW = G * 8;
    constexpr int I_GU = 16 * 176, I_D = 44 * 32, I_IN = 16 * 88, I_OUT = 16 * 32;
    constexpr int NITEMS = 2 * I_GU + 2 * I_D + I_IN + I_OUT;
    for (int it = gw; it < NITEMS; it += NGW) {
        int r = it;
        if (r < 2 * I_GU) {
            const int which = r / I_GU; r -= which * I_GU; const int nb = r % 176, kb = r / 176, n0 = nb * 32;
            const int pn = n0 >> 8, q = n0 & 255, bj = q >> 7, hid = pn * 128 + (q & 127) + (lane & 31);
            const float* W = which == 0 ? (bj ? p.in[4] : p.in[3]) : (bj ? p.in[15] : p.in[14]);
            p0_item(W, FF, hid, which == 0 ? nullptr : p.in[13], 1 << 30, (bf16_t*)(p.ws + (which == 0 ? WS_WGU1 : WS_WGU2)), D, n0, kb * 64, scr, lane); continue; }
        r -= 2 * I_GU;
        if (r < 2 * I_D) {
            const int which = r / I_D; r -= which * I_D; const int nb = r % 32, kb = r / 32, n0 = nb * 32;
            p0_item(which == 0 ? p.in[5] : p.in[16], D, n0 + (lane & 31), nullptr, 0, (bf16_t*)(p.ws + (which == 0 ? WS_WD1 : WS_WD2)), FF, n0, kb * 64, scr, lane); continue; }
        r -= 2 * I_D;
        if (r < I_IN) { const int nb = r % 88, kb = r / 88, n0 = nb * 32;
            p0_item(p.in[7], DIN, win_srccol(n0 + (lane & 31)), p.in[6], 1 << 30, (bf16_t*)(p.ws + WS_WIN), D, n0, kb * 64, scr, lane); continue; }
        r -= I_IN;
        { const int nb = r % 32, kb = r / 32, n0 = nb * 32;
            p0_item(p.in[12], D, n0 + (lane & 31), p.in[9], 512, (bf16_t*)(p.ws + WS_WOUT), D, n0, kb * 64, scr, lane); }
    }
    bf16_t* XN = (bf16_t*)(p.ws + WS_ACTA);
    const f32x4* gp = (const f32x4*)p.in[2] + lane;
    for (int rb = gw * 4; rb < T; rb += NGW * 4) {
        f32x4 v[4][4]; float s[4];
#pragma unroll
        for (int q = 0; q < 4; ++q) { const int row = rb + q; const float* xrow = row < TP ? p.in[0] + (size_t)row * D : p.in[1] + (size_t)(row - TP) * D; const f32x4* xr = (const f32x4*)xrow + lane;
#pragma unroll
            for (int j = 0; j < 4; ++j) v[q][j] = xr[64 * j]; }
#pragma unroll
        for (int q = 0; q < 4; ++q) { float a = 0.f;
#pragma unroll
            for (int j = 0; j < 4; ++j) a += (v[q][j][0] * v[q][j][0] + v[q][j][1] * v[q][j][1]) + (v[q][j][2] * v[q][j][2] + v[q][j][3] * v[q][j][3]);
            s[q] = a; }
#pragma unroll
        for (int q = 0; q < 4; ++q) { const float rstd = __builtin_amdgcn_rsqf(wave_sum(s[q]) * (1.f / D) + EPS);
            u32x2* o8 = (u32x2*)(XN + (size_t)(rb + q) * D) + lane;
#pragma unroll
            for (int j = 0; j < 4; ++j) { const f32x4 g = gp[64 * j]; u32x2 w; w.x = pk2(v[q][j][0] * rstd * g[0], v[q][j][1] * rstd * g[1]); w.y = pk2(v[q][j][2] * rstd * g[2], v[q][j][3] * rstd * g[3]); o8[64 * j] = w; } }
    }
}

#define MMA16(b, a, c) __builtin_amdgcn_mfma_f32_16x16x32_bf16((b), (a), (c), 0, 0, 0)
#define LDS16(ptr) (*(const LAS bf16x8*)(ptr))
typedef short v4i16_t __attribute__((ext_vector_type(4)));
__device__ __forceinline__ bf16x8 tr_frag(const LAS bf16_t* p, int pitch) {
    const v4i16_t lo = __builtin_amdgcn_ds_read_tr16_b64_v4i16((LAS v4i16_t*)p), hi = __builtin_amdgcn_ds_read_tr16_b64_v4i16((LAS v4i16_t*)(p + 4 * pitch));
    return (bf16x8){lo[0], lo[1], lo[2], lo[3], hi[0], hi[1], hi[2], hi[3]};
}

__device__ __forceinline__ void attn_phase(const Params& p, LAS unsigned char* lds, int G) {
    const int tid = threadIdx.x, lane = tid & 63, wave = tid >> 6, fr = lane & 15, fq = lane >> 4;
    const bf16_t* proj = (const bf16_t*)(p.ws + WS_HID); bf16_t* mix = (bf16_t*)(p.ws + WS_ACTB);
    LAS bf16_t* Kl = (LAS bf16_t*)lds;
    LAS bf16_t* Vl = (LAS bf16_t*)(lds + 18432);
    LAS bf16_t* Pl = (LAS bf16_t*)(lds + 36864 + wave * 9216);
    LAS float* stat = (LAS float*)(lds + 110592);
    const int h = wave, kvh = h >> 2;
    const float sink = p.in[8][h];
    const int skey = tid >> 3, sdch = tid & 7;
    const int trb = (8 * fq + (fr >> 2)) * 72 + 4 * (fr & 3);
    u32x4 pk[2], pv[2];
#define ATT_RANGE(r0, lo, hi) do { int ss_, se_; if ((r0) < TP) { ss_ = (r0) & ~8191; se_ = ss_ + 8192; } else { ss_ = TP + (((r0) - TP) & ~2047); se_ = ss_ + 2048; } \
        lo = ((r0) - 128 < ss_) ? ((ss_ - ((r0) - 128)) >> 6) : 0; hi = ((r0) + 128 >= se_) ? (((se_ - 64) - ((r0) - 128)) >> 6) : 4; } while (0)
#define ATT_ISSUE(r0, kb) do { const bf16_t* src_ = proj + (size_t)((r0) - 128 + 64 * (kb) + skey) * DIN + 512 + sdch * 8; \
        pk[0] = *(const u32x4*)src_; pv[0] = *(const u32x4*)(src_ + 128); pk[1] = *(const u32x4*)(src_ + 64); pv[1] = *(const u32x4*)(src_ + 192); } while (0)
    int unit = blockIdx.x;
    if (unit < T / 64) { int lo, hi; ATT_RANGE(unit * 64, lo, hi); ATT_ISSUE(unit * 64, lo); (void)hi; }
    for (; unit < T / 64; unit += G) {
        const int row0 = unit * 64; int kb_lo, kb_hi; ATT_RANGE(row0, kb_lo, kb_hi);
        bf16x8 qf[4][2];
#pragma unroll
        for (int m = 0; m < 4; ++m)
#pragma unroll
            for (int k = 0; k < 2; ++k) qf[m][k] = *(const bf16x8*)(proj + (size_t)(row0 + 16 * m + fr) * DIN + h * 64 + 32 * k + 8 * fq);
        f32x4 o[4][4]; float mrow[4], lrow[4];
#pragma unroll
        for (int m = 0; m < 4; ++m) { mrow[m] = sink; lrow[m] = 1.f;
#pragma unroll
            for (int n = 0; n < 4; ++n) o[m][n] = (f32x4){0.f, 0.f, 0.f, 0.f}; }
        for (int kb = kb_lo; kb <= kb_hi; ++kb) {
            const int kstart = row0 - 128 + 64 * kb;
            __syncthreads();
#pragma unroll
            for (int i = 0; i < 2; ++i) {
                *(LAS u32x4*)(Kl + (i * 64 + skey) * 72 + sdch * 8) = pk[i]; *(LAS u32x4*)(Vl + (i * 64 + skey) * 72 + sdch * 8) = pv[i];
            }
            __syncthreads();
            if (kb < kb_hi) { ATT_ISSUE(row0, kb + 1); }
            else if (unit + G < T / 64) { int lo2, hi2; ATT_RANGE((unit + G) * 64, lo2, hi2); ATT_ISSUE((unit + G) * 64, lo2); (void)hi2; }
            bf16x8 kf[4][2];
#pragma unroll
            for (int n = 0; n < 4; ++n) { kf[n][0] = LDS16(Kl + (kvh * 64 + 16 * n + fr) * 72 + 8 * fq); kf[n][1] = LDS16(Kl + (kvh * 64 + 16 * n + fr) * 72 + 32 + 8 * fq); }
            const bool edge = (kb == 0) || (kb == 4);
#pragma unroll
            for (int m = 0; m < 4; ++m) {
                f32x4 s[4];
#pragma unroll
                for (int n = 0; n < 4; ++n) { f32x4 a = (f32x4){0.f, 0.f, 0.f, 0.f}; a = MMA16(kf[n][0], qf[m][0], a); a = MMA16(kf[n][1], qf[m][1], a); s[n] = a; }
                const int i = row0 + 16 * m + fr; float mx = mrow[m];
                if (edge) {
#pragma unroll
                    for (int n = 0; n < 4; ++n)
#pragma unroll
                        for (int e = 0; e < 4; ++e) { const int j = kstart + 16 * n + 4 * fq + e, dlt = i - j; const bool valid = (dlt <= 128) && (dlt >= -128); s[n][e] = valid ? s[n][e] : -1e30f; }
                }
#pragma unroll
                for (int n = 0; n < 4; ++n) mx = fmaxf(fmaxf(mx, fmaxf(s[n][0], s[n][1])), fmaxf(s[n][2], s[n][3]));
                mx = fmaxf(mx, __shfl_xor(mx, 16)); mx = fmaxf(mx, __shfl_xor(mx, 32));
                const float alpha = fexp(mrow[m] - mx); mrow[m] = mx; float ps = 0.f; const float mxl = mx * 1.4426950408889634f;
#pragma unroll
                for (int n = 0; n < 4; ++n) {
                    f32x4 pvv;
#pragma unroll
                    for (int e = 0; e < 4; ++e) { pvv[e] = __builtin_amdgcn_exp2f(s[n][e] * 1.4426950408889634f - mxl); ps += pvv[e]; }
                    u32x2 w; w.x = cvt_pk_bf16(pvv[0], pvv[1]); w.y = cvt_pk_bf16(pvv[2], pvv[3]);
                    *(LAS u32x2*)(Pl + (16 * m + fr) * 72 + 16 * n + 4 * fq) = w;
                    o[m][n] = o[m][n] * alpha;
                }
                ps += __shfl_xor(ps, 16); ps += __shfl_xor(ps, 32);
                lrow[m] = lrow[m] * alpha + ps;
            }
            asm volatile("s_waitcnt lgkmcnt(0)" ::: "memory");
            {
#pragma unroll
                for (int k = 0; k < 2; ++k) {
                    bf16x8 pa[4], vb[4];
#pragma unroll
                    for (int m = 0; m < 4; ++m) pa[m] = LDS16(Pl + (16 * m + fr) * 72 + 32 * k + 8 * fq);
#pragma unroll
                    for (int n = 0; n < 4; ++n) vb[n] = tr_frag(Vl + (kvh * 64 + 32 * k) * 72 + trb + 16 * n, 72);
#pragma unroll
                    for (int n = 0; n < 4; ++n)
#pragma unroll
                        for (int m = 0; m < 4; ++m) o[m][n] = MMA16(vb[n], pa[m], o[m][n]);
                }
            }
        }
#pragma unroll
        for (int m = 0; m < 4; ++m) { const float inv = 1.0f / lrow[m]; float ss = 0.f;
#pragma unroll
            for (int n = 0; n < 4; ++n) { o[m][n] = o[m][n] * inv; ss += (o[m][n][0] * o[m][n][0] + o[m][n][1] * o[m][n][1]) + (o[m][n][2] * o[m][n][2] + o[m][n][3] * o[m][n][3]); }
            ss += __shfl_xor(ss, 16); ss += __shfl_xor(ss, 32);
            if (fq == 0) stat[h * 64 + 16 * m + fr] = ss; }
        __syncthreads();
#pragma unroll
        for (int m = 0; m < 4; ++m) { float tot = 0.f;
#pragma unroll
            for (int hh = 0; hh < 8; ++hh) tot += stat[hh * 64 + 16 * m + fr];
            const float rn = __builtin_amdgcn_rsqf(tot * (1.0f / 512.0f) + EPS);
#pragma unroll
            for (int n = 0; n < 4; ++n) { const f32x4 v = o[m][n] * rn; u32x2 w; w.x = cvt_pk_bf16(v[0], v[1]); w.y = cvt_pk_bf16(v[2], v[3]);
                *(u32x2*)(mix + (size_t)(row0 + 16 * m + fr) * D + h * 64 + 16 * n + 4 * fq) = w; } }
    }
#undef ATT_RANGE
#undef ATT_ISSUE
    __syncthreads();
}

__device__ __forceinline__ void ret_kv_phase(const Params& p, LAS unsigned char* lds, int G) {
    const int tid = threadIdx.x, lane = tid & 63, wave = tid >> 6, fr = lane & 15, fq = lane >> 4;
    const bf16_t* proj = (const bf16_t*)(p.ws + WS_HID); bf16_t* kvbuf = (bf16_t*)p.out;
    LAS bf16_t* Vl = (LAS bf16_t*)lds; LAS bf16_t* Kf = (LAS bf16_t*)(lds + 34816); LAS bf16_t* Kb = (LAS bf16_t*)(lds + 69632);
    const int stok = tid >> 4, sdch = tid & 15;
    const int trb = (8 * fq + (fr >> 2)) * 136 + 4 * (fr & 3);
    u32x4 pk[4], pv[4];
#define R1_ISSUE(u_) do { const bf16_t* src_ = proj + (size_t)(((u_) >> 2) * 128 + stok) * DIN + 1280 + ((u_) & 3) * 128 + sdch * 8; \
        _Pragma("unroll") for (int i_ = 0; i_ < 4; ++i_) { pk[i_] = *(const u32x4*)(src_ + (size_t)i_ * 32 * DIN); pv[i_] = *(const u32x4*)(src_ + 512 + (size_t)i_ * 32 * DIN); } } while (0)
    int unit = blockIdx.x;
    if (unit < (T / 128) * 4) R1_ISSUE(unit);
    for (; unit < (T / 128) * 4; unit += G) {
        const int c = unit >> 2, h = unit & 3;
        const float ldf = p.in[10][h], ldb = p.in[11][h];
        __syncthreads();
#pragma unroll
        for (int i = 0; i < 4; ++i) {
            const int tok = stok + 32 * i; const float wf = fexp(ldf * (float)(127 - tok)), wb = fexp(ldb * (float)tok);
            const unsigned kw[4] = {pk[i].x, pk[i].y, pk[i].z, pk[i].w}; u32x4 of, ob; unsigned fo[4], bo[4];
#pragma unroll
            for (int q = 0; q < 4; ++q) { const float k0 = bf2f((unsigned short)(kw[q] & 0xffffu)), k1 = bf2f((unsigned short)(kw[q] >> 16)); fo[q] = cvt_pk_bf16(k0 * wf, k1 * wf); bo[q] = cvt_pk_bf16(k0 * wb, k1 * wb); }
            of.x = fo[0]; of.y = fo[1]; of.z = fo[2]; of.w = fo[3]; ob.x = bo[0]; ob.y = bo[1]; ob.z = bo[2]; ob.w = bo[3];
            *(LAS u32x4*)(Vl + tok * 136 + sdch * 8) = pv[i]; *(LAS u32x4*)(Kf + tok * 136 + sdch * 8) = of; *(LAS u32x4*)(Kb + tok * 136 + sdch * 8) = ob;
        }
        __syncthreads();
        if (unit + G < (T / 128) * 4) R1_ISSUE(unit + G);
        const int dir = wave >> 2, mt0 = (wave & 3) * 2; LAS bf16_t* Kx = dir ? Kb : Kf;
        f32x4 acc[2][8];
#pragma unroll
        for (int mi = 0; mi < 2; ++mi)
#pragma unroll
            for (int n = 0; n < 8; ++n) acc[mi][n] = (f32x4){0.f, 0.f, 0.f, 0.f};
#pragma unroll
        for (int k = 0; k < 4; ++k) {
            const bf16x8 a0 = tr_frag(Vl + 32 * k * 136 + trb + (mt0 + 0) * 16, 136), a1 = tr_frag(Vl + 32 * k * 136 + trb + (mt0 + 1) * 16, 136);
            bf16x8 bf[8];
#pragma unroll
            for (int n = 0; n < 8; ++n) bf[n] = tr_frag(Kx + 32 * k * 136 + trb + 16 * n, 136);
#pragma unroll
            for (int n = 0; n < 8; ++n) { acc[0][n] = MMA16(bf[n], a0, acc[0][n]); acc[1][n] = MMA16(bf[n], a1, acc[1][n]); }
        }
        bf16_t* dst = kvbuf + ((size_t)(c * 4 + h) * 2 + dir) * 16384;
#pragma unroll
        for (int mi = 0; mi < 2; ++mi)
#pragma unroll
            for (int n = 0; n < 8; ++n) { u32x2 w; w.x = cvt_pk_bf16(acc[mi][n][0], acc[mi][n][1]); w.y = cvt_pk_bf16(acc[mi][n][2], acc[mi][n][3]);
                *(u32x2*)(dst + ((mt0 + mi) * 16 + fr) * 128 + 16 * n + 4 * fq) = w; }
    }
#undef R1_ISSUE
}

__device__ __forceinline__ void ret_scan_phase(const Params& p, int G) {
    bf16_t* kvbuf = (bf16_t*)p.out;
    const int nthr = G * NTHR;
    for (int t = blockIdx.x * NTHR + threadIdx.x; t < 131072; t += nthr) {
        {
            const int e4 = t & 4095, sdh = t >> 12, dir = sdh & 1, h = (sdh >> 1) & 3, b = sdh >> 3, c0 = 64 * b;
            const float Dk = fexp((dir ? p.in[11][h] : p.in[10][h]) * 128.0f);
            float st[4] = {0.f, 0.f, 0.f, 0.f};
            for (int sb = 0; sb < 64; sb += 16) {
                u32x2 v[16];
#pragma unroll
                for (int i = 0; i < 16; ++i) { const int c = dir ? (c0 + 63 - sb - i) : (c0 + sb + i); v[i] = *(const u32x2*)(kvbuf + ((size_t)(c * 4 + h) * 2 + dir) * 16384 + e4 * 4); }
#pragma unroll
                for (int i = 0; i < 16; ++i) { const int c = dir ? (c0 + 63 - sb - i) : (c0 + sb + i);
                    u32x2 w; w.x = pk2(st[0], st[1]); w.y = pk2(st[2], st[3]); *(u32x2*)(kvbuf + ((size_t)(c * 4 + h) * 2 + dir) * 16384 + e4 * 4) = w;
                    st[0] = st[0] * Dk + bf2f((unsigned short)(v[i].x & 0xffffu)); st[1] = st[1] * Dk + bf2f((unsigned short)(v[i].x >> 16));
                    st[2] = st[2] * Dk + bf2f((unsigned short)(v[i].y & 0xffffu)); st[3] = st[3] * Dk + bf2f((unsigned short)(v[i].y >> 16)); }
            }
        }
        {
            const int e8 = t & 2047, sdh = t >> 11, dir = sdh & 1, h = (sdh >> 1) & 3, b = sdh >> 3, c0 = 256 + 16 * b;
            const float Dk = fexp((dir ? p.in[11][h] : p.in[10][h]) * 128.0f);
            float st[8] = {0.f, 0.f, 0.f, 0.f, 0.f, 0.f, 0.f, 0.f};
            u32x4 v[16];
#pragma unroll
            for (int i = 0; i < 16; ++i) { const int c = dir ? (c0 + 15 - i) : (c0 + i); v[i] = *(const u32x4*)(kvbuf + ((size_t)(c * 4 + h) * 2 + dir) * 16384 + e8 * 8); }
#pragma unroll
            for (int i = 0; i < 16; ++i) { const int c = dir ? (c0 + 15 - i) : (c0 + i);
                u32x4 w; w.x = pk2(st[0], st[1]); w.y = pk2(st[2], st[3]); w.z = pk2(st[4], st[5]); w.w = pk2(st[6], st[7]); *(u32x4*)(kvbuf + ((size_t)(c * 4 + h) * 2 + dir) * 16384 + e8 * 8) = w;
                const unsigned vv[4] = {v[i].x, v[i].y, v[i].z, v[i].w};
#pragma unroll
                for (int q = 0; q < 4; ++q) { st[2 * q] = st[2 * q] * Dk + bf2f((unsigned short)(vv[q] & 0xffffu)); st[2 * q + 1] = st[2 * q + 1] * Dk + bf2f((unsigned short)(vv[q] >> 16)); }
            }
        }
    }
}

__device__ __forceinline__ void ret_out_phase(const Params& p, LAS unsigned char* lds, int G) {
    const int tid = threadIdx.x, lane = tid & 63, wave = tid >> 6, fr = lane & 15, fq = lane >> 4;
    const bf16_t* proj = (const bf16_t*)(p.ws + WS_HID); const bf16_t* kvbuf = (const bf16_t*)p.out; bf16_t* mix = (bf16_t*)(p.ws + WS_ACTB);
    LAS bf16_t* Ql = (LAS bf16_t*)lds; LAS bf16_t* Kl = (LAS bf16_t*)(lds + 34816); LAS bf16_t* Vl = (LAS bf16_t*)(lds + 69632); LAS bf16_t* Pl = (LAS bf16_t*)(lds + 104448);
    const int stok = tid >> 4, sdch = tid & 15;
    const int trb = (8 * fq + (fr >> 2)) * 136 + 4 * (fr & 3);
    const int il = 16 * wave + fr;
    u32x4 pq[4], pk[4], pv[4];
#define R3_ISSUE(u_) do { const bf16_t* src_ = proj + (size_t)(((u_) >> 2) * 128 + stok) * DIN + 768 + ((u_) & 3) * 128 + sdch * 8; \
        _Pragma("unroll") for (int i_ = 0; i_ < 4; ++i_) { pq[i_] = *(const u32x4*)(src_ + (size_t)i_ * 32 * DIN); pk[i_] = *(const u32x4*)(src_ + 512 + (size_t)i_ * 32 * DIN); pv[i_] = *(const u32x4*)(src_ + 1024 + (size_t)i_ * 32 * DIN); } } while (0)
    int unit = blockIdx.x;
    if (unit < (T / 128) * 4) R3_ISSUE(unit);
    for (; unit < (T / 128) * 4; unit += G) {
        const int c = unit >> 2, h = unit & 3, row0 = c * 128;
        const float ldf = p.in[10][h], ldb = p.in[11][h];
        __syncthreads();
#pragma unroll
        for (int i = 0; i < 4; ++i) {
            const int tok = stok + 32 * i;
            *(LAS u32x4*)(Ql + tok * 136 + sdch * 8) = pq[i]; *(LAS u32x4*)(Kl + tok * 136 + sdch * 8) = pk[i]; *(LAS u32x4*)(Vl + tok * 136 + sdch * 8) = pv[i];
        }
        __syncthreads();
        u32x4 sfr[4], sbr[4];
        {
            const bf16_t* sf = kvbuf + ((size_t)(c * 4 + h) * 2) * 16384 + stok * 128 + sdch * 8;
#pragma unroll
            for (int i = 0; i < 4; ++i) { sfr[i] = *(const u32x4*)(sf + i * 32 * 128); sbr[i] = *(const u32x4*)(sf + 16384 + i * 32 * 128); }
        }
        bf16x8 qa[4];
#pragma unroll
        for (int k = 0; k < 4; ++k) qa[k] = LDS16(Ql + il * 136 + 32 * k + 8 * fq);
        f32x4 o1[8];
        {
            f32x4 s[8];
#pragma unroll
            for (int n = 0; n < 8; ++n) s[n] = (f32x4){0.f, 0.f, 0.f, 0.f};
#pragma unroll
            for (int k = 0; k < 4; ++k) {
#pragma unroll
                for (int nh = 0; nh < 2; ++nh) { bf16x8 bf[4];
#pragma unroll
                    for (int n = 0; n < 4; ++n) bf[n] = LDS16(Kl + (16 * (4 * nh + n) + fr) * 136 + 32 * k + 8 * fq);
#pragma unroll
                    for (int n = 0; n < 4; ++n) s[4 * nh + n] = MMA16(bf[n], qa[k], s[4 * nh + n]); }
            }
#pragma unroll
            for (int n = 0; n < 8; ++n) { f32x4 pvv;
#pragma unroll
                for (int e = 0; e < 4; ++e) { const int j = 16 * n + 4 * fq + e, dlt = il - j; const float mk = dlt > 0 ? fexp(ldf * (float)dlt) : (dlt < 0 ? fexp(ldb * (float)(-dlt)) : 2.0f); pvv[e] = s[n][e] * mk; }
                u32x2 w; w.x = cvt_pk_bf16(pvv[0], pvv[1]); w.y = cvt_pk_bf16(pvv[2], pvv[3]);
                *(LAS u32x2*)(Pl + il * 136 + 16 * n + 4 * fq) = w; }
            asm volatile("s_waitcnt lgkmcnt(0)" ::: "memory");
            bf16x8 pa[4];
#pragma unroll
            for (int k = 0; k < 4; ++k) pa[k] = LDS16(Pl + il * 136 + 32 * k + 8 * fq);
#pragma unroll
            for (int n = 0; n < 8; ++n) o1[n] = (f32x4){0.f, 0.f, 0.f, 0.f};
#pragma unroll
            for (int k = 0; k < 4; ++k) {
#pragma unroll
                for (int nh = 0; nh < 2; ++nh) { bf16x8 bf[4];
#pragma unroll
                    for (int n = 0; n < 4; ++n) bf[n] = tr_frag(Vl + 32 * k * 136 + trb + 16 * (4 * nh + n), 136);
#pragma unroll
                    for (int n = 0; n < 4; ++n) o1[4 * nh + n] = MMA16(bf[n], pa[k], o1[4 * nh + n]); }
            }
        }
        __syncthreads();
#pragma unroll
        for (int i = 0; i < 4; ++i) { const int dv = stok + 32 * i; *(LAS u32x4*)(Kl + dv * 136 + sdch * 8) = sfr[i]; *(LAS u32x4*)(Pl + dv * 136 + sdch * 8) = sbr[i]; }
        __syncthreads();
        if (unit + G < (T / 128) * 4) R3_ISSUE(unit + G);
        u32x2 gv[8];
        { const bf16_t* gsrc = proj + (size_t)(row0 + il) * DIN + 2304 + h * 128 + 4 * fq;
#pragma unroll
            for (int n = 0; n < 8; ++n) gv[n] = *(const u32x2*)(gsrc + 16 * n); }
        {
            const float ef = fexp(ldf * (float)(il + 1)), eb = fexp(ldb * (float)(128 - il));
#pragma unroll
            for (int pass = 0; pass < 2; ++pass) {
                const LAS bf16_t* St = pass ? Pl : Kl; const float ew = pass ? eb : ef;
#pragma unroll
                for (int nh = 0; nh < 2; ++nh) {
                    f32x4 a[4];
#pragma unroll
                    for (int n = 0; n < 4; ++n) a[n] = (f32x4){0.f, 0.f, 0.f, 0.f};
#pragma unroll
                    for (int k = 0; k < 4; ++k) {
                        bf16x8 bf[4];
#pragma unroll
                        for (int n = 0; n < 4; ++n) bf[n] = LDS16(St + (16 * (4 * nh + n) + fr) * 136 + 32 * k + 8 * fq);
#pragma unroll
                        for (int n = 0; n < 4; ++n) a[n] = MMA16(bf[n], qa[k], a[n]);
                    }
#pragma unroll
                    for (int n = 0; n < 4; ++n) o1[4 * nh + n] = o1[4 * nh + n] + a[n] * ew;
                }
            }
        }
        float sm = 0.f;
#pragma unroll
        for (int n = 0; n < 8; ++n) sm += (o1[n][0] + o1[n][1]) + (o1[n][2] + o1[n][3]);
        sm += __shfl_xor(sm, 16); sm += __shfl_xor(sm, 32);
        const float mu = sm * (1.0f / 128.0f); float sq = 0.f;
#pragma unroll
        for (int n = 0; n < 8; ++n) { o1[n] = o1[n] - mu; sq += (o1[n][0] * o1[n][0] + o1[n][1] * o1[n][1]) + (o1[n][2] * o1[n][2] + o1[n][3] * o1[n][3]); }
        sq += __shfl_xor(sq, 16); sq += __shfl_xor(sq, 32);
        const float rs = __builtin_amdgcn_rsqf(sq * (1.0f / 128.0f) + EPS);
        bf16_t* dst = mix + (size_t)(row0 + il) * D + 512 + h * 128 + 4 * fq;
#pragma unroll
        for (int n = 0; n < 8; ++n) { const u32x2 g = gv[n];
            const float g0 = bf2f((unsigned short)(g.x & 0xffffu)), g1 = bf2f((unsigned short)(g.x >> 16)), g2 = bf2f((unsigned short)(g.y & 0xffffu)), g3 = bf2f((unsigned short)(g.y >> 16));
            u32x2 w; w.x = cvt_pk_bf16(silu_f(g0) * o1[n][0] * rs, silu_f(g1) * o1[n][1] * rs); w.y = cvt_pk_bf16(silu_f(g2) * o1[n][2] * rs, silu_f(g3) * o1[n][3] * rs);
            *(u32x2*)(dst + 16 * n) = w; }
    }
#undef R3_ISSUE
}

__device__ __forceinline__ void final_norm_phase(const Params& p, int G) {
    const int lane = threadIdx.x & 63, wave = threadIdx.x >> 6; const int gw = blockIdx.x * 8 + wave, NGW = G * 8;
    const f32x4* gp = (const f32x4*)p.in[17] + lane;
    for (int row = gw; row < T; row += NGW) {
        f32x4* xr = (f32x4*)(p.out + (size_t)row * D) + lane; f32x4 v[4]; float s = 0.f;
#pragma unroll
        for (int j = 0; j < 4; ++j) { v[j] = xr[64 * j]; s += (v[j][0] * v[j][0] + v[j][1] * v[j][1]) + (v[j][2] * v[j][2] + v[j][3] * v[j][3]); }
        const float rstd = __builtin_amdgcn_rsqf(wave_sum(s) * (1.f / D) + EPS);
#pragma unroll
        for (int j = 0; j < 4; ++j) xr[64 * j] = v[j] * rstd * gp[64 * j];
    }
}

#define XB_TMO      128
#define XB_XCNT(j)  (256  + 64 * (j))
#define XB_XSUB(j)  (1280 + 64 * (j))
#define XB_XGEN(j)  (2304 + 64 * (j))
#define XB_TOP      3328
#define XB_TOPGEN   3392
#define XCD_BAR_WORDS 3456
#define XB_SPIN_CAP (1u << 18)

__device__ __forceinline__ unsigned xb_ld(unsigned* p)              { return __hip_atomic_load(p, __ATOMIC_RELAXED, __HIP_MEMORY_SCOPE_AGENT); }
__device__ __forceinline__ unsigned xb_add(unsigned* p, unsigned v) { return __hip_atomic_fetch_add(p, v, __ATOMIC_RELAXED, __HIP_MEMORY_SCOPE_AGENT); }
__device__ __forceinline__ unsigned xb_xcc_id() { return (unsigned)__builtin_amdgcn_s_getreg((3 << 11) | 20) & 0xFu; }
#define XB_SPIN(cond, bar) do { unsigned _sp = 0; while (cond) { __builtin_amdgcn_s_sleep(1); \
    if ((++_sp & 255u) == 0u) { if (xb_ld(&(bar)[XB_TMO])) break; if (_sp > XB_SPIN_CAP) { atomicAdd(&(bar)[XB_TMO], 1u); break; } } } } while (0)

struct XcdBarrier {
    unsigned* bar; unsigned x;
    volatile LAS unsigned* st;
};

__device__ __forceinline__ XcdBarrier xcd_barrier_post(unsigned* bar, volatile LAS unsigned* st) {
    XcdBarrier b; b.bar = bar; b.x = xb_xcc_id(); b.st = st;
    if (threadIdx.x == 0) (void)xb_add(&bar[XB_XCNT(b.x)], 1u);
    return b;
}
__device__ __forceinline__ void xcd_barrier_complete(unsigned* bar, unsigned x, unsigned& nloc, unsigned& nx) {
    const unsigned G = gridDim.x * gridDim.y * gridDim.z;
    unsigned sum, cnt, mine, sp = 0u;
    for (;;) {
        sum = 0u; cnt = 0u; mine = 0u;
#pragma unroll
        for (unsigned j = 0; j < 16; ++j) { const unsigned c = xb_ld(&bar[XB_XCNT(j)]); sum += c; cnt += (c > 0u) ? 1u : 0u; mine = (j == x) ? c : mine; }
        if (sum == G) break;
        __builtin_amdgcn_s_sleep(1);
        if ((++sp & 255u) == 0u) { if (xb_ld(&bar[XB_TMO])) break; if (sp > XB_SPIN_CAP) { atomicAdd(&bar[XB_TMO], 1u); break; } }
    }
    nloc = mine > 0u ? mine : 1u; nx = cnt > 0u ? cnt : 1u;
}

__device__ __forceinline__ void xcd_barrier(const XcdBarrier& b) {
    asm volatile("s_waitcnt vmcnt(0)" ::: "memory");
    __syncthreads();
    if (threadIdx.x == 0) {
        unsigned* bar = b.bar;
        __builtin_amdgcn_s_waitcnt(0);
        unsigned nloc = b.st[0], nx = b.st[1];
        if (nloc == 0u) { xcd_barrier_complete(bar, b.x, nloc, nx); b.st[0] = nloc; b.st[1] = nx; }
        const unsigned old = xb_add(&bar[XB_XSUB(b.x)], 1u);
        const unsigned gen = old / nloc;
        if (old + 1u == (gen + 1u) * nloc) {
            __builtin_amdgcn_fence(__ATOMIC_RELEASE, "agent");
            asm volatile("s_waitcnt vmcnt(0)" ::: "memory");
            const unsigned og = xb_add(&bar[XB_TOP], 1u);
            const unsigned tg = og / nx;
            if (og + 1u == (tg + 1u) * nx) xb_add(&bar[XB_TOPGEN], 1u);
            else XB_SPIN(xb_ld(&bar[XB_TOPGEN]) == tg, bar);
            __builtin_amdgcn_fence(__ATOMIC_ACQUIRE, "agent");
            xb_add(&bar[XB_XGEN(b.x)], 1u);
            asm volatile("s_waitcnt vmcnt(0)" ::: "memory");
        } else {
            XB_SPIN(xb_ld(&bar[XB_XGEN(b.x)]) == gen, bar);
            __builtin_amdgcn_fence(__ATOMIC_ACQUIRE, "agent");
            asm volatile("s_waitcnt vmcnt(0)" ::: "memory");
        }
    }
    __syncthreads();
}

struct ChainOrder : pg8::StaticOrder {
    const unsigned* ready; unsigned need; unsigned* donew;
    __device__ __forceinline__ void a_ready(const pg8::Unit& u) const {
        if (ready) {
            if (threadIdx.x < 64) {
                unsigned spins = 0;
                while ((unsigned)__builtin_amdgcn_readfirstlane(__hip_atomic_load(ready + 64 * u.pm, __ATOMIC_RELAXED, __HIP_MEMORY_SCOPE_AGENT)) < need) { if (++spins > (1u << 22)) break; __builtin_amdgcn_s_sleep(2); }
                asm volatile("s_waitcnt vmcnt(0)" ::: "memory");
            }
            asm volatile("" ::: "memory"); __builtin_amdgcn_s_barrier(); asm volatile("" ::: "memory");
        }
    }
    mutable int pend;
    __device__ __forceinline__ void done(const pg8::Unit& u) const {
        if (donew) { if (pend >= 0 && (threadIdx.x & 63) == 0) __hip_atomic_fetch_add(donew + 64 * pend, 1u, __ATOMIC_RELAXED, __HIP_MEMORY_SCOPE_AGENT); pend = u.pm; }
    }
    __device__ __forceinline__ void flush() const {
        if (donew && pend >= 0) { asm volatile("s_waitcnt vmcnt(0)" ::: "memory"); if ((threadIdx.x & 63) == 0) __hip_atomic_fetch_add(donew + 64 * pend, 1u, __ATOMIC_RELAXED, __HIP_MEMORY_SCOPE_AGENT); pend = -1; }
    }
};

constexpr int NPHASE = 11;
__global__ void __launch_bounds__(NTHR, 2) mk_fwd(Params p) {
    extern __shared__ __attribute__((aligned(16))) unsigned char lds_raw[];
    LAS unsigned char* lds = (LAS unsigned char*)lds_raw;
    const int G = gridDim.x, lo = p.ph_lo, hi = p.ph_hi;
    cg::grid_group grid = cg::this_grid();
#define IN(k) (lo <= (k) && (k) < hi)
    volatile LAS unsigned* bst = (volatile LAS unsigned*)(lds + 147392);
    if (threadIdx.x == 0) { bst[0] = 0u; bst[1] = 0u; }
    __syncthreads();
    XcdBarrier xbar = xcd_barrier_post((unsigned*)(p.ws + WS_TABR) + 192 * 64, bst);
    unsigned* rankw = (unsigned*)(p.ws + WS_TABR) + 192 * 64 + 3584;
    if (threadIdx.x == 0) { const unsigned x = xb_xcc_id() & 7u; const unsigned r = __hip_atomic_fetch_add(rankw + 8 * x, 1u, __ATOMIC_RELAXED, __HIP_MEMORY_SCOPE_AGENT); bst[2] = r * 8u + x; }
    if (p.ph_lo < -1000) grid.sync();
#define SEAM(k) do { if (IN(k) && IN((k) + 1)) xcd_barrier(xbar); } while (0)
    bf16_t* ACTA = (bf16_t*)(p.ws + WS_ACTA); bf16_t* ACTB = (bf16_t*)(p.ws + WS_ACTB); bf16_t* HID = (bf16_t*)(p.ws + WS_HID);
    float* SSQ = (float*)(p.ws + WS_SSQ);
    if (IN(0)) { p0_prologue(p, lds, G); if (DUP & 1) { __syncthreads(); p0_prologue(p, lds, G); } }
    SEAM(0);
    int vc = (int)blockIdx.x; bool chain_ok = false;
    if (IN(0) && IN(1) && G == 256) {
        if (threadIdx.x == 0) { unsigned ok = 1u; for (int j = 0; j < 8; ++j) ok &= (__hip_atomic_load(rankw + 8 * j, __ATOMIC_RELAXED, __HIP_MEMORY_SCOPE_AGENT) == 32u) ? 1u : 0u; bst[3] = ok; }
        __syncthreads();
        if (bst[3]) { vc = (int)bst[2]; chain_ok = (MK_CHAIN != 0); }
    }
    unsigned* rdy = (unsigned*)(p.ws + WS_TABR) + 192 * 64 + 4096;
#define RDY(k) (rdy + (k) * 12288)
#define CHAIN_SEAM(k) do { if (chain_ok) { __builtin_amdgcn_fence(__ATOMIC_ACQUIRE, "agent"); asm volatile("s_waitcnt vmcnt(0)" ::: "memory"); __syncthreads(); } else SEAM(k); } while (0)
    if (IN(1)) {
        pg8::Gemm g{ACTA, (const bf16_t*)(p.ws + WS_WGU1), T, 2 * FF, D}; ChainOrder S; S.init(T, 2 * FF, G, vc); S.ready = nullptr; S.need = 0u; S.donew = chain_ok ? RDY(0) : nullptr; S.pend = -1;
        EpiSwiGLU<false> E{HID, nullptr};
        pg8::gemm_phase<EpiSwiGLU<false>, ChainOrder, PG8_ALIGN, PG8_SP2>(lds, g, S, E); S.flush();
    }
    CHAIN_SEAM(1);
    if (IN(2)) {
        pg8::Gemm g{HID, (const bf16_t*)(p.ws + WS_WD1), T, D, FF}; ChainOrder S; S.init(T, D, G, vc); S.ready = chain_ok ? RDY(0) : nullptr; S.need = 176u; S.donew = chain_ok ? RDY(1) : nullptr; S.pend = -1;
        EpiResid<false, false, true, true> E{p.in[0], p.in[1] - (size_t)TP * D, nullptr, nullptr, ACTA, SSQ, 0.5f};
        pg8::gemm_phase<EpiResid<false, false, true, true>, ChainOrder, PG8_ALIGN, PG8_SP2>(lds, g, S, E); S.flush();
    }
    CHAIN_SEAM(2);
    if (IN(3)) {
        pg8::Gemm g{ACTA, (const bf16_t*)(p.ws + WS_WIN), T, DIN, D}; ChainOrder S; S.init(T, DIN, G, vc); S.ready = chain_ok ? RDY(1) : nullptr; S.need = 32u; S.donew = nullptr; S.pend = -1;
        EpiProj E{HID, SSQ};
        pg8::gemm_phase<EpiProj, ChainOrder, PG8_ALIGN, PG8_SP2>(lds, g, S, E);
    }
    SEAM(3);
    if (IN(4)) { attn_phase(p, lds, G); ret_kv_phase(p, lds, G); if (DUP & 2) { attn_phase(p, lds, G); } if (DUP & 4) { ret_kv_phase(p, lds, G); } }
    SEAM(4);
    if (IN(5)) { ret_scan_phase(p, G); }
    SEAM(5);
    if (IN(6)) { ret_out_phase(p, lds, G); if (DUP & 8) { ret_out_phase(p, lds, G); } }
    SEAM(6);
    if (IN(7)) {
        __syncthreads();
        pg8::Gemm g{ACTB, (const bf16_t*)(p.ws + WS_WOUT), T, D, D}; ChainOrder S; S.init(T, D, G, vc); S.ready = nullptr; S.need = 0u; S.donew = chain_ok ? RDY(2) : nullptr; S.pend = -1;
        EpiResid<true, false, true, true> E{nullptr, nullptr, ACTA, nullptr, ACTA, SSQ, 1.0f};
        pg8::gemm_phase<EpiResid<true, false, true, true>, ChainOrder, PG8_ALIGN, PG8_SP2>(lds, g, S, E); S.flush();
    }
    CHAIN_SEAM(7);
    if (IN(8)) {
        pg8::Gemm g{ACTA, (const bf16_t*)(p.ws + WS_WGU2), T, 2 * FF, D}; ChainOrder S; S.init(T, 2 * FF, G, vc); S.ready = chain_ok ? RDY(2) : nullptr; S.need = 32u; S.donew = chain_ok ? RDY(3) : nullptr; S.pend = -1;
        EpiSwiGLU<true> E{HID, SSQ};
        pg8::gemm_phase<EpiSwiGLU<true>, ChainOrder, PG8_ALIGN, PG8_SP2>(lds, g, S, E); S.flush();
    }
    CHAIN_SEAM(8);
    const bool fused_final = (G == 256) && IN(10);
    if (IN(9)) {
        pg8::Gemm g{HID, (const bf16_t*)(p.ws + WS_WD2), T, D, FF}; ChainOrder S; S.init(T, D, G, vc); S.ready = chain_ok ? RDY(3) : nullptr; S.need = 176u; S.donew = nullptr; S.pend = -1;
        if (fused_final) { EpiFinal E{ACTA, p.out, SSQ, (unsigned*)(p.ws + WS_TABR), p.in[17]};
            pg8::gemm_phase<EpiFinal, ChainOrder, PG8_ALIGN, PG8_SP2>(lds, g, S, E); }
        else { EpiResid<true, true, false, false> E{nullptr, nullptr, ACTA, p.out, nullptr, nullptr, 0.5f};
            pg8::gemm_phase<EpiResid<true, true, false, false>, ChainOrder, PG8_ALIGN, PG8_SP2>(lds, g, S, E); }
    }
    if (!fused_final) { SEAM(9); if (IN(10)) { final_norm_phase(p, G); } }
#undef IN
#undef SEAM
}

extern "C" void kernel_launch(void* const* d_in, const int* in_sizes, int n_in, void* d_out, int out_size, void* d_ws, size_t ws_size, hipStream_t stream) {
    static int grid = 0;
    if (grid == 0) {
        if (n_in != 18 || out_size != T * D || ws_size < WS_END) { fprintf(stderr, "kernel_launch: unexpected shapes (n_in %d, out %d, ws %zu)\n", n_in, out_size, ws_size); grid = -1; return; }
        int dev = 0, cus = 0, per_cu = 0;
        if (hipGetDevice(&dev) != hipSuccess || hipDeviceGetAttribute(&cus, hipDeviceAttributeMultiprocessorCount, dev) != hipSuccess) { grid = -1; return; }
        if (hipFuncSetAttribute((const void*)mk_fwd, hipFuncAttributeMaxDynamicSharedMemorySize, LDS_BYTES) != hipSuccess) { fprintf(stderr, "kernel_launch: hipFuncSetAttribute failed\n"); grid = -1; return; }
        if (hipOccupancyMaxActiveBlocksPerMultiprocessor(&per_cu, (const void*)mk_fwd, NTHR, LDS_BYTES) != hipSuccess || per_cu < 1) { fprintf(stderr, "kernel_launch: occupancy query says %d\n", per_cu); per_cu = 1; }
        (void)hipGetLastError();
        grid = cus;
    }
    if (grid < 0) return;
    if (hipMemsetAsync((unsigned char*)d_ws + WS_TABR, 0, (192 * 64 + 4096 + 4 * 12288) * 4, stream) != hipSuccess) { fprintf(stderr, "kernel_launch: memset of the control words failed\n"); return; }
    Params a{};
    for (int i = 0; i < 18; ++i) a.in[i] = (const float*)d_in[i];
    a.out = (float*)d_out; a.ws = (unsigned char*)d_ws;
#if MK_ONE_LAUNCH
    a.ph_lo = 0; a.ph_hi = NPHASE;
    void* args[] = {&a};
    hipError_t e = hipLaunchCooperativeKernel((const void*)mk_fwd, dim3(grid), dim3(NTHR), args, LDS_BYTES, stream);
    if (e != hipSuccess) fprintf(stderr, "kernel_launch: cooperative launch failed: %s (grid %d)\n", hipGetErrorString(e), grid);
#else
    for (int ph = 0; ph < NPHASE; ++ph) { a.ph_lo = ph; a.ph_hi = ph + 1; hipLaunchKernelGGL(mk_fwd, dim3(grid), dim3(NTHR), LDS_BYTES, stream, a); }
#endif
}
```

```cpp
#include <hip/hip_runtime.h>
#include <hip/hip_cooperative_groups.h>
#include <cstdio>
#include <cstdint>
namespace cg = cooperative_groups;
#ifndef DUP
#define DUP 0
#endif
#ifndef MK_ONE_LAUNCH
#define MK_ONE_LAUNCH 1
#endif
namespace pg8 {
#define PG8_LAS __attribute__((address_space(3)))
typedef unsigned short bf16_t;
typedef short bf16x8 __attribute__((ext_vector_type(8)));
typedef float f32x4 __attribute__((ext_vector_type(4)));
typedef unsigned u32x4 __attribute__((ext_vector_type(4)));
constexpr int BM = 256, BK = 64, HALF = 128, HTB = HALF * BK * 2  , STAGE_BYTES = 8 * HTB, NXCD = 8, WGM = 8;

__host__ __device__ __forceinline__ int lds_byte(int r, int c) { const int st = (r >> 4) * 2 + (c >> 5), rr = r & 15, cc = c & 31, ob = rr * 64 + cc * 2; return st * 1024 + (ob ^ (((ob >> 9) & 1) << 5)); }
__host__ __device__ __forceinline__ void stage_rc(int b, int& R, int& C) { const int st = b / 1024, sb = b % 1024, swz = sb ^ (((sb >> 9) & 1) << 5); R = (st >> 1) * 16 + swz / 64; C = (st & 1) * 32 + (swz % 64) / 2; }
__host__ __device__ __forceinline__ int perm32(int rho) { const int n = rho >> 4, i = rho & 15; return 8 * (i >> 2) + 4 * n + (i & 3); }

struct Unit { int pm, pn; };
struct Gemm { const bf16_t* A; const bf16_t* Bt; int M, N, K; };

struct StaticOrder {
    int nM, nN, nwg, G, c;
    __host__ __device__ void init(int M, int N, int G_, int c_) { nM = M / BM; nN = N / BM; nwg = nM * nN; G = G_; c = c_; }
    __host__ __device__ bool next(int i, Unit& u) const {
        const long L = (long)i * G + c; if (L >= nwg) return false;
        int wgid = (int)L; { const int q = nwg / NXCD, r = nwg % NXCD, xcd = wgid % NXCD, off = wgid / NXCD; wgid = (xcd < r ? xcd * (q + 1) : r * (q + 1) + (xcd - r) * q) + off; }
        const int nig = WGM * nN, gid = wgid / nig, fm = gid * WGM, gsz = (nM - fm) < WGM ? (nM - fm) : WGM;
        u.pm = fm + ((wgid % nig) % gsz); u.pn = (wgid % nig) / gsz; return true;
    }
    __device__ __forceinline__ void a_ready(const Unit&) const {}
    __device__ __forceinline__ void done(const Unit&) const {}
};

__device__ __forceinline__ unsigned cvt_pk_bf16(float lo, float hi) { unsigned r; asm volatile("v_cvt_pk_bf16_f32 %0, %1, %2" : "=v"(r) : "v"(lo), "v"(hi)); return r; }
typedef float f32x2 __attribute__((ext_vector_type(2)));
template <class Epi, class Sched, bool ALIGN_EPI = false, bool SP2 = false>
__device__ __forceinline__ void gemm_phase(PG8_LAS unsigned char* lds, const Gemm g, const Sched& S, const Epi& E) {
    const int tid = threadIdx.x, wid = __builtin_amdgcn_readfirstlane(tid >> 6), lane = tid & 63, wr = wid >> 2, wc = wid & 3, fr = lane & 15, fq = lane >> 4;
    const int K = g.K, nt = K / BK;
    unsigned voffA[2], voffB[2];
#pragma unroll
    for (int i = 0; i < 2; ++i) { int R, C; stage_rc(tid * 16 + i * 8192, R, C); const int Rb = Epi::PERM ? ((R & ~31) + perm32(R & 31)) : R;
        voffA[i] = (unsigned)(R * K + C) * 2u; voffB[i] = (unsigned)(Rb * K + C) * 2u; }
    const size_t kstep = (size_t)(BK * 2);
    const size_t hstep = (size_t)HALF * K * 2;
    const size_t tstep = 2 * hstep;
    const unsigned ldsw = (unsigned)wid * 1024u;
    const int aoff = lds_byte(wr * 64 + fr, fq * 8), boff = lds_byte(wc * 32 + fr, fq * 8);
#define PG8_SA(b, h) (((b) * 2 + (h)) * HTB)
#define PG8_SB(b, h) ((4 + (b) * 2 + (h)) * HTB)
#define PG8_STAGE(bufoff, gbase, voff) do { _Pragma("unroll") for (int _i = 0; _i < 2; ++_i) \
        __builtin_amdgcn_global_load_lds((const unsigned*)((const char*)(gbase) + (voff)[_i]), (PG8_LAS unsigned*)(lds + (bufoff) + ldsw + _i * 8192), 16, 0, 0); } while (0)
#define PG8_LDA(dst, b, h) do { _Pragma("unroll") for (int m = 0; m < 4; ++m) _Pragma("unroll") for (int k = 0; k < 2; ++k) dst[m][k] = *(const PG8_LAS bf16x8*)(lds + PG8_SA(b, h) + aoff + m * 2048 + k * 1024); } while (0)
#define PG8_LDB(dst, b, h) do { _Pragma("unroll") for (int n = 0; n < 2; ++n) _Pragma("unroll") for (int k = 0; k < 2; ++k) dst[n][k] = *(const PG8_LAS bf16x8*)(lds + PG8_SB(b, h) + boff + n * 2048 + k * 1024); } while (0)
#define PG8_MMA(ai, bj, At, Bt) do { __builtin_amdgcn_s_setprio(1); _Pragma("unroll") for (int m = 0; m < 4; ++m) _Pragma("unroll") for (int n = 0; n < 2; ++n) _Pragma("unroll") for (int k = 0; k < 2; ++k) \
        acc[ai][bj][m][n] = __builtin_amdgcn_mfma_f32_16x16x32_bf16(Bt[n][k], At[m][k], acc[ai][bj][m][n], 0, 0, 0); __builtin_amdgcn_s_setprio(0); } while (0)
#define PG8_WAIT_V(n) asm volatile("s_waitcnt vmcnt(" #n ")" ::: "memory")
#define PG8_WAIT_L(n) asm volatile("s_waitcnt lgkmcnt(" #n ")" ::: "memory")
#define PG8_BAR __builtin_amdgcn_s_barrier()
#define PG8_SCHED __builtin_amdgcn_sched_barrier(0)
    Unit cur, nxt; int ui = 0;
    if (!S.next(0, cur)) return;
    f32x4 acc[2][2][4][2];
#pragma unroll
    for (int a = 0; a < 2; ++a)
#pragma unroll
        for (int b = 0; b < 2; ++b)
#pragma unroll
            for (int m = 0; m < 4; ++m)
#pragma unroll
                for (int n = 0; n < 2; ++n) acc[a][b][m][n] = (f32x4){0.f, 0.f, 0.f, 0.f};
    bf16x8 At[4][2], B0[2][2], B1[2][2];
    const char* cA = (const char*)g.A + (size_t)cur.pm * tstep; const char* cB = (const char*)g.Bt + (size_t)cur.pn * tstep;
    S.a_ready(cur);
    if constexpr (SP2) {
        PG8_STAGE(PG8_SB(0, 0), cB, voffB); PG8_STAGE(PG8_SB(0, 1), cB + hstep, voffB); PG8_STAGE(PG8_SA(0, 0), cA, voffA); PG8_STAGE(PG8_SA(0, 1), cA + hstep, voffA);
        if (wr == 1) PG8_BAR;
        PG8_WAIT_V(2); PG8_BAR;
        PG8_STAGE(PG8_SB(1, 0), cB + kstep, voffB); PG8_STAGE(PG8_SA(1, 0), cA + kstep, voffA); PG8_STAGE(PG8_SB(1, 1), cB + hstep + kstep, voffB);
        PG8_WAIT_V(6); PG8_BAR;
    } else {
        PG8_STAGE(PG8_SB(0, 0), cB, voffB); PG8_STAGE(PG8_SA(0, 0), cA, voffA); PG8_STAGE(PG8_SB(0, 1), cB + hstep, voffB); PG8_STAGE(PG8_SA(0, 1), cA + hstep, voffA);
        if (wr == 1) PG8_BAR;
        PG8_WAIT_V(4); PG8_BAR;
        PG8_STAGE(PG8_SB(1, 0), cB + kstep, voffB); PG8_STAGE(PG8_SA(1, 0), cA + kstep, voffA); PG8_STAGE(PG8_SB(1, 1), cB + hstep + kstep, voffB);
        PG8_WAIT_V(6); PG8_BAR;
    }
    for (;;) {
        const bool has_next = S.next(ui + 1, nxt);
        const char* nA = has_next ? (const char*)g.A + (size_t)nxt.pm * tstep : cA; const char* nB = has_next ? (const char*)g.Bt + (size_t)nxt.pn * tstep : cB;
        for (int t = 0; t < nt; t += 2) {
            const bool last = (t == nt - 2);
            const char* a1 = cA + (size_t)(t + 1) * kstep;
            const char* a2 = last ? nA : cA + (size_t)(t + 2) * kstep; const char* b2 = last ? nB : cB + (size_t)(t + 2) * kstep;
            const char* a3 = a2 + kstep; const char* b3 = b2 + kstep;
            if (last && has_next) S.a_ready(nxt);
            if constexpr (SP2) {
            PG8_LDB(B0, 0, 0); PG8_LDB(B1, 0, 1); PG8_SCHED; PG8_LDA(At, 0, 0); PG8_STAGE(PG8_SA(1, 1), a1 + hstep, voffA);
            PG8_WAIT_V(8); PG8_WAIT_L(0); PG8_BAR; PG8_MMA(0, 0, At, B0); PG8_MMA(0, 1, At, B1); PG8_BAR; PG8_SCHED;
            PG8_LDA(At, 0, 1); PG8_STAGE(PG8_SB(0, 0), b2, voffB); PG8_STAGE(PG8_SB(0, 1), b2 + hstep, voffB); PG8_STAGE(PG8_SA(0, 0), a2, voffA);
            PG8_WAIT_V(8); PG8_WAIT_L(0); PG8_BAR; PG8_MMA(1, 0, At, B0); PG8_MMA(1, 1, At, B1); PG8_BAR; PG8_SCHED;
            PG8_LDB(B0, 1, 0); PG8_LDB(B1, 1, 1); PG8_SCHED; PG8_LDA(At, 1, 0); PG8_STAGE(PG8_SA(0, 1), a2 + hstep, voffA);
            PG8_WAIT_V(8); PG8_WAIT_L(0); PG8_BAR; PG8_MMA(0, 0, At, B0); PG8_MMA(0, 1, At, B1); PG8_BAR; PG8_SCHED;
            PG8_LDA(At, 1, 1); PG8_STAGE(PG8_SB(1, 0), b3, voffB); PG8_STAGE(PG8_SB(1, 1), b3 + hstep, voffB); PG8_STAGE(PG8_SA(1, 0), a3, voffA);
            PG8_WAIT_V(8); PG8_WAIT_L(0); PG8_BAR; PG8_MMA(1, 0, At, B0); PG8_MMA(1, 1, At, B1); PG8_BAR; PG8_SCHED;
            } else {
            PG8_LDB(B0, 0, 0); PG8_SCHED; PG8_LDA(At, 0, 0); PG8_STAGE(PG8_SA(1, 1), a1 + hstep, voffA);
            PG8_WAIT_L(8); PG8_BAR; PG8_WAIT_L(0); PG8_MMA(0, 0, At, B0); PG8_BAR; PG8_SCHED;
            PG8_LDB(B1, 0, 1); PG8_STAGE(PG8_SB(0, 0), b2, voffB);
            PG8_BAR; PG8_WAIT_L(0); PG8_MMA(0, 1, At, B1); PG8_BAR;
            PG8_LDA(At, 0, 1); PG8_STAGE(PG8_SA(0, 0), a2, voffA);
            PG8_BAR; PG8_WAIT_L(0); PG8_MMA(1, 0, At, B0); PG8_BAR; PG8_SCHED;
            PG8_STAGE(PG8_SB(0, 1), b2 + hstep, voffB);
            PG8_WAIT_V(6); PG8_BAR; PG8_MMA(1, 1, At, B1); PG8_BAR;
            PG8_LDB(B0, 1, 0); PG8_SCHED; PG8_LDA(At, 1, 0); PG8_STAGE(PG8_SA(0, 1), a2 + hstep, voffA);
            PG8_WAIT_L(8); PG8_BAR; PG8_WAIT_L(0); PG8_MMA(0, 0, At, B0); PG8_BAR; PG8_SCHED;
            PG8_LDB(B1, 1, 1); PG8_STAGE(PG8_SB(1, 0), b3, voffB);
            PG8_BAR; PG8_WAIT_L(0); PG8_MMA(0, 1, At, B1); PG8_BAR;
            PG8_LDA(At, 1, 1); PG8_STAGE(PG8_SA(1, 0), a3, voffA);
            PG8_BAR; PG8_WAIT_L(0); PG8_MMA(1, 0, At, B0); PG8_BAR; PG8_SCHED;
            PG8_STAGE(PG8_SB(1, 1), b3 + hstep, voffB);
            PG8_WAIT_V(6); PG8_BAR; PG8_MMA(1, 1, At, B1); PG8_BAR;
            }
        }
        if constexpr (ALIGN_EPI) { if (wr == 0) PG8_BAR; }
        if constexpr (!Epi::AFTER_DRAIN) { E(acc, cur, wr, wc, fr, fq); S.done(cur); }
        if (!has_next) break;
#pragma unroll
        for (int a = 0; a < 2; ++a)
#pragma unroll
            for (int b = 0; b < 2; ++b)
#pragma unroll
                for (int m = 0; m < 4; ++m)
#pragma unroll
                    for (int n = 0; n < 2; ++n) acc[a][b][m][n] = (f32x4){0.f, 0.f, 0.f, 0.f};
        cur = nxt; cA = nA; cB = nB; ++ui;
        if constexpr (ALIGN_EPI) { if (wr == 1) PG8_BAR; }
    }
    PG8_WAIT_V(0);
    if constexpr (!ALIGN_EPI) { if (wr == 0) PG8_BAR; }
    PG8_BAR;
    if constexpr (Epi::AFTER_DRAIN) { E.fused(acc, cur, wr, wc, fr, fq, lds, wid, lane); S.done(cur); }
#undef PG8_SA
#undef PG8_SB
#undef PG8_STAGE
#undef PG8_LDA
#undef PG8_LDB
#undef PG8_MMA
#undef PG8_WAIT_V
#undef PG8_WAIT_L
#undef PG8_BAR
#undef PG8_SCHED
}
}

#ifndef PG8_SP2
#define PG8_SP2 true
#endif
#ifndef PG8_ALIGN
#define PG8_ALIGN true
#endif

#define LAS __attribute__((address_space(3)))
using pg8::bf16_t; using pg8::bf16x8; using pg8::f32x4; using pg8::u32x4;
typedef float f32x2_t __attribute__((ext_vector_type(2)));
typedef __bf16 bf16x2_t __attribute__((ext_vector_type(2)));
__device__ __forceinline__ unsigned cvt_pk_bf16(float lo, float hi) { f32x2_t v = {lo, hi}; bf16x2_t b = __builtin_convertvector(v, bf16x2_t); return __builtin_bit_cast(unsigned, b); }
typedef unsigned u32x2 __attribute__((ext_vector_type(2)));
constexpr int T = 49152, TP = 32768, D = 1024, FF = 2816, DIN = 2816, NTHR = 512;
constexpr float EPS = 1e-6f;
constexpr size_t MiB = 1u << 20;
constexpr size_t WU = (size_t)2816 * 1024 * 2;
constexpr size_t WS_WGU1 = 0, WS_WD1 = 2 * WU, WS_WIN = 3 * WU, WS_WOUT = 4 * WU, WS_WGU2 = WS_WOUT + 2 * MiB, WS_WD2 = WS_WGU2 + 2 * WU;
constexpr size_t WS_TABR = WS_WD2 + WU, WS_TABA = WS_TABR + 8192 * 64 * 8, WS_SSQ = WS_TABA + 8192 * 8 * 8;
constexpr size_t WS_ACTA = 48 * MiB, WS_ACTB = 144 * MiB, WS_HID = 240 * MiB, WS_END = 504 * MiB;
static_assert(WS_SSQ + (size_t)T * 16 * 4 <= WS_ACTA, "ws map");
static_assert(WS_ACTA + (size_t)T * D * 2 <= WS_ACTB && WS_ACTB + (size_t)T * D * 2 <= WS_HID && WS_HID + (size_t)T * FF * 2 <= WS_END, "ws map");
constexpr int LDS_BYTES = 147456;

struct Params { const float* in[18]; float* out; unsigned char* ws; int ph_lo, ph_hi; };

__device__ __forceinline__ float silu_f(float x) { return x * __builtin_amdgcn_rcpf(1.0f + __builtin_amdgcn_exp2f(-1.4426950408889634f * x)); }
__device__ __forceinline__ float fexp(float x) { return __builtin_amdgcn_exp2f(1.4426950408889634f * x); }
__device__ __forceinline__ float bf2f(unsigned short b) { return __builtin_bit_cast(float, ((unsigned)b) << 16); }
__device__ __forceinline__ unsigned f2bf(float f) { unsigned u = __builtin_bit_cast(unsigned, f); return (u + 0x7fffu + ((u >> 16) & 1u)) >> 16; }
__device__ __forceinline__ unsigned pk2(float lo, float hi) { return f2bf(lo) | (f2bf(hi) << 16); }
__device__ __forceinline__ float wave_sum(float v) {
#pragma unroll
    for (int o = 1; o < 64; o <<= 1) v += __shfl_xor(v, o);
    return v;
}
__device__ __forceinline__ int row_pos(int row) { return row < TP ? (row & 8191) : (row & 2047); }
__device__ __forceinline__ float row_rstd(const float* ssq, int row, int fq) {
    const f32x4 p = *(const f32x4*)(ssq + (size_t)row * 16 + 4 * fq);
    float s = (p[0] + p[1]) + (p[2] + p[3]);
    s += __shfl_xor(s, 16); s += __shfl_xor(s, 32);
    return __builtin_amdgcn_rsqf(s * (1.0f / 1024.0f) + EPS);
}

__device__ __forceinline__ void row_rstd8(const float* ssq, int row0, int fq, float (&r)[8]) {
    f32x4 pp[8];
#pragma unroll
    for (int q = 0; q < 8; ++q) pp[q] = *(const f32x4*)(ssq + (size_t)(row0 + (q >> 2) * 128 + (q & 3) * 16) * 16 + 4 * fq);
#pragma unroll
    for (int q = 0; q < 8; ++q) { float s = (pp[q][0] + pp[q][1]) + (pp[q][2] + pp[q][3]); s += __shfl_xor(s, 16); s += __shfl_xor(s, 32); r[q] = __builtin_amdgcn_rsqf(s * (1.0f / 1024.0f) + EPS); }
}
template <bool SCALE> struct EpiSwiGLU {
    static constexpr bool PERM = true, AFTER_DRAIN = false;
    bf16_t* O; const float* ssq;
    __device__ __forceinline__ void operator()(const f32x4 (&acc)[2][2][4][2], const pg8::Unit& u, int wr, int wc, int fr, int fq) const {
        const int row0 = u.pm * 256 + wr * 64 + fr, col0 = u.pn * 128 + wc * 32 + 8 * fq;
        float rr[8]; if (SCALE) row_rstd8(ssq, row0, fq, rr);
#pragma unroll
        for (int ai = 0; ai < 2; ++ai)
#pragma unroll
            for (int m = 0; m < 4; ++m) {
                const int row = row0 + ai * 128 + m * 16;
                float r = 1.f; if (SCALE) r = rr[ai * 4 + m];
                const f32x4 g0 = acc[ai][0][m][0] * r, g1 = acc[ai][0][m][1] * r, u0 = acc[ai][1][m][0] * r, u1 = acc[ai][1][m][1] * r;
                u32x4 w;
                f32x4 h0, h1;
#pragma unroll
                for (int j = 0; j < 4; ++j) { h0[j] = g0[j] * u0[j] * __builtin_amdgcn_rcpf(1.0f + __builtin_amdgcn_exp2f(-g0[j])); h1[j] = g1[j] * u1[j] * __builtin_amdgcn_rcpf(1.0f + __builtin_amdgcn_exp2f(-g1[j])); }
                w.x = cvt_pk_bf16(h0[0], h0[1]); w.y = cvt_pk_bf16(h0[2], h0[3]); w.z = cvt_pk_bf16(h1[0], h1[1]); w.w = cvt_pk_bf16(h1[2], h1[3]);
                *(u32x4*)(O + (size_t)row * FF + col0) = w;
            }
    }
};
template <bool RB, bool OF, bool OB, bool WS> struct EpiResid {
    static constexpr bool PERM = true, AFTER_DRAIN = false;
    const float* res0; const float* res1; const bf16_t* resb; float* out; bf16_t* outb; float* ssq; float scale;
    __device__ __forceinline__ void operator()(const f32x4 (&acc)[2][2][4][2], const pg8::Unit& u, int wr, int wc, int fr, int fq) const {
        const int row0 = u.pm * 256 + wr * 64 + fr, col0 = u.pn * 256 + wc * 32 + 8 * fq;
        const float* rb = (u.pm * 256 < TP) ? res0 : res1;
#pragma unroll
        for (int ai = 0; ai < 2; ++ai)
#pragma unroll
            for (int mp = 0; mp < 2; ++mp) {
                f32x4 x[2][2][2];
#pragma unroll
                for (int mq = 0; mq < 2; ++mq)
#pragma unroll
                    for (int bj = 0; bj < 2; ++bj) { const size_t off = (size_t)(row0 + ai * 128 + (2 * mp + mq) * 16) * D + col0 + bj * 128;
                        if (RB) { const u32x4 r = *(const u32x4*)(resb + off);
                            x[mq][bj][0] = (f32x4){__builtin_bit_cast(float, r.x << 16), __builtin_bit_cast(float, r.x & 0xffff0000u), __builtin_bit_cast(float, r.y << 16), __builtin_bit_cast(float, r.y & 0xffff0000u)};
                            x[mq][bj][1] = (f32x4){__builtin_bit_cast(float, r.z << 16), __builtin_bit_cast(float, r.z & 0xffff0000u), __builtin_bit_cast(float, r.w << 16), __builtin_bit_cast(float, r.w & 0xffff0000u)}; }
                        else { x[mq][bj][0] = *(const f32x4*)(rb + off); x[mq][bj][1] = *(const f32x4*)(rb + off + 4); } }
#pragma unroll
                for (int mq = 0; mq < 2; ++mq) { const int m = 2 * mp + mq, row = row0 + ai * 128 + m * 16; float ss = 0.f;
#pragma unroll
                    for (int bj = 0; bj < 2; ++bj) { const size_t off = (size_t)row * D + col0 + bj * 128;
                        const f32x4 v0 = x[mq][bj][0] + acc[ai][bj][m][0] * scale, v1 = x[mq][bj][1] + acc[ai][bj][m][1] * scale;
                        if (OF) { *(f32x4*)(out + off) = v0; *(f32x4*)(out + off + 4) = v1; }
                        if (OB) { u32x4 w; w.x = cvt_pk_bf16(v0[0], v0[1]); w.y = cvt_pk_bf16(v0[2], v0[3]); w.z = cvt_pk_bf16(v1[0], v1[1]); w.w = cvt_pk_bf16(v1[2], v1[3]); *(u32x4*)(outb + off) = w; }
                        if (WS) ss += ((v0[0] * v0[0] + v0[1] * v0[1]) + (v0[2] * v0[2] + v0[3] * v0[3])) + ((v1[0] * v1[0] + v1[1] * v1[1]) + (v1[2] * v1[2] + v1[3] * v1[3])); }
                    if (WS) { ss += __shfl_xor(ss, 16); ss += __shfl_xor(ss, 32); if (fq == 0) ssq[(size_t)row * 16 + u.pn * 4 + wc] = ss; } }
            }
    }
};
struct EpiProj {
    static constexpr bool PERM = true, AFTER_DRAIN = false;
    bf16_t* O; const float* ssq;
    __device__ __forceinline__ void operator()(const f32x4 (&acc)[2][2][4][2], const pg8::Unit& u, int wr, int wc, int fr, int fq) const {
        const int row0 = u.pm * 256 + wr * 64 + fr, col0 = u.pn * 256 + wc * 32 + 8 * fq;
        float rr[8]; row_rstd8(ssq, row0, fq, rr);
        float fa[4], fr4[4];
#pragma unroll
        for (int j = 0; j < 4; ++j) { fa[j] = 0.15915494309189535f * exp2f(-18.931568569324174f * ((float)(2 * (4 * fq + j)) * (1.0f / 16.0f)));
                                      fr4[j] = 0.15915494309189535f * exp2f(-13.287712379549449f * ((float)(16 * wc + 4 * fq + j) * (1.0f / 63.0f))); }
#pragma unroll
        for (int ai = 0; ai < 2; ++ai)
#pragma unroll
            for (int m = 0; m < 4; ++m) {
                const int row = row0 + ai * 128 + m * 16; const float pos = (float)row_pos(row);
                const float r = rr[ai * 4 + m];
#pragma unroll
                for (int bj = 0; bj < 2; ++bj) {
                    const int seg = 2 * u.pn + bj;
                    float sc = r; if (seg < 4) sc = r * 0.125f; if (seg >= 10 && seg < 14) sc = r * 0.08838834764831845f;
                    f32x4 v0 = acc[ai][bj][m][0] * sc, v1 = acc[ai][bj][m][1] * sc;
                    const bool rotA = (seg <= 4) && ((wc & 1) == 0) && (fq < 2), rotR = (seg >= 6 && seg < 14);
                    if (seg <= 4 || rotR) {
#pragma unroll
                        for (int j = 0; j < 4; ++j) { const float rev = pos * (rotR ? fr4[j] : fa[j]), fv = rev - __builtin_floorf(rev);
                            const float c = (rotA || rotR) ? __builtin_amdgcn_cosf(fv) : 1.0f, sn = (rotA || rotR) ? __builtin_amdgcn_sinf(fv) : 0.0f;
                            const float x1 = v0[j], x2 = v1[j]; v0[j] = x1 * c - x2 * sn; v1[j] = x2 * c + x1 * sn; }
                    }
                    u32x4 w; w.x = cvt_pk_bf16(v0[0], v0[1]); w.y = cvt_pk_bf16(v0[2], v0[3]); w.z = cvt_pk_bf16(v1[0], v1[1]); w.w = cvt_pk_bf16(v1[2], v1[3]);
                    *(u32x4*)(O + (size_t)row * DIN + col0 + bj * 128) = w;
                }
            }
    }
};

struct EpiFinal {
    static constexpr bool PERM = true, AFTER_DRAIN = false;
    const bf16_t* resb; float* out; float* xch; unsigned* cnt; const float* gain;
    __device__ __forceinline__ void operator()(const f32x4 (&acc_)[2][2][4][2], const pg8::Unit& u, int wr, int wc, int fr, int fq) const {
        f32x4 (&A)[2][2][4][2] = const_cast<f32x4 (&)[2][2][4][2]>(acc_);
        const int row0 = u.pm * 256 + wr * 64 + fr, col0 = u.pn * 256 + wc * 32 + 8 * fq, lane = threadIdx.x & 63;
#pragma unroll
        for (int ai = 0; ai < 2; ++ai)
#pragma unroll
            for (int m = 0; m < 4; ++m) {
                const int row = row0 + ai * 128 + m * 16; float ss = 0.f;
#pragma unroll
                for (int bj = 0; bj < 2; ++bj) {
                    const size_t off = (size_t)row * D + col0 + bj * 128;
                    const u32x4 r = *(const u32x4*)(resb + off);
                    const f32x4 x0 = (f32x4){__builtin_bit_cast(float, r.x << 16), __builtin_bit_cast(float, r.x & 0xffff0000u), __builtin_bit_cast(float, r.y << 16), __builtin_bit_cast(float, r.y & 0xffff0000u)};
                    const f32x4 x1 = (f32x4){__builtin_bit_cast(float, r.z << 16), __builtin_bit_cast(float, r.z & 0xffff0000u), __builtin_bit_cast(float, r.w << 16), __builtin_bit_cast(float, r.w & 0xffff0000u)};
                    const f32x4 v0 = x0 + A[ai][bj][m][0] * 0.5f, v1 = x1 + A[ai][bj][m][1] * 0.5f;
                    A[ai][bj][m][0] = v0; A[ai][bj][m][1] = v1;
                    ss += ((v0[0] * v0[0] + v0[1] * v0[1]) + (v0[2] * v0[2] + v0[3] * v0[3])) + ((v1[0] * v1[0] + v1[1] * v1[1]) + (v1[2] * v1[2] + v1[3] * v1[3]));
                }
                ss += __shfl_xor(ss, 16); ss += __shfl_xor(ss, 32);
                if (fq == 0) __hip_atomic_store(xch + (size_t)row * 16 + u.pn * 4 + wc, ss, __ATOMIC_RELAXED, __HIP_MEMORY_SCOPE_AGENT);
            }
        asm volatile("s_waitcnt vmcnt(0)" ::: "memory");
        unsigned* cw = cnt + 64 * u.pm;
        if (lane == 0) __hip_atomic_fetch_add(cw, 1u, __ATOMIC_RELAXED, __HIP_MEMORY_SCOPE_AGENT);
        { unsigned spins = 0;
          while ((unsigned)__builtin_amdgcn_readfirstlane(__hip_atomic_load(cw, __ATOMIC_RELAXED, __HIP_MEMORY_SCOPE_AGENT)) < 32u) { if (++spins > (1u << 22)) break; __builtin_amdgcn_s_sleep(2); } }
        __builtin_amdgcn_fence(__ATOMIC_ACQUIRE, "agent");
        asm volatile("s_waitcnt vmcnt(0)" ::: "memory");
        f32x4 g[2][2];
#pragma unroll
        for (int bj = 0; bj < 2; ++bj) { g[bj][0] = *(const f32x4*)(gain + col0 + bj * 128); g[bj][1] = *(const f32x4*)(gain + col0 + bj * 128 + 4); }
#pragma unroll
        for (int ai = 0; ai < 2; ++ai)
#pragma unroll
            for (int m = 0; m < 4; ++m) {
                const int row = row0 + ai * 128 + m * 16; const float* xp = xch + (size_t)row * 16 + 4 * fq;
                float s = (__hip_atomic_load(xp + 0, __ATOMIC_RELAXED, __HIP_MEMORY_SCOPE_AGENT) + __hip_atomic_load(xp + 1, __ATOMIC_RELAXED, __HIP_MEMORY_SCOPE_AGENT))
                        + (__hip_atomic_load(xp + 2, __ATOMIC_RELAXED, __HIP_MEMORY_SCOPE_AGENT) + __hip_atomic_load(xp + 3, __ATOMIC_RELAXED, __HIP_MEMORY_SCOPE_AGENT));
                s += __shfl_xor(s, 16); s += __shfl_xor(s, 32);
                const float rstd = __builtin_amdgcn_rsqf(s * (1.0f / 1024.0f) + EPS);
#pragma unroll
                for (int bj = 0; bj < 2; ++bj) { const size_t off = (size_t)row * D + col0 + bj * 128;
                    *(f32x4*)(out + off) = A[ai][bj][m][0] * rstd * g[bj][0]; *(f32x4*)(out + off + 4) = A[ai][bj][m][1] * rstd * g[bj][1]; }
            }
    }
};

__device__ __forceinline__ void p0_item(const float* W, int ldw, int sc, const float* gain, int gain_lim, bf16_t* WT, int K, int n0, int k0, LAS float* scr, int lane, float cs = 1.0f) {
    float wv[32];
#pragma unroll
    for (int i = 0; i < 32; ++i) { const int k = k0 + 2 * i + (lane >> 5); wv[i] = W[(size_t)k * ldw + sc]; }
#pragma unroll
    for (int i = 0; i < 32; ++i) { const int kk = 2 * i + (lane >> 5), k = k0 + kk; float v = wv[i] * cs; if (gain && k < gain_lim) v *= gain[k]; scr[kk * 33 + (lane & 31)] = v; }
    asm volatile("s_waitcnt lgkmcnt(0)" ::: "memory");
    const int c = lane & 7;
#pragma unroll
    for (int j = 0; j < 4; ++j) { const int n = (lane >> 3) + 8 * j; const LAS float* s = scr + (8 * c) * 33 + n;
        u32x4 o; o.x = pk2(s[0 * 33], s[1 * 33]); o.y = pk2(s[2 * 33], s[3 * 33]); o.z = pk2(s[4 * 33], s[5 * 33]); o.w = pk2(s[6 * 33], s[7 * 33]);
        *(u32x4*)(WT + (size_t)(n0 + n) * K + k0 + 8 * c) = o; }
    asm volatile("s_waitcnt lgkmcnt(0)" ::: "memory");
}
__device__ __forceinline__ int win_srccol(int n) {
    if (n < 640) { const int p = n & 63; if (p < 16) return (n - p) + ((p & 3) | ((p & 4) << 1) | ((p & 8) >> 1)); return n; }
    if (n >= 768 && n < 1792) { const int p = (n - 768) & 127, q = p >> 3, nn = (p >> 2) & 1, j = p & 3; return (n - p) + nn * 64 + 4 * q + j; }
    return n;
}
__device__ __forceinline__ void p0_prologue(const Params& p, LAS unsigned char* lds, int G) {
    const int tid = threadIdx.x, lane = tid & 63, wave = tid >> 6;
    LAS float* scr = (LAS float*)(lds + wave * 16384);
    const int gw = blockIdx.x * 8 + wave, NGW = G * 8;
    constexpr int I_GU = 16 * 176, I_D = 44 * 32, I_IN = 16 * 88, I_OUT = 16 * 32;
    constexpr int NITEMS = 2 * I_GU + 2 * I_D + I_IN + I_OUT;
    for (int it = gw; it < NITEMS; it += NGW) {
        int r = it;
        if (r < 2 * I_GU) {
            const int which = r / I_GU; r -= which * I_GU; const int nb = r % 176, kb = r / 176, n0 = nb * 32;
            const int pn = n0 >> 8, q = n0 & 255, bj = q >> 7, hid = pn * 128 + (q & 127) + (lane & 31);
            const float* W = which == 0 ? (bj ? p.in[4] : p.in[3]) : (bj ? p.in[15] : p.in[14]);
            p0_item(W, FF, hid, which == 0 ? nullptr : p.in[13], 1 << 30, (bf16_t*)(p.ws + (which == 0 ? WS_WGU1 : WS_WGU2)), D, n0, kb * 64, scr, lane, bj ? 0.6931471805599453f : 1.4426950408889634f); continue; }
        r -= 2 * I_GU;
        if (r < 2 * I_D) {
            const int which = r / I_D; r -= which * I_D; const int nb = r % 32, kb = r / 32, n0 = nb * 32;
            p0_item(which == 0 ? p.in[5] : p.in[16], D, n0 + (lane & 31), nullptr, 0, (bf16_t*)(p.ws + (which == 0 ? WS_WD1 : WS_WD2)), FF, n0, kb * 64, scr, lane); continue; }
        r -= 2 * I_D;
        if (r < I_IN) { const int nb = r % 88, kb = r / 88, n0 = nb * 32;
            p0_item(p.in[7], DIN, win_srccol(n0 + (lane & 31)), p.in[6], 1 << 30, (bf16_t*)(p.ws + WS_WIN), D, n0, kb * 64, scr, lane); continue; }
        r -= I_IN;
        { const int nb = r % 32, kb = r / 32, n0 = nb * 32;
            p0_item(p.in[12], D, n0 + (lane & 31), p.in[9], 512, (bf16_t*)(p.ws + WS_WOUT), D, n0, kb * 64, scr, lane); }
    }
    bf16_t* XN = (bf16_t*)(p.ws + WS_ACTA);
    const f32x4* gp = (const f32x4*)p.in[2] + lane;
    for (int rb = gw * 4; rb < T; rb += NGW * 4) {
        f32x4 v[4][4]; float s[4];
#pragma unroll
        for (int q = 0; q < 4; ++q) { const int row = rb + q; const float* xrow = row < TP ? p.in[0] + (size_t)row * D : p.in[1] + (size_t)(row - TP) * D; const f32x4* xr = (const f32x4*)xrow + lane;
#pragma unroll
            for (int j = 0; j < 4; ++j) v[q][j] = xr[64 * j]; }
#pragma unroll
        for (int q = 0; q < 4; ++q) { float a = 0.f;
#pragma unroll
            for (int j = 0; j < 4; ++j) a += (v[q][j][0] * v[q][j][0] + v[q][j][1] * v[q][j][1]) + (v[q][j][2] * v[q][j][2] + v[q][j][3] * v[q][j][3]);
            s[q] = a; }
#pragma unroll
        for (int q = 0; q < 4; ++q) { const float rstd = __builtin_amdgcn_rsqf(wave_sum(s[q]) * (1.f / D) + EPS);
            u32x2* o8 = (u32x2*)(XN + (size_t)(rb + q) * D) + lane;
#pragma unroll
            for (int j = 0; j < 4; ++j) { const f32x4 g = gp[64 * j]; u32x2 w; w.x = pk2(v[q][j][0] * rstd * g[0], v[q][j][1] * rstd * g[1]); w.y = pk2(v[q][j][2] * rstd * g[2], v[q][j][3] * rstd * g[3]); o8[64 * j] = w; } }
    }
}

#define MMA16(b, a, c) __builtin_amdgcn_mfma_f32_16x16x32_bf16((b), (a), (c), 0, 0, 0)
#define LDS16(ptr) (*(const LAS bf16x8*)(ptr))
typedef short v4i16_t __attribute__((ext_vector_type(4)));
__device__ __forceinline__ bf16x8 tr_frag(const LAS bf16_t* p, int pitch) {
    const v4i16_t lo = __builtin_amdgcn_ds_read_tr16_b64_v4i16((LAS v4i16_t*)p), hi = __builtin_amdgcn_ds_read_tr16_b64_v4i16((LAS v4i16_t*)(p + 4 * pitch));
    return (bf16x8){lo[0], lo[1], lo[2], lo[3], hi[0], hi[1], hi[2], hi[3]};
}

__device__ __forceinline__ void attn_phase(const Params& p, LAS unsigned char* lds, int G) {
    const int tid = threadIdx.x, lane = tid & 63, wave = tid >> 6, fr = lane & 15, fq = lane >> 4;
    const bf16_t* proj = (const bf16_t*)(p.ws + WS_HID); bf16_t* mix = (bf16_t*)(p.ws + WS_ACTB);
    LAS bf16_t* Kl = (LAS bf16_t*)lds;
    LAS bf16_t* Vl = (LAS bf16_t*)(lds + 18432);
    LAS bf16_t* Pl = (LAS bf16_t*)(lds + 36864 + wave * 9216);
    LAS float* stat = (LAS float*)(lds + 110592);
    const int h = wave, kvh = h >> 2;
    const float sink = p.in[8][h];
    const int skey = tid >> 3, sdch = tid & 7;
    const int trb = (8 * fq + (fr >> 2)) * 72 + 4 * (fr & 3);
    u32x4 pk[2], pv[2];
#define ATT_RANGE(r0, lo, hi) do { int ss_, se_; if ((r0) < TP) { ss_ = (r0) & ~8191; se_ = ss_ + 8192; } else { ss_ = TP + (((r0) - TP) & ~2047); se_ = ss_ + 2048; } \
        lo = ((r0) - 128 < ss_) ? ((ss_ - ((r0) - 128)) >> 6) : 0; hi = ((r0) + 128 >= se_) ? (((se_ - 64) - ((r0) - 128)) >> 6) : 4; } while (0)
#define ATT_ISSUE(r0, kb) do { const bf16_t* src_ = proj + (size_t)((r0) - 128 + 64 * (kb) + skey) * DIN + 512 + sdch * 8; \
        pk[0] = *(const u32x4*)src_; pv[0] = *(const u32x4*)(src_ + 128); pk[1] = *(const u32x4*)(src_ + 64); pv[1] = *(const u32x4*)(src_ + 192); } while (0)
    int unit = blockIdx.x;
    if (unit < T / 64) { int lo, hi; ATT_RANGE(unit * 64, lo, hi); ATT_ISSUE(unit * 64, lo); (void)hi; }
    for (; unit < T / 64; unit += G) {
        const int row0 = unit * 64; int kb_lo, kb_hi; ATT_RANGE(row0, kb_lo, kb_hi);
        bf16x8 qf[4][2];
#pragma unroll
        for (int m = 0; m < 4; ++m)
#pragma unroll
            for (int k = 0; k < 2; ++k) qf[m][k] = *(const bf16x8*)(proj + (size_t)(row0 + 16 * m + fr) * DIN + h * 64 + 32 * k + 8 * fq);
        f32x4 o[4][4]; float mrow[4], lrow[4];
#pragma unroll
        for (int m = 0; m < 4; ++m) { mrow[m] = sink; lrow[m] = 1.f;
#pragma unroll
            for (int n = 0; n < 4; ++n) o[m][n] = (f32x4){0.f, 0.f, 0.f, 0.f}; }
        for (int kb = kb_lo; kb <= kb_hi; ++kb) {
            const int kstart = row0 - 128 + 64 * kb;
            __syncthreads();
#pragma unroll
            for (int i = 0; i < 2; ++i) {
                *(LAS u32x4*)(Kl + (i * 64 + skey) * 72 + sdch * 8) = pk[i]; *(LAS u32x4*)(Vl + (i * 64 + skey) * 72 + sdch * 8) = pv[i];
            }
            __syncthreads();
            if (kb < kb_hi) { ATT_ISSUE(row0, kb + 1); }
            else if (unit + G < T / 64) { int lo2, hi2; ATT_RANGE((unit + G) * 64, lo2, hi2); ATT_ISSUE((unit + G) * 64, lo2); (void)hi2; }
            bf16x8 kf[4][2];
#pragma unroll
            for (int n = 0; n < 4; ++n) { kf[n][0] = LDS16(Kl + (kvh * 64 + 16 * n + fr) * 72 + 8 * fq); kf[n][1] = LDS16(Kl + (kvh * 64 + 16 * n + fr) * 72 + 32 + 8 * fq); }
            const bool edge = (kb == 0) || (kb == 4);
#pragma unroll
            for (int m = 0; m < 4; ++m) {
                f32x4 s[4];
#pragma unroll
                for (int n = 0; n < 4; ++n) { f32x4 a = (f32x4){0.f, 0.f, 0.f, 0.f}; a = MMA16(kf[n][0], qf[m][0], a); a = MMA16(kf[n][1], qf[m][1], a); s[n] = a; }
                const int i = row0 + 16 * m + fr; float mx = mrow[m];
                if (edge) {
#pragma unroll
                    for (int n = 0; n < 4; ++n)
#pragma unroll
                        for (int e = 0; e < 4; ++e) { const int j = kstart + 16 * n + 4 * fq + e, dlt = i - j; const bool valid = (dlt <= 128) && (dlt >= -128); s[n][e] = valid ? s[n][e] : -1e30f; }
                }
#pragma unroll
                for (int n = 0; n < 4; ++n) mx = fmaxf(fmaxf(mx, fmaxf(s[n][0], s[n][1])), fmaxf(s[n][2], s[n][3]));
                mx = fmaxf(mx, __shfl_xor(mx, 16)); mx = fmaxf(mx, __shfl_xor(mx, 32));
                const float alpha = fexp(mrow[m] - mx); mrow[m] = mx; float ps = 0.f; const float mxl = mx * 1.4426950408889634f;
#pragma unroll
                for (int n = 0; n < 4; ++n) {
                    f32x4 pvv;
#pragma unroll
                    for (int e = 0; e < 4; ++e) { pvv[e] = __builtin_amdgcn_exp2f(s[n][e] * 1.4426950408889634f - mxl); ps += pvv[e]; }
                    u32x2 w; w.x = cvt_pk_bf16(pvv[0], pvv[1]); w.y = cvt_pk_bf16(pvv[2], pvv[3]);
                    *(LAS u32x2*)(Pl + (16 * m + fr) * 72 + 16 * n + 4 * fq) = w;
                    o[m][n] = o[m][n] * alpha;
                }
                ps += __shfl_xor(ps, 16); ps += __shfl_xor(ps, 32);
                lrow[m] = lrow[m] * alpha + ps;
            }
            asm volatile("s_waitcnt lgkmcnt(0)" ::: "memory");
#pragma unroll
            for (int n = 0; n < 4; ++n) {
                const bf16x8 b0 = tr_frag(Vl + kvh * 64 * 72 + trb + 16 * n, 72), b1 = tr_frag(Vl + (kvh * 64 + 32) * 72 + trb + 16 * n, 72);
#pragma unroll
                for (int m = 0; m < 4; ++m) { const bf16x8 a0 = LDS16(Pl + (16 * m + fr) * 72 + 8 * fq), a1 = LDS16(Pl + (16 * m + fr) * 72 + 32 + 8 * fq);
                    o[m][n] = MMA16(b0, a0, o[m][n]); o[m][n] = MMA16(b1, a1, o[m][n]); }
            }
        }
#pragma unroll
        for (int m = 0; m < 4; ++m) { const float inv = 1.0f / lrow[m]; float ss = 0.f;
#pragma unroll
            for (int n = 0; n < 4; ++n) { o[m][n] = o[m][n] * inv; ss += (o[m][n][0] * o[m][n][0] + o[m][n][1] * o[m][n][1]) + (o[m][n][2] * o[m][n][2] + o[m][n][3] * o[m][n][3]); }
            ss += __shfl_xor(ss, 16); ss += __shfl_xor(ss, 32);
            if (fq == 0) stat[h * 64 + 16 * m + fr] = ss; }
        __syncthreads();
#pragma unroll
        for (int m = 0; m < 4; ++m) { float tot = 0.f;
#pragma unroll
            for (int hh = 0; hh < 8; ++hh) tot += stat[hh * 64 + 16 * m + fr];
            const float rn = __builtin_amdgcn_rsqf(tot * (1.0f / 512.0f) + EPS);
#pragma unroll
            for (int n = 0; n < 4; ++n) { const f32x4 v = o[m][n] * rn; u32x2 w; w.x = cvt_pk_bf16(v[0], v[1]); w.y = cvt_pk_bf16(v[2], v[3]);
                *(u32x2*)(mix + (size_t)(row0 + 16 * m + fr) * D + h * 64 + 16 * n + 4 * fq) = w; } }
    }
#undef ATT_RANGE
#undef ATT_ISSUE
    __syncthreads();
}

__device__ __forceinline__ void ret_kv_phase(const Params& p, LAS unsigned char* lds, int G) {
    const int tid = threadIdx.x, lane = tid & 63, wave = tid >> 6, fr = lane & 15, fq = lane >> 4;
    const bf16_t* proj = (const bf16_t*)(p.ws + WS_HID); bf16_t* kvbuf = (bf16_t*)p.out;
    LAS bf16_t* Vl = (LAS bf16_t*)lds; LAS bf16_t* Kf = (LAS bf16_t*)(lds + 34816); LAS bf16_t* Kb = (LAS bf16_t*)(lds + 69632);
    const int stok = tid >> 4, sdch = tid & 15;
    const int trb = (8 * fq + (fr >> 2)) * 136 + 4 * (fr & 3);
    u32x4 pk[4], pv[4];
#define R1_ISSUE(u_) do { const bf16_t* src_ = proj + (size_t)(((u_) >> 2) * 128 + stok) * DIN + 1280 + ((u_) & 3) * 128 + sdch * 8; \
        _Pragma("unroll") for (int i_ = 0; i_ < 4; ++i_) { pk[i_] = *(const u32x4*)(src_ + (size_t)i_ * 32 * DIN); pv[i_] = *(const u32x4*)(src_ + 512 + (size_t)i_ * 32 * DIN); } } while (0)
    int unit = blockIdx.x;
    if (unit < (T / 128) * 4) R1_ISSUE(unit);
    for (; unit < (T / 128) * 4; unit += G) {
        const int c = unit >> 2, h = unit & 3;
        const float ldf = p.in[10][h], ldb = p.in[11][h];
        __syncthreads();
#pragma unroll
        for (int i = 0; i < 4; ++i) {
            const int tok = stok + 32 * i; const float wf = fexp(ldf * (float)(127 - tok)), wb = fexp(ldb * (float)tok);
            const unsigned kw[4] = {pk[i].x, pk[i].y, pk[i].z, pk[i].w}; u32x4 of, ob; unsigned fo[4], bo[4];
#pragma unroll
            for (int q = 0; q < 4; ++q) { const float k0 = bf2f((unsigned short)(kw[q] & 0xffffu)), k1 = bf2f((unsigned short)(kw[q] >> 16)); fo[q] = cvt_pk_bf16(k0 * wf, k1 * wf); bo[q] = cvt_pk_bf16(k0 * wb, k1 * wb); }
            of.x = fo[0]; of.y = fo[1]; of.z = fo[2]; of.w = fo[3]; ob.x = bo[0]; ob.y = bo[1]; ob.z = bo[2]; ob.w = bo[3];
            *(LAS u32x4*)(Vl + tok * 136 + sdch * 8) = pv[i]; *(LAS u32x4*)(Kf + tok * 136 + sdch * 8) = of; *(LAS u32x4*)(Kb + tok * 136 + sdch * 8) = ob;
        }
        __syncthreads();
        if (unit + G < (T / 128) * 4) R1_ISSUE(unit + G);
        const int dir = wave >> 2, mt0 = (wave & 3) * 2; LAS bf16_t* Kx = dir ? Kb : Kf;
        f32x4 acc[2][8];
#pragma unroll
        for (int mi = 0; mi < 2; ++mi)
#pragma unroll
            for (int n = 0; n < 8; ++n) acc[mi][n] = (f32x4){0.f, 0.f, 0.f, 0.f};
#pragma unroll
        for (int k = 0; k < 4; ++k) {
            const bf16x8 a0 = tr_frag(Vl + 32 * k * 136 + trb + (mt0 + 0) * 16, 136), a1 = tr_frag(Vl + 32 * k * 136 + trb + (mt0 + 1) * 16, 136);
#pragma unroll
            for (int n = 0; n < 8; ++n) { const bf16x8 b = tr_frag(Kx + 32 * k * 136 + trb + 16 * n, 136); acc[0][n] = MMA16(b, a0, acc[0][n]); acc[1][n] = MMA16(b, a1, acc[1][n]); }
        }
        bf16_t* dst = kvbuf + ((size_t)(c * 4 + h) * 2 + dir) * 16384;
#pragma unroll
        for (int mi = 0; mi < 2; ++mi)
#pragma unroll
            for (int n = 0; n < 8; ++n) { u32x2 w; w.x = cvt_pk_bf16(acc[mi][n][0], acc[mi][n][1]); w.y = cvt_pk_bf16(acc[mi][n][2], acc[mi][n][3]);
                *(u32x2*)(dst + ((mt0 + mi) * 16 + fr) * 128 + 16 * n + 4 * fq) = w; }
    }
#undef R1_ISSUE
}

__device__ __forceinline__ void ret_scan_phase(const Params& p, int G) {
    bf16_t* kvbuf = (bf16_t*)p.out;
    const int nthr = G * NTHR;
    for (int t = blockIdx.x * NTHR + threadIdx.x; t < 131072; t += nthr) {
        {
            const int e4 = t & 4095, sdh = t >> 12, dir = sdh & 1, h = (sdh >> 1) & 3, b = sdh >> 3, c0 = 64 * b;
            const float Dk = fexp((dir ? p.in[11][h] : p.in[10][h]) * 128.0f);
            float st[4] = {0.f, 0.f, 0.f, 0.f};
            for (int sb = 0; sb < 64; sb += 16) {
                u32x2 v[16];
#pragma unroll
                for (int i = 0; i < 16; ++i) { const int c = dir ? (c0 + 63 - sb - i) : (c0 + sb + i); v[i] = *(const u32x2*)(kvbuf + ((size_t)(c * 4 + h) * 2 + dir) * 16384 + e4 * 4); }
#pragma unroll
                for (int i = 0; i < 16; ++i) { const int c = dir ? (c0 + 63 - sb - i) : (c0 + sb + i);
                    u32x2 w; w.x = pk2(st[0], st[1]); w.y = pk2(st[2], st[3]); *(u32x2*)(kvbuf + ((size_t)(c * 4 + h) * 2 + dir) * 16384 + e4 * 4) = w;
                    st[0] = st[0] * Dk + bf2f((unsigned short)(v[i].x & 0xffffu)); st[1] = st[1] * Dk + bf2f((unsigned short)(v[i].x >> 16));
                    st[2] = st[2] * Dk + bf2f((unsigned short)(v[i].y & 0xffffu)); st[3] = st[3] * Dk + bf2f((unsigned short)(v[i].y >> 16)); }
            }
        }
        {
            const int e8 = t & 2047, sdh = t >> 11, dir = sdh & 1, h = (sdh >> 1) & 3, b = sdh >> 3, c0 = 256 + 16 * b;
            const float Dk = fexp((dir ? p.in[11][h] : p.in[10][h]) * 128.0f);
            float st[8] = {0.f, 0.f, 0.f, 0.f, 0.f, 0.f, 0.f, 0.f};
            u32x4 v[16];
#pragma unroll
            for (int i = 0; i < 16; ++i) { const int c = dir ? (c0 + 15 - i) : (c0 + i); v[i] = *(const u32x4*)(kvbuf + ((size_t)(c * 4 + h) * 2 + dir) * 16384 + e8 * 8); }
#pragma unroll
            for (int i = 0; i < 16; ++i) { const int c = dir ? (c0 + 15 - i) : (c0 + i);
                u32x4 w; w.x = pk2(st[0], st[1]); w.y = pk2(st[2], st[3]); w.z = pk2(st[4], st[5]); w.w = pk2(st[6], st[7]); *(u32x4*)(kvbuf + ((size_t)(c * 4 + h) * 2 + dir) * 16384 + e8 * 8) = w;
                const unsigned vv[4] = {v[i].x, v[i].y, v[i].z, v[i].w};
#pragma unroll
                for (int q = 0; q < 4; ++q) { st[2 * q] = st[2 * q] * Dk + bf2f((unsigned short)(vv[q] & 0xffffu)); st[2 * q + 1] = st[2 * q + 1] * Dk + bf2f((unsigned short)(vv[q] >> 16)); }
            }
        }
    }
}

__device__ __forceinline__ void ret_out_phase(const Params& p, LAS unsigned char* lds, int G) {
    const int tid = threadIdx.x, lane = tid & 63, wave = tid >> 6, fr = lane & 15, fq = lane >> 4;
    const bf16_t* proj = (const bf16_t*)(p.ws + WS_HID); const bf16_t* kvbuf = (const bf16_t*)p.out; bf16_t* mix = (bf16_t*)(p.ws + WS_ACTB);
    LAS bf16_t* Ql = (LAS bf16_t*)lds; LAS bf16_t* Kl = (LAS bf16_t*)(lds + 34816); LAS bf16_t* Vl = (LAS bf16_t*)(lds + 69632); LAS bf16_t* Pl = (LAS bf16_t*)(lds + 104448);
    const int stok = tid >> 4, sdch = tid & 15;
    const int trb = (8 * fq + (fr >> 2)) * 136 + 4 * (fr & 3);
    const int il = 16 * wave + fr;
    u32x4 pq[4], pk[4], pv[4];
#define R3_ISSUE(u_) do { const bf16_t* src_ = proj + (size_t)(((u_) >> 2) * 128 + stok) * DIN + 768 + ((u_) & 3) * 128 + sdch * 8; \
        _Pragma("unroll") for (int i_ = 0; i_ < 4; ++i_) { pq[i_] = *(const u32x4*)(src_ + (size_t)i_ * 32 * DIN); pk[i_] = *(const u32x4*)(src_ + 512 + (size_t)i_ * 32 * DIN); pv[i_] = *(const u32x4*)(src_ + 1024 + (size_t)i_ * 32 * DIN); } } while (0)
    int unit = blockIdx.x;
    if (unit < (T / 128) * 4) R3_ISSUE(unit);
    for (; unit < (T / 128) * 4; unit += G) {
        const int c = unit >> 2, h = unit & 3, row0 = c * 128;
        const float ldf = p.in[10][h], ldb = p.in[11][h];
        __syncthreads();
#pragma unroll
        for (int i = 0; i < 4; ++i) {
            const int tok = stok + 32 * i;
            *(LAS u32x4*)(Ql + tok * 136 + sdch * 8) = pq[i]; *(LAS u32x4*)(Kl + tok * 136 + sdch * 8) = pk[i]; *(LAS u32x4*)(Vl + tok * 136 + sdch * 8) = pv[i];
        }
        __syncthreads();
        u32x4 sfr[4], sbr[4];
        {
            const bf16_t* sf = kvbuf + ((size_t)(c * 4 + h) * 2) * 16384 + stok * 128 + sdch * 8;
#pragma unroll
            for (int i = 0; i < 4; ++i) { sfr[i] = *(const u32x4*)(sf + i * 32 * 128); sbr[i] = *(const u32x4*)(sf + 16384 + i * 32 * 128); }
        }
        bf16x8 qa[4];
#pragma unroll
        for (int k = 0; k < 4; ++k) qa[k] = LDS16(Ql + il * 136 + 32 * k + 8 * fq);
        f32x4 o1[8];
        {
            f32x4 s[8];
#pragma unroll
            for (int n = 0; n < 8; ++n) { s[n] = (f32x4){0.f, 0.f, 0.f, 0.f};
#pragma unroll
                for (int k = 0; k < 4; ++k) s[n] = MMA16(LDS16(Kl + (16 * n + fr) * 136 + 32 * k + 8 * fq), qa[k], s[n]); }
#pragma unroll
            for (int n = 0; n < 8; ++n) { f32x4 pvv;
#pragma unroll
                for (int e = 0; e < 4; ++e) { const int j = 16 * n + 4 * fq + e, dlt = il - j; const float mk = dlt > 0 ? fexp(ldf * (float)dlt) : (dlt < 0 ? fexp(ldb * (float)(-dlt)) : 2.0f); pvv[e] = s[n][e] * mk; }
                u32x2 w; w.x = cvt_pk_bf16(pvv[0], pvv[1]); w.y = cvt_pk_bf16(pvv[2], pvv[3]);
                *(LAS u32x2*)(Pl + il * 136 + 16 * n + 4 * fq) = w; }
            asm volatile("s_waitcnt lgkmcnt(0)" ::: "memory");
            bf16x8 pa[4];
#pragma unroll
            for (int k = 0; k < 4; ++k) pa[k] = LDS16(Pl + il * 136 + 32 * k + 8 * fq);
#pragma unroll
            for (int n = 0; n < 8; ++n) { o1[n] = (f32x4){0.f, 0.f, 0.f, 0.f};
#pragma unroll
                for (int k = 0; k < 4; ++k) o1[n] = MMA16(tr_frag(Vl + 32 * k * 136 + trb + 16 * n, 136), pa[k], o1[n]); }
        }
        __syncthreads();
#pragma unroll
        for (int i = 0; i < 4; ++i) { const int dv = stok + 32 * i; *(LAS u32x4*)(Kl + dv * 136 + sdch * 8) = sfr[i]; *(LAS u32x4*)(Pl + dv * 136 + sdch * 8) = sbr[i]; }
        __syncthreads();
        if (unit + G < (T / 128) * 4) R3_ISSUE(unit + G);
        u32x2 gv[8];
        { const bf16_t* gsrc = proj + (size_t)(row0 + il) * DIN + 2304 + h * 128 + 4 * fq;
#pragma unroll
            for (int n = 0; n < 8; ++n) gv[n] = *(const u32x2*)(gsrc + 16 * n); }
        {
            const float ef = fexp(ldf * (float)(il + 1)), eb = fexp(ldb * (float)(128 - il));
#pragma unroll
            for (int n = 0; n < 8; ++n) { f32x4 a = (f32x4){0.f, 0.f, 0.f, 0.f}, b = (f32x4){0.f, 0.f, 0.f, 0.f};
#pragma unroll
                for (int k = 0; k < 4; ++k) { a = MMA16(LDS16(Kl + (16 * n + fr) * 136 + 32 * k + 8 * fq), qa[k], a); b = MMA16(LDS16(Pl + (16 * n + fr) * 136 + 32 * k + 8 * fq), qa[k], b); }
                o1[n] = o1[n] + a * ef + b * eb; }
        }
        float sm = 0.f;
#pragma unroll
        for (int n = 0; n < 8; ++n) sm += (o1[n][0] + o1[n][1]) + (o1[n][2] + o1[n][3]);
        sm += __shfl_xor(sm, 16); sm += __shfl_xor(sm, 32);
        const float mu = sm * (1.0f / 128.0f); float sq = 0.f;
#pragma unroll
        for (int n = 0; n < 8; ++n) { o1[n] = o1[n] - mu; sq += (o1[n][0] * o1[n][0] + o1[n][1] * o1[n][1]) + (o1[n][2] * o1[n][2] + o1[n][3] * o1[n][3]); }
        sq += __shfl_xor(sq, 16); sq += __shfl_xor(sq, 32);
        const float rs = __builtin_amdgcn_rsqf(sq * (1.0f / 128.0f) + EPS);
        bf16_t* dst = mix + (size_t)(row0 + il) * D + 512 + h * 128 + 4 * fq;
#pragma unroll
        for (int n = 0; n < 8; ++n) { const u32x2 g = gv[n];
            const float g0 = bf2f((unsigned short)(g.x & 0xffffu)), g1 = bf2f((unsigned short)(g.x >> 16)), g2 = bf2f((unsigned short)(g.y & 0xffffu)), g3 = bf2f((unsigned short)(g.y >> 16));
            u32x2 w; w.x = cvt_pk_bf16(silu_f(g0) * o1[n][0] * rs, silu_f(g1) * o1[n][1] * rs); w.y = cvt_pk_bf16(silu_f(g2) * o1[n][2] * rs, silu_f(g3) * o1[n][3] * rs);
            *(u32x2*)(dst + 16 * n) = w; }
    }
#undef R3_ISSUE
}

__device__ __forceinline__ void final_norm_phase(const Params& p, int G) {
    const int lane = threadIdx.x & 63, wave = threadIdx.x >> 6; const int gw = blockIdx.x * 8 + wave, NGW = G * 8;
    const f32x4* gp = (const f32x4*)p.in[17] + lane;
    for (int row = gw; row < T; row += NGW) {
        f32x4* xr = (f32x4*)(p.out + (size_t)row * D) + lane; f32x4 v[4]; float s = 0.f;
#pragma unroll
        for (int j = 0; j < 4; ++j) { v[j] = xr[64 * j]; s += (v[j][0] * v[j][0] + v[j][1] * v[j][1]) + (v[j][2] * v[j][2] + v[j][3] * v[j][3]); }
        const float rstd = __builtin_amdgcn_rsqf(wave_sum(s) * (1.f / D) + EPS);
#pragma unroll
        for (int j = 0; j < 4; ++j) xr[64 * j] = v[j] * rstd * gp[64 * j];
    }
}

#define XB_TMO      128
#define XB_XCNT(j)  (256  + 64 * (j))
#define XB_XSUB(j)  (1280 + 64 * (j))
#define XB_XGEN(j)  (2304 + 64 * (j))
#define XB_TOP      3328
#define XB_TOPGEN   3392
#define XCD_BAR_WORDS 3456
#define XB_SPIN_CAP (1u << 18)

__device__ __forceinline__ unsigned xb_ld(unsigned* p)              { return __hip_atomic_load(p, __ATOMIC_RELAXED, __HIP_MEMORY_SCOPE_AGENT); }
__device__ __forceinline__ unsigned xb_add(unsigned* p, unsigned v) { return __hip_atomic_fetch_add(p, v, __ATOMIC_RELAXED, __HIP_MEMORY_SCOPE_AGENT); }
__device__ __forceinline__ unsigned xb_xcc_id() { return (unsigned)__builtin_amdgcn_s_getreg((3 << 11) | 20) & 0xFu; }
#define XB_SPIN(cond, bar) do { unsigned _sp = 0; while (cond) { __builtin_amdgcn_s_sleep(1); \
    if ((++_sp & 255u) == 0u) { if (xb_ld(&(bar)[XB_TMO])) break; if (_sp > XB_SPIN_CAP) { atomicAdd(&(bar)[XB_TMO], 1u); break; } } } } while (0)

struct XcdBarrier {
    unsigned* bar; unsigned x;
    volatile LAS unsigned* st;
};

__device__ __forceinline__ XcdBarrier xcd_barrier_post(unsigned* bar, volatile LAS unsigned* st) {
    XcdBarrier b; b.bar = bar; b.x = xb_xcc_id(); b.st = st;
    if (threadIdx.x == 0) (void)xb_add(&bar[XB_XCNT(b.x)], 1u);
    return b;
}
__device__ __forceinline__ void xcd_barrier_complete(unsigned* bar, unsigned x, unsigned& nloc, unsigned& nx) {
    const unsigned G = gridDim.x * gridDim.y * gridDim.z;
    unsigned sum, cnt, mine, sp = 0u;
    for (;;) {
        sum = 0u; cnt = 0u; mine = 0u;
#pragma unroll
        for (unsigned j = 0; j < 16; ++j) { const unsigned c = xb_ld(&bar[XB_XCNT(j)]); sum += c; cnt += (c > 0u) ? 1u : 0u; mine = (j == x) ? c : mine; }
        if (sum == G) break;
        __builtin_amdgcn_s_sleep(1);
        if ((++sp & 255u) == 0u) { if (xb_ld(&bar[XB_TMO])) break; if (sp > XB_SPIN_CAP) { atomicAdd(&bar[XB_TMO], 1u); break; } }
    }
    nloc = mine > 0u ? mine : 1u; nx = cnt > 0u ? cnt : 1u;
}

__device__ __forceinline__ void xcd_barrier(const XcdBarrier& b) {
    asm volatile("s_waitcnt vmcnt(0)" ::: "memory");
    __syncthreads();
    if (threadIdx.x == 0) {
        unsigned* bar = b.bar;
        __builtin_amdgcn_s_waitcnt(0);
        unsigned nloc = b.st[0], nx = b.st[1];
        if (nloc == 0u) { xcd_barrier_complete(bar, b.x, nloc, nx); b.st[0] = nloc; b.st[1] = nx; }
        const unsigned old = xb_add(&bar[XB_XSUB(b.x)], 1u);
        const unsigned gen = old / nloc;
        if (old + 1u == (gen + 1u) * nloc) {
            __builtin_amdgcn_fence(__ATOMIC_RELEASE, "agent");
            asm volatile("s_waitcnt vmcnt(0)" ::: "memory");
            const unsigned og = xb_add(&bar[XB_TOP], 1u);
            const unsigned tg = og / nx;
            if (og + 1u == (tg + 1u) * nx) xb_add(&bar[XB_TOPGEN], 1u);
            else XB_SPIN(xb_ld(&bar[XB_TOPGEN]) == tg, bar);
            __builtin_amdgcn_fence(__ATOMIC_ACQUIRE, "agent");
            xb_add(&bar[XB_XGEN(b.x)], 1u);
            asm volatile("s_waitcnt vmcnt(0)" ::: "memory");
        } else {
            XB_SPIN(xb_ld(&bar[XB_XGEN(b.x)]) == gen, bar);
            __builtin_amdgcn_fence(__ATOMIC_ACQUIRE, "agent");
            asm volatile("s_waitcnt vmcnt(0)" ::: "memory");
        }
    }
    __syncthreads();
}

constexpr int NPHASE = 11;
__global__ void __launch_bounds__(NTHR, 2) mk_fwd(Params p) {
    extern __shared__ __attribute__((aligned(16))) unsigned char lds_raw[];
    LAS unsigned char* lds = (LAS unsigned char*)lds_raw;
    const int G = gridDim.x, lo = p.ph_lo, hi = p.ph_hi;
    cg::grid_group grid = cg::this_grid();
#define IN(k) (lo <= (k) && (k) < hi)
    volatile LAS unsigned* bst = (volatile LAS unsigned*)(lds + 147392);
    if (threadIdx.x == 0) { bst[0] = 0u; bst[1] = 0u; }
    __syncthreads();
    XcdBarrier xbar = xcd_barrier_post((unsigned*)(p.ws + WS_TABR) + 192 * 64, bst);
    unsigned* rankw = (unsigned*)(p.ws + WS_TABR) + 192 * 64 + 3584;
    if (threadIdx.x == 0) { const unsigned x = xb_xcc_id() & 7u; const unsigned r = __hip_atomic_fetch_add(rankw + 8 * x, 1u, __ATOMIC_RELAXED, __HIP_MEMORY_SCOPE_AGENT); bst[2] = r * 8u + x; }
    if (p.ph_lo < -1000) grid.sync();
#define SEAM(k) do { if (IN(k) && IN((k) + 1)) xcd_barrier(xbar); } while (0)
    bf16_t* ACTA = (bf16_t*)(p.ws + WS_ACTA); bf16_t* ACTB = (bf16_t*)(p.ws + WS_ACTB); bf16_t* HID = (bf16_t*)(p.ws + WS_HID);
    float* SSQ = (float*)(p.ws + WS_SSQ);
    if (IN(0)) { p0_prologue(p, lds, G); if (DUP & 1) { __syncthreads(); p0_prologue(p, lds, G); } }
    SEAM(0);
    int vc = (int)blockIdx.x;
    if (IN(0) && IN(1) && G == 256) {
        if (threadIdx.x == 0) { unsigned ok = 1u; for (int j = 0; j < 8; ++j) ok &= (__hip_atomic_load(rankw + 8 * j, __ATOMIC_RELAXED, __HIP_MEMORY_SCOPE_AGENT) == 32u) ? 1u : 0u; bst[3] = ok; }
        __syncthreads();
        if (bst[3]) vc = (int)bst[2];
    }
    if (IN(1)) {
        pg8::Gemm g{ACTA, (const bf16_t*)(p.ws + WS_WGU1), T, 2 * FF, D}; pg8::StaticOrder S; S.init(T, 2 * FF, G, vc);
        EpiSwiGLU<false> E{HID, nullptr};
        pg8::gemm_phase<EpiSwiGLU<false>, pg8::StaticOrder, PG8_ALIGN, PG8_SP2>(lds, g, S, E);
        if (DUP & 16) { __syncthreads(); pg8::gemm_phase<EpiSwiGLU<false>, pg8::StaticOrder, PG8_ALIGN, PG8_SP2>(lds, g, S, E); }
    }
    SEAM(1);
    if (IN(2)) {
        pg8::Gemm g{HID, (const bf16_t*)(p.ws + WS_WD1), T, D, FF}; pg8::StaticOrder S; S.init(T, D, G, vc);
        EpiResid<false, false, true, true> E{p.in[0], p.in[1] - (size_t)TP * D, nullptr, nullptr, ACTA, SSQ, 0.5f};
        pg8::gemm_phase<EpiResid<false, false, true, true>, pg8::StaticOrder, PG8_ALIGN, PG8_SP2>(lds, g, S, E);
    }
    SEAM(2);
    if (IN(3)) {
        pg8::Gemm g{ACTA, (const bf16_t*)(p.ws + WS_WIN), T, DIN, D}; pg8::StaticOrder S; S.init(T, DIN, G, vc);
        EpiProj E{HID, SSQ};
        pg8::gemm_phase<EpiProj, pg8::StaticOrder, PG8_ALIGN, PG8_SP2>(lds, g, S, E);
        if (DUP & 32) { __syncthreads(); pg8::gemm_phase<EpiProj, pg8::StaticOrder, PG8_ALIGN, PG8_SP2>(lds, g, S, E); }
    }
    SEAM(3);
    if (IN(4)) { attn_phase(p, lds, G); ret_kv_phase(p, lds, G); if (DUP & 2) { attn_phase(p, lds, G); } if (DUP & 4) { ret_kv_phase(p, lds, G); } }
    SEAM(4);
    if (IN(5)) { ret_scan_phase(p, G); }
    SEAM(5);
    if (IN(6)) { ret_out_phase(p, lds, G); if (DUP & 8) { ret_out_phase(p, lds, G); } }
    SEAM(6);
    if (IN(7)) {
        __syncthreads();
        pg8::Gemm g{ACTB, (const bf16_t*)(p.ws + WS_WOUT), T, D, D}; pg8::StaticOrder S; S.init(T, D, G, vc);
        EpiResid<true, false, true, true> E{nullptr, nullptr, ACTA, nullptr, ACTA, SSQ, 1.0f};
        pg8::gemm_phase<EpiResid<true, false, true, true>, pg8::StaticOrder, PG8_ALIGN, PG8_SP2>(lds, g, S, E);
    }
    SEAM(7);
    if (IN(8)) {
        pg8::Gemm g{ACTA, (const bf16_t*)(p.ws + WS_WGU2), T, 2 * FF, D}; pg8::StaticOrder S; S.init(T, 2 * FF, G, vc);
        EpiSwiGLU<true> E{HID, SSQ};
        pg8::gemm_phase<EpiSwiGLU<true>, pg8::StaticOrder, PG8_ALIGN, PG8_SP2>(lds, g, S, E);
    }
    SEAM(8);
    const bool fused_final = (G == 256) && IN(10);
    if (IN(9)) {
        pg8::Gemm g{HID, (const bf16_t*)(p.ws + WS_WD2), T, D, FF}; pg8::StaticOrder S; S.init(T, D, G, vc);
        if (fused_final) { EpiFinal E{ACTA, p.out, SSQ, (unsigned*)(p.ws + WS_TABR), p.in[17]};
            pg8::gemm_phase<EpiFinal, pg8::StaticOrder, PG8_ALIGN, PG8_SP2>(lds, g, S, E); }
        else { EpiResid<true, true, false, false> E{nullptr, nullptr, ACTA, p.out, nullptr, nullptr, 0.5f};
            pg8::gemm_phase<EpiResid<true, true, false, false>, pg8::StaticOrder, PG8_ALIGN, PG8_SP2>(lds, g, S, E); }
    }
    if (!fused_final) { SEAM(9); if (IN(10)) { final_norm_phase(p, G); } }
#undef IN
#undef SEAM
}

extern "C" void kernel_launch(void* const* d_in, const int* in_sizes, int n_in, void* d_out, int out_size, void* d_ws, size_t ws_size, hipStream_t stream) {
    static int grid = 0;
    if (grid == 0) {
        if (n_in != 18 || out_size != T * D || ws_size < WS_END) { fprintf(stderr, "kernel_launch: unexpected shapes (n_in %d, out %d, ws %zu)\n", n_in, out_size, ws_size); grid = -1; return; }
        int dev = 0, cus = 0, per_cu = 0;
        if (hipGetDevice(&dev) != hipSuccess || hipDeviceGetAttribute(&cus, hipDeviceAttributeMultiprocessorCount, dev) != hipSuccess) { grid = -1; return; }
        if (hipFuncSetAttribute((const void*)mk_fwd, hipFuncAttributeMaxDynamicSharedMemorySize, LDS_BYTES) != hipSuccess) { fprintf(stderr, "kernel_launch: hipFuncSetAttribute failed\n"); grid = -1; return; }
        if (hipOccupancyMaxActiveBlocksPerMultiprocessor(&per_cu, (const void*)mk_fwd, NTHR, LDS_BYTES) != hipSuccess || per_cu < 1) { fprintf(stderr, "kernel_launch: occupancy query says %d\n", per_cu); per_cu = 1; }
        (void)hipGetLastError();
        grid = cus;
    }
    if (grid < 0) return;
    if (hipMemsetAsync((unsigned char*)d_ws + WS_TABR, 0, (192 * 64 + 4096) * 4, stream) != hipSuccess) { fprintf(stderr, "kernel_launch: memset of the control words failed\n"); return; }
    Params a{};
    for (int i = 0; i < 18; ++i) a.in[i] = (const float*)d_in[i];
    a.out = (float*)d_out; a.ws = (unsigned char*)d_ws;
#if MK_ONE_LAUNCH
    a.ph_lo = 0; a.ph_hi = NPHASE;
    void* args[] = {&a};
    hipError_t e = hipLaunchCooperativeKernel((const void*)mk_fwd, dim3(grid), dim3(NTHR), args, LDS_BYTES, stream);
    if (e != hipSuccess) fprintf(stderr, "kernel_launch: cooperative launch failed: %s (grid %d)\n", hipGetErrorString(e), grid);
#else
    for (int ph = 0; ph < NPHASE; ++ph) { a.ph_lo = ph; a.ph_hi = ph + 1; hipLaunchKernelGGL(mk_fwd, dim3(grid), dim3(NTHR), LDS_BYTES, stream, a); }
#endif
}
```

```cpp
#include <hip/hip_runtime.h>
#include <hip/hip_cooperative_groups.h>
#include <cstdio>
#include <cstdint>
namespace cg = cooperative_groups;
#ifndef DUP
#define DUP 0
#endif
#ifndef MK_ONE_LAUNCH
#define MK_ONE_LAUNCH 1
#endif
namespace pg8 {
#define PG8_LAS __attribute__((address_space(3)))
typedef unsigned short bf16_t;
typedef short bf16x8 __attribute__((ext_vector_type(8)));
typedef float f32x4 __attribute__((ext_vector_type(4)));
typedef unsigned u32x4 __attribute__((ext_vector_type(4)));
constexpr int BM = 256, BK = 64, HALF = 128, HTB = HALF * BK * 2  , STAGE_BYTES = 8 * HTB, NXCD = 8, WGM = 8;

__host__ __device__ __forceinline__ int lds_byte(int r, int c) { const int st = (r >> 4) * 2 + (c >> 5), rr = r & 15, cc = c & 31, ob = rr * 64 + cc * 2; return st * 1024 + (ob ^ (((ob >> 9) & 1) << 5)); }
__host__ __device__ __forceinline__ void stage_rc(int b, int& R, int& C) { const int st = b / 1024, sb = b % 1024, swz = sb ^ (((sb >> 9) & 1) << 5); R = (st >> 1) * 16 + swz / 64; C = (st & 1) * 32 + (swz % 64) / 2; }
__host__ __device__ __forceinline__ int perm32(int rho) { const int n = rho >> 4, i = rho & 15; return 8 * (i >> 2) + 4 * n + (i & 3); }

struct Unit { int pm, pn; };
struct Gemm { const bf16_t* A; const bf16_t* Bt; int M, N, K; };

struct StaticOrder {
    int nM, nN, nwg, G, c;
    __host__ __device__ void init(int M, int N, int G_, int c_) { nM = M / BM; nN = N / BM; nwg = nM * nN; G = G_; c = c_; }
    __host__ __device__ bool next(int i, Unit& u) const {
        const long L = (long)i * G + c; if (L >= nwg) return false;
        int wgid = (int)L; { const int q = nwg / NXCD, r = nwg % NXCD, xcd = wgid % NXCD, off = wgid / NXCD; wgid = (xcd < r ? xcd * (q + 1) : r * (q + 1) + (xcd - r) * q) + off; }
        const int nig = WGM * nN, gid = wgid / nig, fm = gid * WGM, gsz = (nM - fm) < WGM ? (nM - fm) : WGM;
        u.pm = fm + ((wgid % nig) % gsz); u.pn = (wgid % nig) / gsz; return true;
    }
    __device__ __forceinline__ void a_ready(const Unit&) const {}
    __device__ __forceinline__ void done(const Unit&) const {}
};

__device__ __forceinline__ unsigned cvt_pk_bf16(float lo, float hi) { unsigned r; asm volatile("v_cvt_pk_bf16_f32 %0, %1, %2" : "=v"(r) : "v"(lo), "v"(hi)); return r; }
typedef float f32x2 __attribute__((ext_vector_type(2)));
template <class Epi, class Sched, bool ALIGN_EPI = false, bool SP2 = false>
__device__ __forceinline__ void gemm_phase(PG8_LAS unsigned char* lds, const Gemm g, const Sched& S, const Epi& E) {
    const int tid = threadIdx.x, wid = __builtin_amdgcn_readfirstlane(tid >> 6), lane = tid & 63, wr = wid >> 2, wc = wid & 3, fr = lane & 15, fq = lane >> 4;
    const int K = g.K, nt = K / BK;
    unsigned voffA[2], voffB[2];
#pragma unroll
    for (int i = 0; i < 2; ++i) { int R, C; stage_rc(tid * 16 + i * 8192, R, C); const int Rb = Epi::PERM ? ((R & ~31) + perm32(R & 31)) : R;
        voffA[i] = (unsigned)(R * K + C) * 2u; voffB[i] = (unsigned)(Rb * K + C) * 2u; }
    const size_t kstep = (size_t)(BK * 2);
    const size_t hstep = (size_t)HALF * K * 2;
    const size_t tstep = 2 * hstep;
    const unsigned ldsw = (unsigned)wid * 1024u;
    const int aoff = lds_byte(wr * 64 + fr, fq * 8), boff = lds_byte(wc * 32 + fr, fq * 8);
#define PG8_SA(b, h) (((b) * 2 + (h)) * HTB)
#define PG8_SB(b, h) ((4 + (b) * 2 + (h)) * HTB)
#define PG8_STAGE(bufoff, gbase, voff) do { _Pragma("unroll") for (int _i = 0; _i < 2; ++_i) \
        __builtin_amdgcn_global_load_lds((const unsigned*)((const char*)(gbase) + (voff)[_i]), (PG8_LAS unsigned*)(lds + (bufoff) + ldsw + _i * 8192), 16, 0, 0); } while (0)
#define PG8_LDA(dst, b, h) do { _Pragma("unroll") for (int m = 0; m < 4; ++m) _Pragma("unroll") for (int k = 0; k < 2; ++k) dst[m][k] = *(const PG8_LAS bf16x8*)(lds + PG8_SA(b, h) + aoff + m * 2048 + k * 1024); } while (0)
#define PG8_LDB(dst, b, h) do { _Pragma("unroll") for (int n = 0; n < 2; ++n) _Pragma("unroll") for (int k = 0; k < 2; ++k) dst[n][k] = *(const PG8_LAS bf16x8*)(lds + PG8_SB(b, h) + boff + n * 2048 + k * 1024); } while (0)
#define PG8_MMA(ai, bj, At, Bt) do { __builtin_amdgcn_s_setprio(1); _Pragma("unroll") for (int m = 0; m < 4; ++m) _Pragma("unroll") for (int n = 0; n < 2; ++n) _Pragma("unroll") for (int k = 0; k < 2; ++k) \
        acc[ai][bj][m][n] = __builtin_amdgcn_mfma_f32_16x16x32_bf16(Bt[n][k], At[m][k], acc[ai][bj][m][n], 0, 0, 0); __builtin_amdgcn_s_setprio(0); } while (0)
#define PG8_WAIT_V(n) asm volatile("s_waitcnt vmcnt(" #n ")" ::: "memory")
#define PG8_WAIT_L(n) asm volatile("s_waitcnt lgkmcnt(" #n ")" ::: "memory")
#define PG8_BAR __builtin_amdgcn_s_barrier()
#define PG8_SCHED __builtin_amdgcn_sched_barrier(0)
    Unit cur, nxt; int ui = 0;
    if (!S.next(0, cur)) return;
    f32x4 acc[2][2][4][2];
#pragma unroll
    for (int a = 0; a < 2; ++a)
#pragma unroll
        for (int b = 0; b < 2; ++b)
#pragma unroll
            for (int m = 0; m < 4; ++m)
#pragma unroll
                for (int n = 0; n < 2; ++n) acc[a][b][m][n] = (f32x4){0.f, 0.f, 0.f, 0.f};
    bf16x8 At[4][2], B0[2][2], B1[2][2];
    const char* cA = (const char*)g.A + (size_t)cur.pm * tstep; const char* cB = (const char*)g.Bt + (size_t)cur.pn * tstep;
    S.a_ready(cur);
    if constexpr (SP2) {
        PG8_STAGE(PG8_SB(0, 0), cB, voffB); PG8_STAGE(PG8_SB(0, 1), cB + hstep, voffB); PG8_STAGE(PG8_SA(0, 0), cA, voffA); PG8_STAGE(PG8_SA(0, 1), cA + hstep, voffA);
        if (wr == 1) PG8_BAR;
        PG8_WAIT_V(2); PG8_BAR;
        PG8_STAGE(PG8_SB(1, 0), cB + kstep, voffB); PG8_STAGE(PG8_SA(1, 0), cA + kstep, voffA); PG8_STAGE(PG8_SB(1, 1), cB + hstep + kstep, voffB);
        PG8_WAIT_V(6); PG8_BAR;
    } else {
        PG8_STAGE(PG8_SB(0, 0), cB, voffB); PG8_STAGE(PG8_SA(0, 0), cA, voffA); PG8_STAGE(PG8_SB(0, 1), cB + hstep, voffB); PG8_STAGE(PG8_SA(0, 1), cA + hstep, voffA);
        if (wr == 1) PG8_BAR;
        PG8_WAIT_V(4); PG8_BAR;
        PG8_STAGE(PG8_SB(1, 0), cB + kstep, voffB); PG8_STAGE(PG8_SA(1, 0), cA + kstep, voffA); PG8_STAGE(PG8_SB(1, 1), cB + hstep + kstep, voffB);
        PG8_WAIT_V(6); PG8_BAR;
    }
    for (;;) {
        const bool has_next = S.next(ui + 1, nxt);
        const char* nA = has_next ? (const char*)g.A + (size_t)nxt.pm * tstep : cA; const char* nB = has_next ? (const char*)g.Bt + (size_t)nxt.pn * tstep : cB;
        for (int t = 0; t < nt; t += 2) {
            const bool last = (t == nt - 2);
            const char* a1 = cA + (size_t)(t + 1) * kstep;
            const char* a2 = last ? nA : cA + (size_t)(t + 2) * kstep; const char* b2 = last ? nB : cB + (size_t)(t + 2) * kstep;
            const char* a3 = a2 + kstep; const char* b3 = b2 + kstep;
            if (last && has_next) S.a_ready(nxt);
            if constexpr (SP2) {
            PG8_LDB(B0, 0, 0); PG8_LDB(B1, 0, 1); PG8_SCHED; PG8_LDA(At, 0, 0); PG8_STAGE(PG8_SA(1, 1), a1 + hstep, voffA);
            PG8_WAIT_V(8); PG8_WAIT_L(0); PG8_BAR; PG8_MMA(0, 0, At, B0); PG8_MMA(0, 1, At, B1); PG8_BAR; PG8_SCHED;
            PG8_LDA(At, 0, 1); PG8_STAGE(PG8_SB(0, 0), b2, voffB); PG8_STAGE(PG8_SB(0, 1), b2 + hstep, voffB); PG8_STAGE(PG8_SA(0, 0), a2, voffA);
            PG8_WAIT_V(8); PG8_WAIT_L(0); PG8_BAR; PG8_MMA(1, 0, At, B0); PG8_MMA(1, 1, At, B1); PG8_BAR; PG8_SCHED;
            PG8_LDB(B0, 1, 0); PG8_LDB(B1, 1, 1); PG8_SCHED; PG8_LDA(At, 1, 0); PG8_STAGE(PG8_SA(0, 1), a2 + hstep, voffA);
            PG8_WAIT_V(8); PG8_WAIT_L(0); PG8_BAR; PG8_MMA(0, 0, At, B0); PG8_MMA(0, 1, At, B1); PG8_BAR; PG8_SCHED;
            PG8_LDA(At, 1, 1); PG8_STAGE(PG8_SB(1, 0), b3, voffB); PG8_STAGE(PG8_SB(1, 1), b3 + hstep, voffB); PG8_STAGE(PG8_SA(1, 0), a3, voffA);
            PG8_WAIT_V(8); PG8_WAIT_L(0); PG8_BAR; PG8_MMA(1, 0, At, B0); PG8_MMA(1, 1, At, B1); PG8_BAR; PG8_SCHED;
            } else {
            PG8_LDB(B0, 0, 0); PG8_SCHED; PG8_LDA(At, 0, 0); PG8_STAGE(PG8_SA(1, 1), a1 + hstep, voffA);
            PG8_WAIT_L(8); PG8_BAR; PG8_WAIT_L(0); PG8_MMA(0, 0, At, B0); PG8_BAR; PG8_SCHED;
            PG8_LDB(B1, 0, 1); PG8_STAGE(PG8_SB(0, 0), b2, voffB);
            PG8_BAR; PG8_WAIT_L(0); PG8_MMA(0, 1, At, B1); PG8_BAR;
            PG8_LDA(At, 0, 1); PG8_STAGE(PG8_SA(0, 0), a2, voffA);
            PG8_BAR; PG8_WAIT_L(0); PG8_MMA(1, 0, At, B0); PG8_BAR; PG8_SCHED;
            PG8_STAGE(PG8_SB(0, 1), b2 + hstep, voffB);
            PG8_WAIT_V(6); PG8_BAR; PG8_MMA(1, 1, At, B1); PG8_BAR;
            PG8_LDB(B0, 1, 0); PG8_SCHED; PG8_LDA(At, 1, 0); PG8_STAGE(PG8_SA(0, 1), a2 + hstep, voffA);
            PG8_WAIT_L(8); PG8_BAR; PG8_WAIT_L(0); PG8_MMA(0, 0, At, B0); PG8_BAR; PG8_SCHED;
            PG8_LDB(B1, 1, 1); PG8_STAGE(PG8_SB(1, 0), b3, voffB);
            PG8_BAR; PG8_WAIT_L(0); PG8_MMA(0, 1, At, B1); PG8_BAR;
            PG8_LDA(At, 1, 1); PG8_STAGE(PG8_SA(1, 0), a3, voffA);
            PG8_BAR; PG8_WAIT_L(0); PG8_MMA(1, 0, At, B0); PG8_BAR; PG8_SCHED;
            PG8_STAGE(PG8_SB(1, 1), b3 + hstep, voffB);
            PG8_WAIT_V(6); PG8_BAR; PG8_MMA(1, 1, At, B1); PG8_BAR;
            }
        }
        if constexpr (ALIGN_EPI) { if (wr == 0) PG8_BAR; }
        if constexpr (!Epi::AFTER_DRAIN) { E(acc, cur, wr, wc, fr, fq); S.done(cur); }
        if (!has_next) break;
#pragma unroll
        for (int a = 0; a < 2; ++a)
#pragma unroll
            for (int b = 0; b < 2; ++b)
#pragma unroll
                for (int m = 0; m < 4; ++m)
#pragma unroll
                    for (int n = 0; n < 2; ++n) acc[a][b][m][n] = (f32x4){0.f, 0.f, 0.f, 0.f};
        cur = nxt; cA = nA; cB = nB; ++ui;
        if constexpr (ALIGN_EPI) { if (wr == 1) PG8_BAR; }
    }
    PG8_WAIT_V(0);
    if constexpr (!ALIGN_EPI) { if (wr == 0) PG8_BAR; }
    PG8_BAR;
    if constexpr (Epi::AFTER_DRAIN) { E.fused(acc, cur, wr, wc, fr, fq, lds, wid, lane); S.done(cur); }
#undef PG8_SA
#undef PG8_SB
#undef PG8_STAGE
#undef PG8_LDA
#undef PG8_LDB
#undef PG8_MMA
#undef PG8_WAIT_V
#undef PG8_WAIT_L
#undef PG8_BAR
#undef PG8_SCHED
}
}

#ifndef PG8_SP2
#define PG8_SP2 true
#endif
#ifndef PG8_ALIGN
#define PG8_ALIGN true
#endif

#define LAS __attribute__((address_space(3)))
using pg8::bf16_t; using pg8::bf16x8; using pg8::f32x4; using pg8::u32x4;
typedef float f32x2_t __attribute__((ext_vector_type(2)));
typedef __bf16 bf16x2_t __attribute__((ext_vector_type(2)));
__device__ __forceinline__ unsigned cvt_pk_bf16(float lo, float hi) { f32x2_t v = {lo, hi}; bf16x2_t b = __builtin_convertvector(v, bf16x2_t); return __builtin_bit_cast(unsigned, b); }
typedef unsigned u32x2 __attribute__((ext_vector_type(2)));
constexpr int T = 49152, TP = 32768, D = 1024, FF = 2816, DIN = 2816, NTHR = 512;
constexpr float EPS = 1e-6f;
constexpr size_t MiB = 1u << 20;
constexpr size_t WU = (size_t)2816 * 1024 * 2;
constexpr size_t WS_WGU1 = 0, WS_WD1 = 2 * WU, WS_WIN = 3 * WU, WS_WOUT = 4 * WU, WS_WGU2 = WS_WOUT + 2 * MiB, WS_WD2 = WS_WGU2 + 2 * WU;
constexpr size_t WS_TABR = WS_WD2 + WU, WS_TABA = WS_TABR + 8192 * 64 * 8, WS_SSQ = WS_TABA + 8192 * 8 * 8;
constexpr size_t WS_ACTA = 48 * MiB, WS_ACTB = 144 * MiB, WS_HID = 240 * MiB, WS_END = 504 * MiB;
static_assert(WS_SSQ + (size_t)T * 16 * 4 <= WS_ACTA, "ws map");
static_assert(WS_ACTA + (size_t)T * D * 2 <= WS_ACTB && WS_ACTB + (size_t)T * D * 2 <= WS_HID && WS_HID + (size_t)T * FF * 2 <= WS_END, "ws map");
constexpr int LDS_BYTES = 147456;

struct Params { const float* in[18]; float* out; unsigned char* ws; int ph_lo, ph_hi; };

__device__ __forceinline__ float silu_f(float x) { return x * __builtin_amdgcn_rcpf(1.0f + __builtin_amdgcn_exp2f(-1.4426950408889634f * x)); }
__device__ __forceinline__ float fexp(float x) { return __builtin_amdgcn_exp2f(1.4426950408889634f * x); }
__device__ __forceinline__ float bf2f(unsigned short b) { return __builtin_bit_cast(float, ((unsigned)b) << 16); }
__device__ __forceinline__ unsigned f2bf(float f) { unsigned u = __builtin_bit_cast(unsigned, f); return (u + 0x7fffu + ((u >> 16) & 1u)) >> 16; }
__device__ __forceinline__ unsigned pk2(float lo, float hi) { return f2bf(lo) | (f2bf(hi) << 16); }
__device__ __forceinline__ float wave_sum(float v) {
#pragma unroll
    for (int o = 1; o < 64; o <<= 1) v += __shfl_xor(v, o);
    return v;
}
__device__ __forceinline__ int row_pos(int row) { return row < TP ? (row & 8191) : (row & 2047); }
__device__ __forceinline__ float row_rstd(const float* ssq, int row, int fq) {
    const f32x4 p = *(const f32x4*)(ssq + (size_t)row * 16 + 4 * fq);
    float s = (p[0] + p[1]) + (p[2] + p[3]);
    s += __shfl_xor(s, 16); s += __shfl_xor(s, 32);
    return __builtin_amdgcn_rsqf(s * (1.0f / 1024.0f) + EPS);
}

__device__ __forceinline__ void row_rstd8(const float* ssq, int row0, int fq, float (&r)[8]) {
    f32x4 pp[8];
#pragma unroll
    for (int q = 0; q < 8; ++q) pp[q] = *(const f32x4*)(ssq + (size_t)(row0 + (q >> 2) * 128 + (q & 3) * 16) * 16 + 4 * fq);
#pragma unroll
    for (int q = 0; q < 8; ++q) { float s = (pp[q][0] + pp[q][1]) + (pp[q][2] + pp[q][3]); s += __shfl_xor(s, 16); s += __shfl_xor(s, 32); r[q] = __builtin_amdgcn_rsqf(s * (1.0f / 1024.0f) + EPS); }
}
template <bool SCALE> struct EpiSwiGLU {
    static constexpr bool PERM = true, AFTER_DRAIN = false;
    bf16_t* O; const float* ssq;
    __device__ __forceinline__ void operator()(const f32x4 (&acc)[2][2][4][2], const pg8::Unit& u, int wr, int wc, int fr, int fq) const {
        const int row0 = u.pm * 256 + wr * 64 + fr, col0 = u.pn * 128 + wc * 32 + 8 * fq;
        float rr[8]; if (SCALE) row_rstd8(ssq, row0, fq, rr);
#pragma unroll
        for (int ai = 0; ai < 2; ++ai)
#pragma unroll
            for (int m = 0; m < 4; ++m) {
                const int row = row0 + ai * 128 + m * 16;
                float r = 1.f; if (SCALE) r = rr[ai * 4 + m];
                const f32x4 g0 = acc[ai][0][m][0] * r, g1 = acc[ai][0][m][1] * r, u0 = acc[ai][1][m][0] * r, u1 = acc[ai][1][m][1] * r;
                u32x4 w;
                f32x4 h0, h1;
#pragma unroll
                for (int j = 0; j < 4; ++j) { h0[j] = g0[j] * u0[j] * __builtin_amdgcn_rcpf(1.0f + __builtin_amdgcn_exp2f(-g0[j])); h1[j] = g1[j] * u1[j] * __builtin_amdgcn_rcpf(1.0f + __builtin_amdgcn_exp2f(-g1[j])); }
                w.x = cvt_pk_bf16(h0[0], h0[1]); w.y = cvt_pk_bf16(h0[2], h0[3]); w.z = cvt_pk_bf16(h1[0], h1[1]); w.w = cvt_pk_bf16(h1[2], h1[3]);
                *(u32x4*)(O + (size_t)row * FF + col0) = w;
            }
    }
};
template <bool RB, bool OF, bool OB, bool WS> struct EpiResid {
    static constexpr bool PERM = true, AFTER_DRAIN = false;
    const float* res0; const float* res1; const bf16_t* resb; float* out; bf16_t* outb; float* ssq; float scale;
    __device__ __forceinline__ void operator()(const f32x4 (&acc)[2][2][4][2], const pg8::Unit& u, int wr, int wc, int fr, int fq) const {
        const int row0 = u.pm * 256 + wr * 64 + fr, col0 = u.pn * 256 + wc * 32 + 8 * fq;
        const float* rb = (u.pm * 256 < TP) ? res0 : res1;
#pragma unroll
        for (int ai = 0; ai < 2; ++ai)
#pragma unroll
            for (int mp = 0; mp < 2; ++mp) {
                f32x4 x[2][2][2];
#pragma unroll
                for (int mq = 0; mq < 2; ++mq)
#pragma unroll
                    for (int bj = 0; bj < 2; ++bj) { const size_t off = (size_t)(row0 + ai * 128 + (2 * mp + mq) * 16) * D + col0 + bj * 128;
                        if (RB) { const u32x4 r = *(const u32x4*)(resb + off);
                            x[mq][bj][0] = (f32x4){__builtin_bit_cast(float, r.x << 16), __builtin_bit_cast(float, r.x & 0xffff0000u), __builtin_bit_cast(float, r.y << 16), __builtin_bit_cast(float, r.y & 0xffff0000u)};
                            x[mq][bj][1] = (f32x4){__builtin_bit_cast(float, r.z << 16), __builtin_bit_cast(float, r.z & 0xffff0000u), __builtin_bit_cast(float, r.w << 16), __builtin_bit_cast(float, r.w & 0xffff0000u)}; }
                        else { x[mq][bj][0] = *(const f32x4*)(rb + off); x[mq][bj][1] = *(const f32x4*)(rb + off + 4); } }
#pragma unroll
                for (int mq = 0; mq < 2; ++mq) { const int m = 2 * mp + mq, row = row0 + ai * 128 + m * 16; float ss = 0.f;
#pragma unroll
                    for (int bj = 0; bj < 2; ++bj) { const size_t off = (size_t)row * D + col0 + bj * 128;
                        const f32x4 v0 = x[mq][bj][0] + acc[ai][bj][m][0] * scale, v1 = x[mq][bj][1] + acc[ai][bj][m][1] * scale;
                        if (OF) { *(f32x4*)(out + off) = v0; *(f32x4*)(out + off + 4) = v1; }
                        if (OB) { u32x4 w; w.x = cvt_pk_bf16(v0[0], v0[1]); w.y = cvt_pk_bf16(v0[2], v0[3]); w.z = cvt_pk_bf16(v1[0], v1[1]); w.w = cvt_pk_bf16(v1[2], v1[3]); *(u32x4*)(outb + off) = w; }
                        if (WS) ss += ((v0[0] * v0[0] + v0[1] * v0[1]) + (v0[2] * v0[2] + v0[3] * v0[3])) + ((v1[0] * v1[0] + v1[1] * v1[1]) + (v1[2] * v1[2] + v1[3] * v1[3])); }
                    if (WS) { ss += __shfl_xor(ss, 16); ss += __shfl_xor(ss, 32); if (fq == 0) ssq[(size_t)row * 16 + u.pn * 4 + wc] = ss; } }
            }
    }
};
struct EpiProj {
    static constexpr bool PERM = true, AFTER_DRAIN = false;
    bf16_t* O; const float* ssq;
    __device__ __forceinline__ void operator()(const f32x4 (&acc)[2][2][4][2], const pg8::Unit& u, int wr, int wc, int fr, int fq) const {
        const int row0 = u.pm * 256 + wr * 64 + fr, col0 = u.pn * 256 + wc * 32 + 8 * fq;
        float rr[8]; row_rstd8(ssq, row0, fq, rr);
        float fa[4], fr4[4];
#pragma unroll
        for (int j = 0; j < 4; ++j) { fa[j] = 0.15915494309189535f * exp2f(-18.931568569324174f * ((float)(2 * (4 * fq + j)) * (1.0f / 16.0f)));
                                      fr4[j] = 0.15915494309189535f * exp2f(-13.287712379549449f * ((float)(16 * wc + 4 * fq + j) * (1.0f / 63.0f))); }
#pragma unroll
        for (int ai = 0; ai < 2; ++ai)
#pragma unroll
            for (int m = 0; m < 4; ++m) {
                const int row = row0 + ai * 128 + m * 16; const float pos = (float)row_pos(row);
                const float r = rr[ai * 4 + m];
#pragma unroll
                for (int bj = 0; bj < 2; ++bj) {
                    const int seg = 2 * u.pn + bj;
                    float sc = r; if (seg < 4) sc = r * 0.125f; if (seg >= 10 && seg < 14) sc = r * 0.08838834764831845f;
                    f32x4 v0 = acc[ai][bj][m][0] * sc, v1 = acc[ai][bj][m][1] * sc;
                    const bool rotA = (seg <= 4) && ((wc & 1) == 0) && (fq < 2), rotR = (seg >= 6 && seg < 14);
                    if (seg <= 4 || rotR) {
#pragma unroll
                        for (int j = 0; j < 4; ++j) { const float rev = pos * (rotR ? fr4[j] : fa[j]), fv = rev - __builtin_floorf(rev);
                            const float c = (rotA || rotR) ? __builtin_amdgcn_cosf(fv) : 1.0f, sn = (rotA || rotR) ? __builtin_amdgcn_sinf(fv) : 0.0f;
                            const float x1 = v0[j], x2 = v1[j]; v0[j] = x1 * c - x2 * sn; v1[j] = x2 * c + x1 * sn; }
                    }
                    u32x4 w; w.x = cvt_pk_bf16(v0[0], v0[1]); w.y = cvt_pk_bf16(v0[2], v0[3]); w.z = cvt_pk_bf16(v1[0], v1[1]); w.w = cvt_pk_bf16(v1[2], v1[3]);
                    *(u32x4*)(O + (size_t)row * DIN + col0 + bj * 128) = w;
                }
            }
    }
};

struct EpiFinal {
    static constexpr bool PERM = true, AFTER_DRAIN = false;
    const bf16_t* resb; float* out; float* xch; unsigned* cnt; const float* gain;
    __device__ __forceinline__ void operator()(const f32x4 (&acc_)[2][2][4][2], const pg8::Unit& u, int wr, int wc, int fr, int fq) const {
        f32x4 (&A)[2][2][4][2] = const_cast<f32x4 (&)[2][2][4][2]>(acc_);
        const int row0 = u.pm * 256 + wr * 64 + fr, col0 = u.pn * 256 + wc * 32 + 8 * fq, lane = threadIdx.x & 63;
#pragma unroll
        for (int ai = 0; ai < 2; ++ai)
#pragma unroll
            for (int m = 0; m < 4; ++m) {
                const int row = row0 + ai * 128 + m * 16; float ss = 0.f;
#pragma unroll
                for (int bj = 0; bj < 2; ++bj) {
                    const size_t off = (size_t)row * D + col0 + bj * 128;
                    const u32x4 r = *(const u32x4*)(resb + off);
                    const f32x4 x0 = (f32x4){__builtin_bit_cast(float, r.x << 16), __builtin_bit_cast(float, r.x & 0xffff0000u), __builtin_bit_cast(float, r.y << 16), __builtin_bit_cast(float, r.y & 0xffff0000u)};
                    const f32x4 x1 = (f32x4){__builtin_bit_cast(float, r.z << 16), __builtin_bit_cast(float, r.z & 0xffff0000u), __builtin_bit_cast(float, r.w << 16), __builtin_bit_cast(float, r.w & 0xffff0000u)};
                    const f32x4 v0 = x0 + A[ai][bj][m][0] * 0.5f, v1 = x1 + A[ai][bj][m][1] * 0.5f;
                    A[ai][bj][m][0] = v0; A[ai][bj][m][1] = v1;
                    ss += ((v0[0] * v0[0] + v0[1] * v0[1]) + (v0[2] * v0[2] + v0[3] * v0[3])) + ((v1[0] * v1[0] + v1[1] * v1[1]) + (v1[2] * v1[2] + v1[3] * v1[3]));
                }
                ss += __shfl_xor(ss, 16); ss += __shfl_xor(ss, 32);
                if (fq == 0) __hip_atomic_store(xch + (size_t)row * 16 + u.pn * 4 + wc, ss, __ATOMIC_RELAXED, __HIP_MEMORY_SCOPE_AGENT);
            }
        asm volatile("s_waitcnt vmcnt(0)" ::: "memory");
        unsigned* cw = cnt + 64 * u.pm;
        if (lane == 0) __hip_atomic_fetch_add(cw, 1u, __ATOMIC_RELAXED, __HIP_MEMORY_SCOPE_AGENT);
        { unsigned spins = 0;
          while ((unsigned)__builtin_amdgcn_readfirstlane(__hip_atomic_load(cw, __ATOMIC_RELAXED, __HIP_MEMORY_SCOPE_AGENT)) < 32u) { if (++spins > (1u << 22)) break; __builtin_amdgcn_s_sleep(2); } }
        __builtin_amdgcn_fence(__ATOMIC_ACQUIRE, "agent");
        asm volatile("s_waitcnt vmcnt(0)" ::: "memory");
        f32x4 g[2][2];
#pragma unroll
        for (int bj = 0; bj < 2; ++bj) { g[bj][0] = *(const f32x4*)(gain + col0 + bj * 128); g[bj][1] = *(const f32x4*)(gain + col0 + bj * 128 + 4); }
#pragma unroll
        for (int ai = 0; ai < 2; ++ai)
#pragma unroll
            for (int m = 0; m < 4; ++m) {
                const int row = row0 + ai * 128 + m * 16; const float* xp = xch + (size_t)row * 16 + 4 * fq;
                float s = (__hip_atomic_load(xp + 0, __ATOMIC_RELAXED, __HIP_MEMORY_SCOPE_AGENT) + __hip_atomic_load(xp + 1, __ATOMIC_RELAXED, __HIP_MEMORY_SCOPE_AGENT))
                        + (__hip_atomic_load(xp + 2, __ATOMIC_RELAXED, __HIP_MEMORY_SCOPE_AGENT) + __hip_atomic_load(xp + 3, __ATOMIC_RELAXED, __HIP_MEMORY_SCOPE_AGENT));
                s += __shfl_xor(s, 16); s += __shfl_xor(s, 32);
                const float rstd = __builtin_amdgcn_rsqf(s * (1.0f / 1024.0f) + EPS);
#pragma unroll
                for (int bj = 0; bj < 2; ++bj) { const size_t off = (size_t)row * D + col0 + bj * 128;
                    *(f32x4*)(out + off) = A[ai][bj][m][0] * rstd * g[bj][0]; *(f32x4*)(out + off + 4) = A[ai][bj][m][1] * rstd * g[bj][1]; }
            }
    }
};

__device__ __forceinline__ void p0_item(const float* W, int ldw, int sc, const float* gain, int gain_lim, bf16_t* WT, int K, int n0, int k0, LAS float* scr, int lane, float cs = 1.0f) {
    float wv[32];
#pragma unroll
    for (int i = 0; i < 32; ++i) { const int k = k0 + 2 * i + (lane >> 5); wv[i] = W[(size_t)k * ldw + sc]; }
#pragma unroll
    for (int i = 0; i < 32; ++i) { const int kk = 2 * i + (lane >> 5), k = k0 + kk; float v = wv[i] * cs; if (gain && k < gain_lim) v *= gain[k]; scr[kk * 33 + (lane & 31)] = v; }
    asm volatile("s_waitcnt lgkmcnt(0)" ::: "memory");
    const int c = lane & 7;
#pragma unroll
    for (int j = 0; j < 4; ++j) { const int n = (lane >> 3) + 8 * j; const LAS float* s = scr + (8 * c) * 33 + n;
        u32x4 o; o.x = pk2(s[0 * 33], s[1 * 33]); o.y = pk2(s[2 * 33], s[3 * 33]); o.z = pk2(s[4 * 33], s[5 * 33]); o.w = pk2(s[6 * 33], s[7 * 33]);
        *(u32x4*)(WT + (size_t)(n0 + n) * K + k0 + 8 * c) = o; }
    asm volatile("s_waitcnt lgkmcnt(0)" ::: "memory");
}
__device__ __forceinline__ int win_srccol(int n) {
    if (n < 640) { const int p = n & 63; if (p < 16) return (n - p) + ((p & 3) | ((p & 4) << 1) | ((p & 8) >> 1)); return n; }
    if (n >= 768 && n < 1792) { const int p = (n - 768) & 127, q = p >> 3, nn = (p >> 2) & 1, j = p & 3; return (n - p) + nn * 64 + 4 * q + j; }
    return n;
}
__device__ __forceinline__ void p0_prologue(const Params& p, LAS unsigned char* lds, int G) {
    const int tid = threadIdx.x, lane = tid & 63, wave = tid >> 6;
    LAS float* scr = (LAS float*)(lds + wave * 16384);
    const int gw = blockIdx.x * 8 + wave, NGW = G * 8;
    constexpr int I_GU = 16 * 176, I_D = 44 * 32, I_IN = 16 * 88, I_OUT = 16 * 32;
    constexpr int NITEMS = 2 * I_GU + 2 * I_D + I_IN + I_OUT;
    for (int it = gw; it < NITEMS; it += NGW) {
        int r = it;
        if (r < 2 * I_GU) {
            const int which = r / I_GU; r -= which * I_GU; const int nb = r % 176, kb = r / 176, n0 = nb * 32;
            const int pn = n0 >> 8, q = n0 & 255, bj = q >> 7, hid = pn * 128 + (q & 127) + (lane & 31);
            const float* W = which == 0 ? (bj ? p.in[4] : p.in[3]) : (bj ? p.in[15] : p.in[14]);
            p0_item(W, FF, hid, which == 0 ? nullptr : p.in[13], 1 << 30, (bf16_t*)(p.ws + (which == 0 ? WS_WGU1 : WS_WGU2)), D, n0, kb * 64, scr, lane, bj ? 0.6931471805599453f : 1.4426950408889634f); continue; }
        r -= 2 * I_GU;
        if (r < 2 * I_D) {
            const int which = r / I_D; r -= which * I_D; const int nb = r % 32, kb = r / 32, n0 = nb * 32;
            p0_item(which == 0 ? p.in[5] : p.in[16], D, n0 + (lane & 31), nullptr, 0, (bf16_t*)(p.ws + (which == 0 ? WS_WD1 : WS_WD2)), FF, n0, kb * 64, scr, lane); continue; }
        r -= 2 * I_D;
        if (r < I_IN) { const int nb = r % 88, kb = r / 88, n0 = nb * 32;
            p0_item(p.in[7], DIN, win_srccol(n0 + (lane & 31)), p.in[6], 1 << 30, (bf16_t*)(p.ws + WS_WIN), D, n0, kb * 64, scr, lane); continue; }
        r -= I_IN;
        { const int nb = r % 32, kb = r / 32, n0 = nb * 32;
            p0_item(p.in[12], D, n0 + (lane & 31), p.in[9], 512, (bf16_t*)(p.ws + WS_WOUT), D, n0, kb * 64, scr, lane); }
    }
    bf16_t* XN = (bf16_t*)(p.ws + WS_ACTA);
    const f32x4* gp = (const f32x4*)p.in[2] + lane;
    for (int rb = gw * 4; rb < T; rb += NGW * 4) {
        f32x4 v[4][4]; float s[4];
#pragma unroll
        for (int q = 0; q < 4; ++q) { const int row = rb + q; const float* xrow = row < TP ? p.in[0] + (size_t)row * D : p.in[1] + (size_t)(row - TP) * D; const f32x4* xr = (const f32x4*)xrow + lane;
#pragma unroll
            for (int j = 0; j < 4; ++j) v[q][j] = xr[64 * j]; }
#pragma unroll
        for (int q = 0; q < 4; ++q) { float a = 0.f;
#pragma unroll
            for (int j = 0; j < 4; ++j) a += (v[q][j][0] * v[q][j][0] + v[q][j][1] * v[q][j][1]) + (v[q][j][2] * v[q][j][2] + v[q][j][3] * v[q][j][3]);
            s[q] = a; }
#pragma unroll
        for (int q = 0; q < 4; ++q) { const float rstd = __builtin_amdgcn_rsqf(wave_sum(s[q]) * (1.f / D) + EPS);
            u32x2* o8 = (u32x2*)(XN + (size_t)(rb + q) * D) + lane;
#pragma unroll
            for (int j = 0; j < 4; ++j) { const f32x4 g = gp[64 * j]; u32x2 w; w.x = pk2(v[q][j][0] * rstd * g[0], v[q][j][1] * rstd * g[1]); w.y = pk2(v[q][j][2] * rstd * g[2], v[q][j][3] * rstd * g[3]); o8[64 * j] = w; } }
    }
}

#define MMA16(b, a, c) __builtin_amdgcn_mfma_f32_16x16x32_bf16((b), (a), (c), 0, 0, 0)
#define LDS16(ptr) (*(const LAS bf16x8*)(ptr))
typedef short v4i16_t __attribute__((ext_vector_type(4)));
__device__ __forceinline__ bf16x8 tr_frag(const LAS bf16_t* p, int pitch) {
    const v4i16_t lo = __builtin_amdgcn_ds_read_tr16_b64_v4i16((LAS v4i16_t*)p), hi = __builtin_amdgcn_ds_read_tr16_b64_v4i16((LAS v4i16_t*)(p + 4 * pitch));
    return (bf16x8){lo[0], lo[1], lo[2], lo[3], hi[0], hi[1], hi[2], hi[3]};
}

__device__ __forceinline__ void attn_phase(const Params& p, LAS unsigned char* lds, int G) {
    const int tid = threadIdx.x, lane = tid & 63, wave = tid >> 6, fr = lane & 15, fq = lane >> 4;
    const bf16_t* proj = (const bf16_t*)(p.ws + WS_HID); bf16_t* mix = (bf16_t*)(p.ws + WS_ACTB);
    LAS bf16_t* Kl = (LAS bf16_t*)lds;
    LAS bf16_t* Vl = (LAS bf16_t*)(lds + 18432);
    LAS bf16_t* Pl = (LAS bf16_t*)(lds + 36864 + wave * 9216);
    LAS float* stat = (LAS float*)(lds + 110592);
    const int h = wave, kvh = h >> 2;
    const float sink = p.in[8][h];
    const int skey = tid >> 3, sdch = tid & 7;
    const int trb = (8 * fq + (fr >> 2)) * 72 + 4 * (fr & 3);
    u32x4 pk[2], pv[2];
#define ATT_RANGE(r0, lo, hi) do { int ss_, se_; if ((r0) < TP) { ss_ = (r0) & ~8191; se_ = ss_ + 8192; } else { ss_ = TP + (((r0) - TP) & ~2047); se_ = ss_ + 2048; } \
        lo = ((r0) - 128 < ss_) ? ((ss_ - ((r0) - 128)) >> 6) : 0; hi = ((r0) + 128 >= se_) ? (((se_ - 64) - ((r0) - 128)) >> 6) : 4; } while (0)
#define ATT_ISSUE(r0, kb) do { const bf16_t* src_ = proj + (size_t)((r0) - 128 + 64 * (kb) + skey) * DIN + 512 + sdch * 8; \
        pk[0] = *(const u32x4*)src_; pv[0] = *(const u32x4*)(src_ + 128); pk[1] = *(const u32x4*)(src_ + 64); pv[1] = *(const u32x4*)(src_ + 192); } while (0)
    int unit = blockIdx.x;
    if (unit < T / 64) { int lo, hi; ATT_RANGE(unit * 64, lo, hi); ATT_ISSUE(unit * 64, lo); (void)hi; }
    for (; unit < T / 64; unit += G) {
        const int row0 = unit * 64; int kb_lo, kb_hi; ATT_RANGE(row0, kb_lo, kb_hi);
        bf16x8 qf[4][2];
#pragma unroll
        for (int m = 0; m < 4; ++m)
#pragma unroll
            for (int k = 0; k < 2; ++k) qf[m][k] = *(const bf16x8*)(proj + (size_t)(row0 + 16 * m + fr) * DIN + h * 64 + 32 * k + 8 * fq);
        f32x4 o[4][4]; float mrow[4], lrow[4];
#pragma unroll
        for (int m = 0; m < 4; ++m) { mrow[m] = sink; lrow[m] = 1.f;
#pragma unroll
            for (int n = 0; n < 4; ++n) o[m][n] = (f32x4){0.f, 0.f, 0.f, 0.f}; }
        for (int kb = kb_lo; kb <= kb_hi; ++kb) {
            const int kstart = row0 - 128 + 64 * kb;
            __syncthreads();
#pragma unroll
            for (int i = 0; i < 2; ++i) {
                *(LAS u32x4*)(Kl + (i * 64 + skey) * 72 + sdch * 8) = pk[i]; *(LAS u32x4*)(Vl + (i * 64 + skey) * 72 + sdch * 8) = pv[i];
            }
            __syncthreads();
            if (kb < kb_hi) { ATT_ISSUE(row0, kb + 1); }
            else if (unit + G < T / 64) { int lo2, hi2; ATT_RANGE((unit + G) * 64, lo2, hi2); ATT_ISSUE((unit + G) * 64, lo2); (void)hi2; }
            bf16x8 kf[4][2];
#pragma unroll
            for (int n = 0; n < 4; ++n) { kf[n][0] = LDS16(Kl + (kvh * 64 + 16 * n + fr) * 72 + 8 * fq); kf[n][1] = LDS16(Kl + (kvh * 64 + 16 * n + fr) * 72 + 32 + 8 * fq); }
            const bool edge = (kb == 0) || (kb == 4);
#pragma unroll
            for (int m = 0; m < 4; ++m) {
                f32x4 s[4];
#pragma unroll
                for (int n = 0; n < 4; ++n) { f32x4 a = (f32x4){0.f, 0.f, 0.f, 0.f}; a = MMA16(kf[n][0], qf[m][0], a); a = MMA16(kf[n][1], qf[m][1], a); s[n] = a; }
                const int i = row0 + 16 * m + fr; float mx = mrow[m];
                if (edge) {
#pragma unroll
                    for (int n = 0; n < 4; ++n)
#pragma unroll
                        for (int e = 0; e < 4; ++e) { const int j = kstart + 16 * n + 4 * fq + e, dlt = i - j; const bool valid = (dlt <= 128) && (dlt >= -128); s[n][e] = valid ? s[n][e] : -1e30f; }
                }
#pragma unroll
                for (int n = 0; n < 4; ++n) mx = fmaxf(fmaxf(mx, fmaxf(s[n][0], s[n][1])), fmaxf(s[n][2], s[n][3]));
                mx = fmaxf(mx, __shfl_xor(mx, 16)); mx = fmaxf(mx, __shfl_xor(mx, 32));
                const float alpha = fexp(mrow[m] - mx); mrow[m] = mx; float ps = 0.f; const float mxl = mx * 1.4426950408889634f;
#pragma unroll
                for (int n = 0; n < 4; ++n) {
                    f32x4 pvv;
#pragma unroll
                    for (int e = 0; e < 4; ++e) { pvv[e] = __builtin_amdgcn_exp2f(s[n][e] * 1.4426950408889634f - mxl); ps += pvv[e]; }
                    u32x2 w; w.x = cvt_pk_bf16(pvv[0], pvv[1]); w.y = cvt_pk_bf16(pvv[2], pvv[3]);
                    *(LAS u32x2*)(Pl + (16 * m + fr) * 72 + 16 * n + 4 * fq) = w;
                    o[m][n] = o[m][n] * alpha;
                }
                ps += __shfl_xor(ps, 16); ps += __shfl_xor(ps, 32);
                lrow[m] = lrow[m] * alpha + ps;
            }
            asm volatile("s_waitcnt lgkmcnt(0)" ::: "memory");
            {
#pragma unroll
                for (int k = 0; k < 2; ++k) {
                    bf16x8 pa[4], vb[4];
#pragma unroll
                    for (int m = 0; m < 4; ++m) pa[m] = LDS16(Pl + (16 * m + fr) * 72 + 32 * k + 8 * fq);
#pragma unroll
                    for (int n = 0; n < 4; ++n) vb[n] = tr_frag(Vl + (kvh * 64 + 32 * k) * 72 + trb + 16 * n, 72);
#pragma unroll
                    for (int n = 0; n < 4; ++n)
#pragma unroll
                        for (int m = 0; m < 4; ++m) o[m][n] = MMA16(vb[n], pa[m], o[m][n]);
                }
            }
        }
#pragma unroll
        for (int m = 0; m < 4; ++m) { const float inv = 1.0f / lrow[m]; float ss = 0.f;
#pragma unroll
            for (int n = 0; n < 4; ++n) { o[m][n] = o[m][n] * inv; ss += (o[m][n][0] * o[m][n][0] + o[m][n][1] * o[m][n][1]) + (o[m][n][2] * o[m][n][2] + o[m][n][3] * o[m][n][3]); }
            ss += __shfl_xor(ss, 16); ss += __shfl_xor(ss, 32);
            if (fq == 0) stat[h * 64 + 16 * m + fr] = ss; }
        __syncthreads();
#pragma unroll
        for (int m = 0; m < 4; ++m) { float tot = 0.f;
#pragma unroll
            for (int hh = 0; hh < 8; ++hh) tot += stat[hh * 64 + 16 * m + fr];
            const float rn = __builtin_amdgcn_rsqf(tot * (1.0f / 512.0f) + EPS);
#pragma unroll
            for (int n = 0; n < 4; ++n) { const f32x4 v = o[m][n] * rn; u32x2 w; w.x = cvt_pk_bf16(v[0], v[1]); w.y = cvt_pk_bf16(v[2], v[3]);
                *(u32x2*)(mix + (size_t)(row0 + 16 * m + fr) * D + h * 64 + 16 * n + 4 * fq) = w; } }
    }
#undef ATT_RANGE
#undef ATT_ISSUE
    __syncthreads();
}

__device__ __forceinline__ void ret_kv_phase(const Params& p, LAS unsigned char* lds, int G) {
    const int tid = threadIdx.x, lane = tid & 63, wave = tid >> 6, fr = lane & 15, fq = lane >> 4;
    const bf16_t* proj = (const bf16_t*)(p.ws + WS_HID); bf16_t* kvbuf = (bf16_t*)p.out;
    LAS bf16_t* Vl = (LAS bf16_t*)lds; LAS bf16_t* Kf = (LAS bf16_t*)(lds + 34816); LAS bf16_t* Kb = (LAS bf16_t*)(lds + 69632);
    const int stok = tid >> 4, sdch = tid & 15;
    const int trb = (8 * fq + (fr >> 2)) * 136 + 4 * (fr & 3);
    u32x4 pk[4], pv[4];
#define R1_ISSUE(u_) do { const bf16_t* src_ = proj + (size_t)(((u_) >> 2) * 128 + stok) * DIN + 1280 + ((u_) & 3) * 128 + sdch * 8; \
        _Pragma("unroll") for (int i_ = 0; i_ < 4; ++i_) { pk[i_] = *(const u32x4*)(src_ + (size_t)i_ * 32 * DIN); pv[i_] = *(const u32x4*)(src_ + 512 + (size_t)i_ * 32 * DIN); } } while (0)
    int unit = blockIdx.x;
    if (unit < (T / 128) * 4) R1_ISSUE(unit);
    for (; unit < (T / 128) * 4; unit += G) {
        const int c = unit >> 2, h = unit & 3;
        const float ldf = p.in[10][h], ldb = p.in[11][h];
        __syncthreads();
#pragma unroll
        for (int i = 0; i < 4; ++i) {
            const int tok = stok + 32 * i; const float wf = fexp(ldf * (float)(127 - tok)), wb = fexp(ldb * (float)tok);
            const unsigned kw[4] = {pk[i].x, pk[i].y, pk[i].z, pk[i].w}; u32x4 of, ob; unsigned fo[4], bo[4];
#pragma unroll
            for (int q = 0; q < 4; ++q) { const float k0 = bf2f((unsigned short)(kw[q] & 0xffffu)), k1 = bf2f((unsigned short)(kw[q] >> 16)); fo[q] = cvt_pk_bf16(k0 * wf, k1 * wf); bo[q] = cvt_pk_bf16(k0 * wb, k1 * wb); }
            of.x = fo[0]; of.y = fo[1]; of.z = fo[2]; of.w = fo[3]; ob.x = bo[0]; ob.y = bo[1]; ob.z = bo[2]; ob.w = bo[3];
            *(LAS u32x4*)(Vl + tok * 136 + sdch * 8) = pv[i]; *(LAS u32x4*)(Kf + tok * 136 + sdch * 8) = of; *(LAS u32x4*)(Kb + tok * 136 + sdch * 8) = ob;
        }
        __syncthreads();
        if (unit + G < (T / 128) * 4) R1_ISSUE(unit + G);
        const int dir = wave >> 2, mt0 = (wave & 3) * 2; LAS bf16_t* Kx = dir ? Kb : Kf;
        f32x4 acc[2][8];
#pragma unroll
        for (int mi = 0; mi < 2; ++mi)
#pragma unroll
            for (int n = 0; n < 8; ++n) acc[mi][n] = (f32x4){0.f, 0.f, 0.f, 0.f};
#pragma unroll
        for (int k = 0; k < 4; ++k) {
            const bf16x8 a0 = tr_frag(Vl + 32 * k * 136 + trb + (mt0 + 0) * 16, 136), a1 = tr_frag(Vl + 32 * k * 136 + trb + (mt0 + 1) * 16, 136);
            bf16x8 bf[8];
#pragma unroll
            for (int n = 0; n < 8; ++n) bf[n] = tr_frag(Kx + 32 * k * 136 + trb + 16 * n, 136);
#pragma unroll
            for (int n = 0; n < 8; ++n) { acc[0][n] = MMA16(bf[n], a0, acc[0][n]); acc[1][n] = MMA16(bf[n], a1, acc[1][n]); }
        }
        bf16_t* dst = kvbuf + ((size_t)(c * 4 + h) * 2 + dir) * 16384;
#pragma unroll
        for (int mi = 0; mi < 2; ++mi)
#pragma unroll
            for (int n = 0; n < 8; ++n) { u32x2 w; w.x = cvt_pk_bf16(acc[mi][n][0], acc[mi][n][1]); w.y = cvt_pk_bf16(acc[mi][n][2], acc[mi][n][3]);
                *(u32x2*)(dst + ((mt0 + mi) * 16 + fr) * 128 + 16 * n + 4 * fq) = w; }
    }
#undef R1_ISSUE
}

__device__ __forceinline__ void ret_scan_phase(const Params& p, int G) {
    bf16_t* kvbuf = (bf16_t*)p.out;
    const int nthr = G * NTHR;
    for (int t = blockIdx.x * NTHR + threadIdx.x; t < 131072; t += nthr) {
        {
            const int e4 = t & 4095, sdh = t >> 12, dir = sdh & 1, h = (sdh >> 1) & 3, b = sdh >> 3, c0 = 64 * b;
            const float Dk = fexp((dir ? p.in[11][h] : p.in[10][h]) * 128.0f);
            float st[4] = {0.f, 0.f, 0.f, 0.f};
            for (int sb = 0; sb < 64; sb += 16) {
                u32x2 v[16];
#pragma unroll
                for (int i = 0; i < 16; ++i) { const int c = dir ? (c0 + 63 - sb - i) : (c0 + sb + i); v[i] = *(const u32x2*)(kvbuf + ((size_t)(c * 4 + h) * 2 + dir) * 16384 + e4 * 4); }
#pragma unroll
                for (int i = 0; i < 16; ++i) { const int c = dir ? (c0 + 63 - sb - i) : (c0 + sb + i);
                    u32x2 w; w.x = pk2(st[0], st[1]); w.y = pk2(st[2], st[3]); *(u32x2*)(kvbuf + ((size_t)(c * 4 + h) * 2 + dir) * 16384 + e4 * 4) = w;
                    st[0] = st[0] * Dk + bf2f((unsigned short)(v[i].x & 0xffffu)); st[1] = st[1] * Dk + bf2f((unsigned short)(v[i].x >> 16));
                    st[2] = st[2] * Dk + bf2f((unsigned short)(v[i].y & 0xffffu)); st[3] = st[3] * Dk + bf2f((unsigned short)(v[i].y >> 16)); }
            }
        }
        {
            const int e8 = t & 2047, sdh = t >> 11, dir = sdh & 1, h = (sdh >> 1) & 3, b = sdh >> 3, c0 = 256 + 16 * b;
            const float Dk = fexp((dir ? p.in[11][h] : p.in[10][h]) * 128.0f);
            float st[8] = {0.f, 0.f, 0.f, 0.f, 0.f, 0.f, 0.f, 0.f};
            u32x4 v[16];
#pragma unroll
            for (int i = 0; i < 16; ++i) { const int c = dir ? (c0 + 15 - i) : (c0 + i); v[i] = *(const u32x4*)(kvbuf + ((size_t)(c * 4 + h) * 2 + dir) * 16384 + e8 * 8); }
#pragma unroll
            for (int i = 0; i < 16; ++i) { const int c = dir ? (c0 + 15 - i) : (c0 + i);
                u32x4 w; w.x = pk2(st[0], st[1]); w.y = pk2(st[2], st[3]); w.z = pk2(st[4], st[5]); w.w = pk2(st[6], st[7]); *(u32x4*)(kvbuf + ((size_t)(c * 4 + h) * 2 + dir) * 16384 + e8 * 8) = w;
                const unsigned vv[4] = {v[i].x, v[i].y, v[i].z, v[i].w};
#pragma unroll
                for (int q = 0; q < 4; ++q) { st[2 * q] = st[2 * q] * Dk + bf2f((unsigned short)(vv[q] & 0xffffu)); st[2 * q + 1] = st[2 * q + 1] * Dk + bf2f((unsigned short)(vv[q] >> 16)); }
            }
        }
    }
}

__device__ __forceinline__ void ret_out_phase(const Params& p, LAS unsigned char* lds, int G) {
    const int tid = threadIdx.x, lane = tid & 63, wave = tid >> 6, fr = lane & 15, fq = lane >> 4;
    const bf16_t* proj = (const bf16_t*)(p.ws + WS_HID); const bf16_t* kvbuf = (const bf16_t*)p.out; bf16_t* mix = (bf16_t*)(p.ws + WS_ACTB);
    LAS bf16_t* Ql = (LAS bf16_t*)lds; LAS bf16_t* Kl = (LAS bf16_t*)(lds + 34816); LAS bf16_t* Vl = (LAS bf16_t*)(lds + 69632); LAS bf16_t* Pl = (LAS bf16_t*)(lds + 104448);
    const int stok = tid >> 4, sdch = tid & 15;
    const int trb = (8 * fq + (fr >> 2)) * 136 + 4 * (fr & 3);
    const int il = 16 * wave + fr;
    u32x4 pq[4], pk[4], pv[4];
#define R3_ISSUE(u_) do { const bf16_t* src_ = proj + (size_t)(((u_) >> 2) * 128 + stok) * DIN + 768 + ((u_) & 3) * 128 + sdch * 8; \
        _Pragma("unroll") for (int i_ = 0; i_ < 4; ++i_) { pq[i_] = *(const u32x4*)(src_ + (size_t)i_ * 32 * DIN); pk[i_] = *(const u32x4*)(src_ + 512 + (size_t)i_ * 32 * DIN); pv[i_] = *(const u32x4*)(src_ + 1024 + (size_t)i_ * 32 * DIN); } } while (0)
    int unit = blockIdx.x;
    if (unit < (T / 128) * 4) R3_ISSUE(unit);
    for (; unit < (T / 128) * 4; unit += G) {
        const int c = unit >> 2, h = unit & 3, row0 = c * 128;
        const float ldf = p.in[10][h], ldb = p.in[11][h]; const float ldf2 = ldf * 1.4426950408889634f, ldb2 = ldb * 1.4426950408889634f;
        __syncthreads();
#pragma unroll
        for (int i = 0; i < 4; ++i) {
            const int tok = stok + 32 * i;
            *(LAS u32x4*)(Ql + tok * 136 + sdch * 8) = pq[i]; *(LAS u32x4*)(Kl + tok * 136 + sdch * 8) = pk[i]; *(LAS u32x4*)(Vl + tok * 136 + sdch * 8) = pv[i];
        }
        __syncthreads();
        if (unit + G < (T / 128) * 4) R3_ISSUE(unit + G);
        u32x4 sfr[4], sbr[4]; u32x2 gv[8];
        { const bf16_t* gsrc = proj + (size_t)(row0 + il) * DIN + 2304 + h * 128 + 4 * fq;
#pragma unroll
            for (int n = 0; n < 8; ++n) gv[n] = *(const u32x2*)(gsrc + 16 * n); }
        {
            const bf16_t* sf = kvbuf + ((size_t)(c * 4 + h) * 2) * 16384 + stok * 128 + sdch * 8;
#pragma unroll
            for (int i = 0; i < 4; ++i) { sfr[i] = *(const u32x4*)(sf + i * 32 * 128); sbr[i] = *(const u32x4*)(sf + 16384 + i * 32 * 128); }
        }
        bf16x8 qa[4];
#pragma unroll
        for (int k = 0; k < 4; ++k) qa[k] = LDS16(Ql + il * 136 + 32 * k + 8 * fq);
        f32x4 o1[8];
        {
            f32x4 s[8];
#pragma unroll
            for (int n = 0; n < 8; ++n) s[n] = (f32x4){0.f, 0.f, 0.f, 0.f};
#pragma unroll
            for (int k = 0; k < 4; ++k) {
#pragma unroll
                for (int nh = 0; nh < 2; ++nh) { bf16x8 bf[4];
#pragma unroll
                    for (int n = 0; n < 4; ++n) bf[n] = LDS16(Kl + (16 * (4 * nh + n) + fr) * 136 + 32 * k + 8 * fq);
#pragma unroll
                    for (int n = 0; n < 4; ++n) s[4 * nh + n] = MMA16(bf[n], qa[k], s[4 * nh + n]); }
            }
#pragma unroll
            for (int n = 0; n < 8; ++n) { f32x4 pvv;
#pragma unroll
                for (int e = 0; e < 4; ++e) { const int j = 16 * n + 4 * fq + e, dlt = il - j; const float coef = dlt > 0 ? ldf2 : ldb2; const float ex = __builtin_amdgcn_exp2f(coef * (float)(dlt > 0 ? dlt : -dlt)); pvv[e] = s[n][e] * (dlt == 0 ? 2.0f : ex); }
                u32x2 w; w.x = cvt_pk_bf16(pvv[0], pvv[1]); w.y = cvt_pk_bf16(pvv[2], pvv[3]);
                *(LAS u32x2*)(Pl + il * 136 + 16 * n + 4 * fq) = w; }
            asm volatile("s_waitcnt lgkmcnt(0)" ::: "memory");
            bf16x8 pa[4];
#pragma unroll
            for (int k = 0; k < 4; ++k) pa[k] = LDS16(Pl + il * 136 + 32 * k + 8 * fq);
#pragma unroll
            for (int n = 0; n < 8; ++n) o1[n] = (f32x4){0.f, 0.f, 0.f, 0.f};
#pragma unroll
            for (int k = 0; k < 4; ++k) {
#pragma unroll
                for (int nh = 0; nh < 2; ++nh) { bf16x8 bf[4];
#pragma unroll
                    for (int n = 0; n < 4; ++n) bf[n] = tr_frag(Vl + 32 * k * 136 + trb + 16 * (4 * nh + n), 136);
#pragma unroll
                    for (int n = 0; n < 4; ++n) o1[4 * nh + n] = MMA16(bf[n], pa[k], o1[4 * nh + n]); }
            }
        }
        __syncthreads();
#pragma unroll
        for (int i = 0; i < 4; ++i) { const int dv = stok + 32 * i; *(LAS u32x4*)(Kl + dv * 136 + sdch * 8) = sfr[i]; *(LAS u32x4*)(Pl + dv * 136 + sdch * 8) = sbr[i]; }
        __syncthreads();
        {
            const float ef = fexp(ldf * (float)(il + 1)), eb = fexp(ldb * (float)(128 - il));
#pragma unroll
            for (int pass = 0; pass < 2; ++pass) {
                const LAS bf16_t* St = pass ? Pl : Kl; const float ew = pass ? eb : ef;
#pragma unroll
                for (int nh = 0; nh < 2; ++nh) {
                    f32x4 a[4];
#pragma unroll
                    for (int n = 0; n < 4; ++n) a[n] = (f32x4){0.f, 0.f, 0.f, 0.f};
#pragma unroll
                    for (int k = 0; k < 4; ++k) {
                        bf16x8 bf[4];
#pragma unroll
                        for (int n = 0; n < 4; ++n) bf[n] = LDS16(St + (16 * (4 * nh + n) + fr) * 136 + 32 * k + 8 * fq);
#pragma unroll
                        for (int n = 0; n < 4; ++n) a[n] = MMA16(bf[n], qa[k], a[n]);
                    }
#pragma unroll
                    for (int n = 0; n < 4; ++n) o1[4 * nh + n] = o1[4 * nh + n] + a[n] * ew;
                }
            }
        }
        float sm = 0.f;
#pragma unroll
        for (int n = 0; n < 8; ++n) sm += (o1[n][0] + o1[n][1]) + (o1[n][2] + o1[n][3]);
        sm += __shfl_xor(sm, 16); sm += __shfl_xor(sm, 32);
        const float mu = sm * (1.0f / 128.0f); float sq = 0.f;
#pragma unroll
        for (int n = 0; n < 8; ++n) { o1[n] = o1[n] - mu; sq += (o1[n][0] * o1[n][0] + o1[n][1] * o1[n][1]) + (o1[n][2] * o1[n][2] + o1[n][3] * o1[n][3]); }
        sq += __shfl_xor(sq, 16); sq += __shfl_xor(sq, 32);
        const float rs = __builtin_amdgcn_rsqf(sq * (1.0f / 128.0f) + EPS);
        bf16_t* dst = mix + (size_t)(row0 + il) * D + 512 + h * 128 + 4 * fq;
#pragma unroll
        for (int n = 0; n < 8; ++n) { const u32x2 g = gv[n];
            const float g0 = bf2f((unsigned short)(g.x & 0xffffu)), g1 = bf2f((unsigned short)(g.x >> 16)), g2 = bf2f((unsigned short)(g.y & 0xffffu)), g3 = bf2f((unsigned short)(g.y >> 16));
            u32x2 w; w.x = cvt_pk_bf16(silu_f(g0) * o1[n][0] * rs, silu_f(g1) * o1[n][1] * rs); w.y = cvt_pk_bf16(silu_f(g2) * o1[n][2] * rs, silu_f(g3) * o1[n][3] * rs);
            *(u32x2*)(dst + 16 * n) = w; }
    }
#undef R3_ISSUE
}

__device__ __forceinline__ void final_norm_phase(const Params& p, int G) {
    const int lane = threadIdx.x & 63, wave = threadIdx.x >> 6; const int gw = blockIdx.x * 8 + wave, NGW = G * 8;
    const f32x4* gp = (const f32x4*)p.in[17] + lane;
    for (int row = gw; row < T; row += NGW) {
        f32x4* xr = (f32x4*)(p.out + (size_t)row * D) + lane; f32x4 v[4]; float s = 0.f;
#pragma unroll
        for (int j = 0; j < 4; ++j) { v[j] = xr[64 * j]; s += (v[j][0] * v[j][0] + v[j][1] * v[j][1]) + (v[j][2] * v[j][2] + v[j][3] * v[j][3]); }
        const float rstd = __builtin_amdgcn_rsqf(wave_sum(s) * (1.f / D) + EPS);
#pragma unroll
        for (int j = 0; j < 4; ++j) xr[64 * j] = v[j] * rstd * gp[64 * j];
    }
}

#define XB_TMO      128
#define XB_XCNT(j)  (256  + 64 * (j))
#define XB_XSUB(j)  (1280 + 64 * (j))
#define XB_XGEN(j)  (2304 + 64 * (j))
#define XB_TOP      3328
#define XB_TOPGEN   3392
#define XCD_BAR_WORDS 3456
#define XB_SPIN_CAP (1u << 18)

__device__ __forceinline__ unsigned xb_ld(unsigned* p)              { return __hip_atomic_load(p, __ATOMIC_RELAXED, __HIP_MEMORY_SCOPE_AGENT); }
__device__ __forceinline__ unsigned xb_add(unsigned* p, unsigned v) { return __hip_atomic_fetch_add(p, v, __ATOMIC_RELAXED, __HIP_MEMORY_SCOPE_AGENT); }
__device__ __forceinline__ unsigned xb_xcc_id() { return (unsigned)__builtin_amdgcn_s_getreg((3 << 11) | 20) & 0xFu; }
#define XB_SPIN(cond, bar) do { unsigned _sp = 0; while (cond) { __builtin_amdgcn_s_sleep(1); \
    if ((++_sp & 255u) == 0u) { if (xb_ld(&(bar)[XB_TMO])) break; if (_sp > XB_SPIN_CAP) { atomicAdd(&(bar)[XB_TMO], 1u); break; } } } } while (0)

struct XcdBarrier {
    unsigned* bar; unsigned x;
    volatile LAS unsigned* st;
};

__device__ __forceinline__ XcdBarrier xcd_barrier_post(unsigned* bar, volatile LAS unsigned* st) {
    XcdBarrier b; b.bar = bar; b.x = xb_xcc_id(); b.st = st;
    if (threadIdx.x == 0) (void)xb_add(&bar[XB_XCNT(b.x)], 1u);
    return b;
}
__device__ __forceinline__ void xcd_barrier_complete(unsigned* bar, unsigned x, unsigned& nloc, unsigned& nx) {
    const unsigned G = gridDim.x * gridDim.y * gridDim.z;
    unsigned sum, cnt, mine, sp = 0u;
    for (;;) {
        sum = 0u; cnt = 0u; mine = 0u;
#pragma unroll
        for (unsigned j = 0; j < 16; ++j) { const unsigned c = xb_ld(&bar[XB_XCNT(j)]); sum += c; cnt += (c > 0u) ? 1u : 0u; mine = (j == x) ? c : mine; }
        if (sum == G) break;
        __builtin_amdgcn_s_sleep(1);
        if ((++sp & 255u) == 0u) { if (xb_ld(&bar[XB_TMO])) break; if (sp > XB_SPIN_CAP) { atomicAdd(&bar[XB_TMO], 1u); break; } }
    }
    nloc = mine > 0u ? mine : 1u; nx = cnt > 0u ? cnt : 1u;
}

__device__ __forceinline__ void xcd_barrier(const XcdBarrier& b) {
    asm volatile("s_waitcnt vmcnt(0)" ::: "memory");
    __syncthreads();
    if (threadIdx.x == 0) {
        unsigned* bar = b.bar;
        __builtin_amdgcn_s_waitcnt(0);
        unsigned nloc = b.st[0], nx = b.st[1];
        if (nloc == 0u) { xcd_barrier_complete(bar, b.x, nloc, nx); b.st[0] = nloc; b.st[1] = nx; }
        const unsigned old = xb_add(&bar[XB_XSUB(b.x)], 1u);
        const unsigned gen = old / nloc;
        if (old + 1u == (gen + 1u) * nloc) {
            __builtin_amdgcn_fence(__ATOMIC_RELEASE, "agent");
            asm volatile("s_waitcnt vmcnt(0)" ::: "memory");
            const unsigned og = xb_add(&bar[XB_TOP], 1u);
            const unsigned tg = og / nx;
            if (og + 1u == (tg + 1u) * nx) xb_add(&bar[XB_TOPGEN], 1u);
            else XB_SPIN(xb_ld(&bar[XB_TOPGEN]) == tg, bar);
            __builtin_amdgcn_fence(__ATOMIC_ACQUIRE, "agent");
            xb_add(&bar[XB_XGEN(b.x)], 1u);
            asm volatile("s_waitcnt vmcnt(0)" ::: "memory");
        } else {
            XB_SPIN(xb_ld(&bar[XB_XGEN(b.x)]) == gen, bar);
            __builtin_amdgcn_fence(__ATOMIC_ACQUIRE, "agent");
            asm volatile("s_waitcnt vmcnt(0)" ::: "memory");
        }
    }
    __syncthreads();
}

constexpr int NPHASE = 11;
__global__ void __launch_bounds__(NTHR, 2) mk_fwd(Params p) {
    extern __shared__ __attribute__((aligned(16))) unsigned char lds_raw[];
    LAS unsigned char* lds = (LAS unsigned char*)lds_raw;
    const int G = gridDim.x, lo = p.ph_lo, hi = p.ph_hi;
    cg::grid_group grid = cg::this_grid();
#define IN(k) (lo <= (k) && (k) < hi)
    volatile LAS unsigned* bst = (volatile LAS unsigned*)(lds + 147392);
    if (threadIdx.x == 0) { bst[0] = 0u; bst[1] = 0u; }
    __syncthreads();
    XcdBarrier xbar = xcd_barrier_post((unsigned*)(p.ws + WS_TABR) + 192 * 64, bst);
    unsigned* rankw = (unsigned*)(p.ws + WS_TABR) + 192 * 64 + 3584;
    if (threadIdx.x == 0) { const unsigned x = xb_xcc_id() & 7u; const unsigned r = __hip_atomic_fetch_add(rankw + 8 * x, 1u, __ATOMIC_RELAXED, __HIP_MEMORY_SCOPE_AGENT); bst[2] = r * 8u + x; }
    if (p.ph_lo < -1000) grid.sync();
#define SEAM(k) do { if (IN(k) && IN((k) + 1)) xcd_barrier(xbar); } while (0)
    bf16_t* ACTA = (bf16_t*)(p.ws + WS_ACTA); bf16_t* ACTB = (bf16_t*)(p.ws + WS_ACTB); bf16_t* HID = (bf16_t*)(p.ws + WS_HID);
    float* SSQ = (float*)(p.ws + WS_SSQ);
    if (IN(0)) { p0_prologue(p, lds, G); if (DUP & 1) { __syncthreads(); p0_prologue(p, lds, G); } }
    SEAM(0);
    int vc = (int)blockIdx.x;
    if (IN(0) && IN(1) && G == 256) {
        if (threadIdx.x == 0) { unsigned ok = 1u; for (int j = 0; j < 8; ++j) ok &= (__hip_atomic_load(rankw + 8 * j, __ATOMIC_RELAXED, __HIP_MEMORY_SCOPE_AGENT) == 32u) ? 1u : 0u; bst[3] = ok; }
        __syncthreads();
        if (bst[3]) vc = (int)bst[2];
    }
    if (IN(1)) {
        pg8::Gemm g{ACTA, (const bf16_t*)(p.ws + WS_WGU1), T, 2 * FF, D}; pg8::StaticOrder S; S.init(T, 2 * FF, G, vc);
        EpiSwiGLU<false> E{HID, nullptr};
        pg8::gemm_phase<EpiSwiGLU<false>, pg8::StaticOrder, PG8_ALIGN, PG8_SP2>(lds, g, S, E);
        if (DUP & 16) { __syncthreads(); pg8::gemm_phase<EpiSwiGLU<false>, pg8::StaticOrder, PG8_ALIGN, PG8_SP2>(lds, g, S, E); }
    }
    SEAM(1);
    if (IN(2)) {
        pg8::Gemm g{HID, (const bf16_t*)(p.ws + WS_WD1), T, D, FF}; pg8::StaticOrder S; S.init(T, D, G, vc);
        EpiResid<false, false, true, true> E{p.in[0], p.in[1] - (size_t)TP * D, nullptr, nullptr, ACTA, SSQ, 0.5f};
        pg8::gemm_phase<EpiResid<false, false, true, true>, pg8::StaticOrder, PG8_ALIGN, PG8_SP2>(lds, g, S, E);
    }
    SEAM(2);
    if (IN(3)) {
        pg8::Gemm g{ACTA, (const bf16_t*)(p.ws + WS_WIN), T, DIN, D}; pg8::StaticOrder S; S.init(T, DIN, G, vc);
        EpiProj E{HID, SSQ};
        pg8::gemm_phase<EpiProj, pg8::StaticOrder, PG8_ALIGN, PG8_SP2>(lds, g, S, E);
        if (DUP & 32) { __syncthreads(); pg8::gemm_phase<EpiProj, pg8::StaticOrder, PG8_ALIGN, PG8_SP2>(lds, g, S, E); }
    }
    SEAM(3);
    if (IN(4)) { attn_phase(p, lds, G); ret_kv_phase(p, lds, G); if (DUP & 2) { attn_phase(p, lds, G); } if (DUP & 4) { ret_kv_phase(p, lds, G); } }
    SEAM(4);
    if (IN(5)) { ret_scan_phase(p, G); }
    SEAM(5);
    if (IN(6)) { ret_out_phase(p, lds, G); if (DUP & 8) { ret_out_phase(p, lds, G); } }
    SEAM(6);
    if (IN(7)) {
        __syncthreads();
        pg8::Gemm g{ACTB, (const bf16_t*)(p.ws + WS_WOUT), T, D, D}; pg8::StaticOrder S; S.init(T, D, G, vc);
        EpiResid<true, false, true, true> E{nullptr, nullptr, ACTA, nullptr, ACTA, SSQ, 1.0f};
        pg8::gemm_phase<EpiResid<true, false, true, true>, pg8::StaticOrder, PG8_ALIGN, PG8_SP2>(lds, g, S, E);
    }
    SEAM(7);
    if (IN(8)) {
        pg8::Gemm g{ACTA, (const bf16_t*)(p.ws + WS_WGU2), T, 2 * FF, D}; pg8::StaticOrder S; S.init(T, 2 * FF, G, vc);
        EpiSwiGLU<true> E{HID, SSQ};
        pg8::gemm_phase<EpiSwiGLU<true>, pg8::StaticOrder, PG8_ALIGN, PG8_SP2>(lds, g, S, E);
    }
    SEAM(8);
    const bool fused_final = (G == 256) && IN(10);
    if (IN(9)) {
        pg8::Gemm g{HID, (const bf16_t*)(p.ws + WS_WD2), T, D, FF}; pg8::StaticOrder S; S.init(T, D, G, vc);
        if (fused_final) { EpiFinal E{ACTA, p.out, SSQ, (unsigned*)(p.ws + WS_TABR), p.in[17]};
            pg8::gemm_phase<EpiFinal, pg8::StaticOrder, PG8_ALIGN, PG8_SP2>(lds, g, S, E); }
        else { EpiResid<true, true, false, false> E{nullptr, nullptr, ACTA, p.out, nullptr, nullptr, 0.5f};
            pg8::gemm_phase<EpiResid<true, true, false, false>, pg8::StaticOrder, PG8_ALIGN, PG8_SP2>(lds, g, S, E); }
    }
    if (!fused_final) { SEAM(9); if (IN(10)) { final_norm_phase(p, G); } }
#undef IN
#undef SEAM
}

extern "C" void kernel_launch(void* const* d_in, const int* in_sizes, int n_in, void* d_out, int out_size, void* d_ws, size_t ws_size, hipStream_t stream) {
    static int grid = 0;
    if (grid == 0) {
        if (n_in != 18 || out_size != T * D || ws_size < WS_END) { fprintf(stderr, "kernel_launch: unexpected shapes (n_in %d, out %d, ws %zu)\n", n_in, out_size, ws_size); grid = -1; return; }
        int dev = 0, cus = 0, per_cu = 0;
        if (hipGetDevice(&dev) != hipSuccess || hipDeviceGetAttribute(&cus, hipDeviceAttributeMultiprocessorCount, dev) != hipSuccess) { grid = -1; return; }
        if (hipFuncSetAttribute((const void*)mk_fwd, hipFuncAttributeMaxDynamicSharedMemorySize, LDS_BYTES) != hipSuccess) { fprintf(stderr, "kernel_launch: hipFuncSetAttribute failed\n"); grid = -1; return; }
        if (hipOccupancyMaxActiveBlocksPerMultiprocessor(&per_cu, (const void*)mk_fwd, NTHR, LDS_BYTES) != hipSuccess || per_cu < 1) { fprintf(stderr, "kernel_launch: occupancy query says %d\n", per_cu); per_cu = 1; }
        (void)hipGetLastError();
        grid = cus;
    }
    if (grid < 0) return;
    if (hipMemsetAsync((unsigned char*)d_ws + WS_TABR, 0, (192 * 64 + 4096) * 4, stream) != hipSuccess) { fprintf(stderr, "kernel_launch: memset of the control words failed\n"); return; }
    Params a{};
    for (int i = 0; i < 18; ++i) a.in[i] = (const float*)d_in[i];
    a.out = (float*)d_out; a.ws = (unsigned char*)d_ws;
#if MK_ONE_LAUNCH
    a.ph_lo = 0; a.ph_hi = NPHASE;
    void* args[] = {&a};
    hipError_t e = hipLaunchCooperativeKernel((const void*)mk_fwd, dim3(grid), dim3(NTHR), args, LDS_BYTES, stream);
    if (e != hipSuccess) fprintf(stderr, "kernel_launch: cooperative launch failed: %s (grid %d)\n", hipGetErrorString(e), grid);
#else
    for (int ph = 0; ph < NPHASE; ++ph) { a.ph_lo = ph; a.ph_hi = ph + 1; hipLaunchKernelGGL(mk_fwd, dim3(grid), dim3(NTHR), LDS_BYTES, stream, a); }
#endif
}
```

```cpp
#include <hip/hip_runtime.h>
#include <hip/hip_cooperative_groups.h>
#include <cstdio>
#include <cstdint>
namespace cg = cooperative_groups;
#ifndef DUP
#define DUP 0
#endif
#ifndef MK_ONE_LAUNCH
#define MK_ONE_LAUNCH 1
#endif
namespace pg8 {
#define PG8_LAS __attribute__((address_space(3)))
typedef unsigned short bf16_t;
typedef short bf16x8 __attribute__((ext_vector_type(8)));
typedef float f32x4 __attribute__((ext_vector_type(4)));
typedef unsigned u32x4 __attribute__((ext_vector_type(4)));
constexpr int BM = 256, BK = 64, HALF = 128, HTB = HALF * BK * 2  , STAGE_BYTES = 8 * HTB, NXCD = 8, WGM = 8;

__host__ __device__ __forceinline__ int lds_byte(int r, int c) { const int st = (r >> 4) * 2 + (c >> 5), rr = r & 15, cc = c & 31, ob = rr * 64 + cc * 2; return st * 1024 + (ob ^ (((ob >> 9) & 1) << 5)); }
__host__ __device__ __forceinline__ void stage_rc(int b, int& R, int& C) { const int st = b / 1024, sb = b % 1024, swz = sb ^ (((sb >> 9) & 1) << 5); R = (st >> 1) * 16 + swz / 64; C = (st & 1) * 32 + (swz % 64) / 2; }
__host__ __device__ __forceinline__ int perm32(int rho) { const int n = rho >> 4, i = rho & 15; return 8 * (i >> 2) + 4 * n + (i & 3); }

struct Unit { int pm, pn; };
struct Gemm { const bf16_t* A; const bf16_t* Bt; int M, N, K; };

struct StaticOrder {
    int nM, nN, nwg, G, c;
    __host__ __device__ void init(int M, int N, int G_, int c_) { nM = M / BM; nN = N / BM; nwg = nM * nN; G = G_; c = c_; }
    __host__ __device__ bool next(int i, Unit& u) const {
        const long L = (long)i * G + c; if (L >= nwg) return false;
        int wgid = (int)L; { const int q = nwg / NXCD, r = nwg % NXCD, xcd = wgid % NXCD, off = wgid / NXCD; wgid = (xcd < r ? xcd * (q + 1) : r * (q + 1) + (xcd - r) * q) + off; }
        const int nig = WGM * nN, gid = wgid / nig, fm = gid * WGM, gsz = (nM - fm) < WGM ? (nM - fm) : WGM;
        u.pm = fm + ((wgid % nig) % gsz); u.pn = (wgid % nig) / gsz; return true;
    }
    __device__ __forceinline__ void a_ready(const Unit&) const {}
    __device__ __forceinline__ void done(const Unit&) const {}
};

__device__ __forceinline__ unsigned cvt_pk_bf16(float lo, float hi) { unsigned r; asm volatile("v_cvt_pk_bf16_f32 %0, %1, %2" : "=v"(r) : "v"(lo), "v"(hi)); return r; }
typedef float f32x2 __attribute__((ext_vector_type(2)));
template <class Epi, class Sched, bool ALIGN_EPI = false, bool SP2 = false>
__device__ __forceinline__ void gemm_phase(PG8_LAS unsigned char* lds, const Gemm g, const Sched& S, const Epi& E) {
    const int tid = threadIdx.x, wid = __builtin_amdgcn_readfirstlane(tid >> 6), lane = tid & 63, wr = wid >> 2, wc = wid & 3, fr = lane & 15, fq = lane >> 4;
    const int K = g.K, nt = K / BK;
    unsigned voffA[2], voffB[2];
#pragma unroll
    for (int i = 0; i < 2; ++i) { int R, C; stage_rc(tid * 16 + i * 8192, R, C); const int Rb = Epi::PERM ? ((R & ~31) + perm32(R & 31)) : R;
        voffA[i] = (unsigned)(R * K + C) * 2u; voffB[i] = (unsigned)(Rb * K + C) * 2u; }
    const size_t kstep = (size_t)(BK * 2);
    const size_t hstep = (size_t)HALF * K * 2;
    const size_t tstep = 2 * hstep;
    const unsigned ldsw = (unsigned)wid * 1024u;
    const int aoff = lds_byte(wr * 64 + fr, fq * 8), boff = lds_byte(wc * 32 + fr, fq * 8);
#define PG8_SA(b, h) (((b) * 2 + (h)) * HTB)
#define PG8_SB(b, h) ((4 + (b) * 2 + (h)) * HTB)
#define PG8_STAGE(bufoff, gbase, voff) do { _Pragma("unroll") for (int _i = 0; _i < 2; ++_i) \
        __builtin_amdgcn_global_load_lds((const unsigned*)((const char*)(gbase) + (voff)[_i]), (PG8_LAS unsigned*)(lds + (bufoff) + ldsw + _i * 8192), 16, 0, 0); } while (0)
#define PG8_LDA(dst, b, h) do { _Pragma("unroll") for (int m = 0; m < 4; ++m) _Pragma("unroll") for (int k = 0; k < 2; ++k) dst[m][k] = *(const PG8_LAS bf16x8*)(lds + PG8_SA(b, h) + aoff + m * 2048 + k * 1024); } while (0)
#define PG8_LDB(dst, b, h) do { _Pragma("unroll") for (int n = 0; n < 2; ++n) _Pragma("unroll") for (int k = 0; k < 2; ++k) dst[n][k] = *(const PG8_LAS bf16x8*)(lds + PG8_SB(b, h) + boff + n * 2048 + k * 1024); } while (0)
#define PG8_MMA(ai, bj, At, Bt) do { __builtin_amdgcn_s_setprio(1); _Pragma("unroll") for (int m = 0; m < 4; ++m) _Pragma("unroll") for (int n = 0; n < 2; ++n) _Pragma("unroll") for (int k = 0; k < 2; ++k) \
        acc[ai][bj][m][n] = __builtin_amdgcn_mfma_f32_16x16x32_bf16(Bt[n][k], At[m][k], acc[ai][bj][m][n], 0, 0, 0); __builtin_amdgcn_s_setprio(0); } while (0)
#define PG8_WAIT_V(n) asm volatile("s_waitcnt vmcnt(" #n ")" ::: "memory")
#define PG8_WAIT_L(n) asm volatile("s_waitcnt lgkmcnt(" #n ")" ::: "memory")
#define PG8_BAR __builtin_amdgcn_s_barrier()
#define PG8_SCHED __builtin_amdgcn_sched_barrier(0)
    Unit cur, nxt; int ui = 0;
    if (!S.next(0, cur)) return;
    f32x4 acc[2][2][4][2];
#pragma unroll
    for (int a = 0; a < 2; ++a)
#pragma unroll
        for (int b = 0; b < 2; ++b)
#pragma unroll
            for (int m = 0; m < 4; ++m)
#pragma unroll
                for (int n = 0; n < 2; ++n) acc[a][b][m][n] = (f32x4){0.f, 0.f, 0.f, 0.f};
    bf16x8 At[4][2], B0[2][2], B1[2][2];
    const char* cA = (const char*)g.A + (size_t)cur.pm * tstep; const char* cB = (const char*)g.Bt + (size_t)cur.pn * tstep;
    S.a_ready(cur);
    if constexpr (SP2) {
        PG8_STAGE(PG8_SB(0, 0), cB, voffB); PG8_STAGE(PG8_SB(0, 1), cB + hstep, voffB); PG8_STAGE(PG8_SA(0, 0), cA, voffA); PG8_STAGE(PG8_SA(0, 1), cA + hstep, voffA);
        if (wr == 1) PG8_BAR;
        PG8_WAIT_V(2); PG8_BAR;
        PG8_STAGE(PG8_SB(1, 0), cB + kstep, voffB); PG8_STAGE(PG8_SA(1, 0), cA + kstep, voffA); PG8_STAGE(PG8_SB(1, 1), cB + hstep + kstep, voffB);
        PG8_WAIT_V(6); PG8_BAR;
    } else {
        PG8_STAGE(PG8_SB(0, 0), cB, voffB); PG8_STAGE(PG8_SA(0, 0), cA, voffA); PG8_STAGE(PG8_SB(0, 1), cB + hstep, voffB); PG8_STAGE(PG8_SA(0, 1), cA + hstep, voffA);
        if (wr == 1) PG8_BAR;
        PG8_WAIT_V(4); PG8_BAR;
        PG8_STAGE(PG8_SB(1, 0), cB + kstep, voffB); PG8_STAGE(PG8_SA(1, 0), cA + kstep, voffA); PG8_STAGE(PG8_SB(1, 1), cB + hstep + kstep, voffB);
        PG8_WAIT_V(6); PG8_BAR;
    }
    for (;;) {
        const bool has_next = S.next(ui + 1, nxt);
        const char* nA = has_next ? (const char*)g.A + (size_t)nxt.pm * tstep : cA; const char* nB = has_next ? (const char*)g.Bt + (size_t)nxt.pn * tstep : cB;
        for (int t = 0; t < nt; t += 2) {
            const bool last = (t == nt - 2);
            const char* a1 = cA + (size_t)(t + 1) * kstep;
            const char* a2 = last ? nA : cA + (size_t)(t + 2) * kstep; const char* b2 = last ? nB : cB + (size_t)(t + 2) * kstep;
            const char* a3 = a2 + kstep; const char* b3 = b2 + kstep;
            if (last && has_next) S.a_ready(nxt);
            if constexpr (SP2) {
            PG8_LDB(B0, 0, 0); PG8_LDB(B1, 0, 1); PG8_SCHED; PG8_LDA(At, 0, 0); PG8_STAGE(PG8_SA(1, 1), a1 + hstep, voffA);
            PG8_WAIT_V(8); PG8_WAIT_L(0); PG8_BAR; PG8_MMA(0, 0, At, B0); PG8_MMA(0, 1, At, B1); PG8_BAR; PG8_SCHED;
            PG8_LDA(At, 0, 1); PG8_STAGE(PG8_SB(0, 0), b2, voffB); PG8_STAGE(PG8_SB(0, 1), b2 + hstep, voffB); PG8_STAGE(PG8_SA(0, 0), a2, voffA);
            PG8_WAIT_V(8); PG8_WAIT_L(0); PG8_BAR; PG8_MMA(1, 0, At, B0); PG8_MMA(1, 1, At, B1); PG8_BAR; PG8_SCHED;
            PG8_LDB(B0, 1, 0); PG8_LDB(B1, 1, 1); PG8_SCHED; PG8_LDA(At, 1, 0); PG8_STAGE(PG8_SA(0, 1), a2 + hstep, voffA);
            PG8_WAIT_V(8); PG8_WAIT_L(0); PG8_BAR; PG8_MMA(0, 0, At, B0); PG8_MMA(0, 1, At, B1); PG8_BAR; PG8_SCHED;
            PG8_LDA(At, 1, 1); PG8_STAGE(PG8_SB(1, 0), b3, voffB); PG8_STAGE(PG8_SB(1, 1), b3 + hstep, voffB); PG8_STAGE(PG8_SA(1, 0), a3, voffA);
            PG8_WAIT_V(8); PG8_WAIT_L(0); PG8_BAR; PG8_MMA(1, 0, At, B0); PG8_MMA(1, 1, At, B1); PG8_BAR; PG8_SCHED;
            } else {
            PG8_LDB(B0, 0, 0); PG8_SCHED; PG8_LDA(At, 0, 0); PG8_STAGE(PG8_SA(1, 1), a1 + hstep, voffA);
            PG8_WAIT_L(8); PG8_BAR; PG8_WAIT_L(0); PG8_MMA(0, 0, At, B0); PG8_BAR; PG8_SCHED;
            PG8_LDB(B1, 0, 1); PG8_STAGE(PG8_SB(0, 0), b2, voffB);
            PG8_BAR; PG8_WAIT_L(0); PG8_MMA(0, 1, At, B1); PG8_BAR;
            PG8_LDA(At, 0, 1); PG8_STAGE(PG8_SA(0, 0), a2, voffA);
            PG8_BAR; PG8_WAIT_L(0); PG8_MMA(1, 0, At, B0); PG8_BAR; PG8_SCHED;
            PG8_STAGE(PG8_SB(0, 1), b2 + hstep, voffB);
            PG8_WAIT_V(6); PG8_BAR; PG8_MMA(1, 1, At, B1); PG8_BAR;
            PG8_LDB(B0, 1, 0); PG8_SCHED; PG8_LDA(At, 1, 0); PG8_STAGE(PG8_SA(0, 1), a2 + hstep, voffA);
            PG8_WAIT_L(8); PG8_BAR; PG8_WAIT_L(0); PG8_MMA(0, 0, At, B0); PG8_BAR; PG8_SCHED;
            PG8_LDB(B1, 1, 1); PG8_STAGE(PG8_SB(1, 0), b3, voffB);
            PG8_BAR; PG8_WAIT_L(0); PG8_MMA(0, 1, At, B1); PG8_BAR;
            PG8_LDA(At, 1, 1); PG8_STAGE(PG8_SA(1, 0), a3, voffA);
            PG8_BAR; PG8_WAIT_L(0); PG8_MMA(1, 0, At, B0); PG8_BAR; PG8_SCHED;
            PG8_STAGE(PG8_SB(1, 1), b3 + hstep, voffB);
            PG8_WAIT_V(6); PG8_BAR; PG8_MMA(1, 1, At, B1); PG8_BAR;
            }
        }
        if constexpr (ALIGN_EPI) { if (wr == 0) PG8_BAR; }
        if constexpr (!Epi::AFTER_DRAIN) { E(acc, cur, wr, wc, fr, fq); S.done(cur); }
        if (!has_next) break;
#pragma unroll
        for (int a = 0; a < 2; ++a)
#pragma unroll
            for (int b = 0; b < 2; ++b)
#pragma unroll
                for (int m = 0; m < 4; ++m)
#pragma unroll
                    for (int n = 0; n < 2; ++n) acc[a][b][m][n] = (f32x4){0.f, 0.f, 0.f, 0.f};
        cur = nxt; cA = nA; cB = nB; ++ui;
        if constexpr (ALIGN_EPI) { if (wr == 1) PG8_BAR; }
    }
    PG8_WAIT_V(0);
    if constexpr (!ALIGN_EPI) { if (wr == 0) PG8_BAR; }
    PG8_BAR;
    if constexpr (Epi::AFTER_DRAIN) { E.fused(acc, cur, wr, wc, fr, fq, lds, wid, lane); S.done(cur); }
#undef PG8_SA
#undef PG8_SB
#undef PG8_STAGE
#undef PG8_LDA
#undef PG8_LDB
#undef PG8_MMA
#undef PG8_WAIT_V
#undef PG8_WAIT_L
#undef PG8_BAR
#undef PG8_SCHED
}
}

#ifndef PG8_SP2
#define PG8_SP2 true
#endif
#ifndef PG8_ALIGN
#define PG8_ALIGN true
#endif

#define LAS __attribute__((address_space(3)))
using pg8::bf16_t; using pg8::bf16x8; using pg8::f32x4; using pg8::u32x4;
typedef float f32x2_t __attribute__((ext_vector_type(2)));
typedef __bf16 bf16x2_t __attribute__((ext_vector_type(2)));
__device__ __forceinline__ unsigned cvt_pk_bf16(float lo, float hi) { f32x2_t v = {lo, hi}; bf16x2_t b = __builtin_convertvector(v, bf16x2_t); return __builtin_bit_cast(unsigned, b); }
typedef unsigned u32x2 __attribute__((ext_vector_type(2)));
constexpr int T = 49152, TP = 32768, D = 1024, FF = 2816, DIN = 2816, NTHR = 512;
constexpr float EPS = 1e-6f;
constexpr size_t MiB = 1u << 20;
constexpr size_t WU = (size_t)2816 * 1024 * 2;
constexpr size_t WS_WGU1 = 0, WS_WD1 = 2 * WU, WS_WIN = 3 * WU, WS_WOUT = 4 * WU, WS_WGU2 = WS_WOUT + 2 * MiB, WS_WD2 = WS_WGU2 + 2 * WU;
constexpr size_t WS_TABR = WS_WD2 + WU, WS_TABA = WS_TABR + 8192 * 64 * 8, WS_SSQ = WS_TABA + 8192 * 8 * 8;
constexpr size_t WS_ACTA = 48 * MiB, WS_ACTB = 144 * MiB, WS_HID = 240 * MiB, WS_END = 504 * MiB;
static_assert(WS_SSQ + (size_t)T * 16 * 4 <= WS_ACTA, "ws map");
static_assert(WS_ACTA + (size_t)T * D * 2 <= WS_ACTB && WS_ACTB + (size_t)T * D * 2 <= WS_HID && WS_HID + (size_t)T * FF * 2 <= WS_END, "ws map");
constexpr int LDS_BYTES = 147456;

struct Params { const float* in[18]; float* out; unsigned char* ws; int ph_lo, ph_hi; };

__device__ __forceinline__ float silu_f(float x) { return x * __builtin_amdgcn_rcpf(1.0f + __builtin_amdgcn_exp2f(-1.4426950408889634f * x)); }
__device__ __forceinline__ float fexp(float x) { return __builtin_amdgcn_exp2f(1.4426950408889634f * x); }
__device__ __forceinline__ float bf2f(unsigned short b) { return __builtin_bit_cast(float, ((unsigned)b) << 16); }
__device__ __forceinline__ unsigned f2bf(float f) { unsigned u = __builtin_bit_cast(unsigned, f); return (u + 0x7fffu + ((u >> 16) & 1u)) >> 16; }
__device__ __forceinline__ unsigned pk2(float lo, float hi) { return f2bf(lo) | (f2bf(hi) << 16); }
__device__ __forceinline__ float wave_sum(float v) {
#pragma unroll
    for (int o = 1; o < 64; o <<= 1) v += __shfl_xor(v, o);
    return v;
}
__device__ __forceinline__ int row_pos(int row) { return row < TP ? (row & 8191) : (row & 2047); }
__device__ __forceinline__ float row_rstd(const float* ssq, int row, int fq) {
    const f32x4 p = *(const f32x4*)(ssq + (size_t)row * 16 + 4 * fq);
    float s = (p[0] + p[1]) + (p[2] + p[3]);
    s += __shfl_xor(s, 16); s += __shfl_xor(s, 32);
    return __builtin_amdgcn_rsqf(s * (1.0f / 1024.0f) + EPS);
}

__device__ __forceinline__ void row_rstd8(const float* ssq, int row0, int fq, float (&r)[8]) {
    f32x4 pp[8];
#pragma unroll
    for (int q = 0; q < 8; ++q) pp[q] = *(const f32x4*)(ssq + (size_t)(row0 + (q >> 2) * 128 + (q & 3) * 16) * 16 + 4 * fq);
#pragma unroll
    for (int q = 0; q < 8; ++q) { float s = (pp[q][0] + pp[q][1]) + (pp[q][2] + pp[q][3]); s += __shfl_xor(s, 16); s += __shfl_xor(s, 32); r[q] = __builtin_amdgcn_rsqf(s * (1.0f / 1024.0f) + EPS); }
}
template <bool SCALE> struct EpiSwiGLU {
    static constexpr bool PERM = true, AFTER_DRAIN = false;
    bf16_t* O; const float* ssq;
    __device__ __forceinline__ void operator()(const f32x4 (&acc)[2][2][4][2], const pg8::Unit& u, int wr, int wc, int fr, int fq) const {
        const int row0 = u.pm * 256 + wr * 64 + fr, col0 = u.pn * 128 + wc * 32 + 8 * fq;
        float rr[8]; if (SCALE) row_rstd8(ssq, row0, fq, rr);
#pragma unroll
        for (int ai = 0; ai < 2; ++ai)
#pragma unroll
            for (int m = 0; m < 4; ++m) {
                const int row = row0 + ai * 128 + m * 16;
                float r = 1.f; if (SCALE) r = rr[ai * 4 + m];
                const f32x4 g0 = acc[ai][0][m][0] * r, g1 = acc[ai][0][m][1] * r, u0 = acc[ai][1][m][0] * r, u1 = acc[ai][1][m][1] * r;
                u32x4 w;
                w.x = cvt_pk_bf16(silu_f(g0[0]) * u0[0], silu_f(g0[1]) * u0[1]); w.y = cvt_pk_bf16(silu_f(g0[2]) * u0[2], silu_f(g0[3]) * u0[3]);
                w.z = cvt_pk_bf16(silu_f(g1[0]) * u1[0], silu_f(g1[1]) * u1[1]); w.w = cvt_pk_bf16(silu_f(g1[2]) * u1[2], silu_f(g1[3]) * u1[3]);
                *(u32x4*)(O + (size_t)row * FF + col0) = w;
            }
    }
};
template <bool RB, bool OF, bool OB, bool WS> struct EpiResid {
    static constexpr bool PERM = true, AFTER_DRAIN = false;
    const float* res0; const float* res1; const bf16_t* resb; float* out; bf16_t* outb; float* ssq; float scale;
    __device__ __forceinline__ void operator()(const f32x4 (&acc)[2][2][4][2], const pg8::Unit& u, int wr, int wc, int fr, int fq) const {
        const int row0 = u.pm * 256 + wr * 64 + fr, col0 = u.pn * 256 + wc * 32 + 8 * fq;
        const float* rb = (u.pm * 256 < TP) ? res0 : res1;
#pragma unroll
        for (int ai = 0; ai < 2; ++ai)
#pragma unroll
            for (int mp = 0; mp < 2; ++mp) {
                f32x4 x[2][2][2];
#pragma unroll
                for (int mq = 0; mq < 2; ++mq)
#pragma unroll
                    for (int bj = 0; bj < 2; ++bj) { const size_t off = (size_t)(row0 + ai * 128 + (2 * mp + mq) * 16) * D + col0 + bj * 128;
                        if (RB) { const u32x4 r = *(const u32x4*)(resb + off);
                            x[mq][bj][0] = (f32x4){__builtin_bit_cast(float, r.x << 16), __builtin_bit_cast(float, r.x & 0xffff0000u), __builtin_bit_cast(float, r.y << 16), __builtin_bit_cast(float, r.y & 0xffff0000u)};
                            x[mq][bj][1] = (f32x4){__builtin_bit_cast(float, r.z << 16), __builtin_bit_cast(float, r.z & 0xffff0000u), __builtin_bit_cast(float, r.w << 16), __builtin_bit_cast(float, r.w & 0xffff0000u)}; }
                        else { x[mq][bj][0] = *(const f32x4*)(rb + off); x[mq][bj][1] = *(const f32x4*)(rb + off + 4); } }
#pragma unroll
                for (int mq = 0; mq < 2; ++mq) { const int m = 2 * mp + mq, row = row0 + ai * 128 + m * 16; float ss = 0.f;
#pragma unroll
                    for (int bj = 0; bj < 2; ++bj) { const size_t off = (size_t)row * D + col0 + bj * 128;
                        const f32x4 v0 = x[mq][bj][0] + acc[ai][bj][m][0] * scale, v1 = x[mq][bj][1] + acc[ai][bj][m][1] * scale;
                        if (OF) { *(f32x4*)(out + off) = v0; *(f32x4*)(out + off + 4) = v1; }
                        if (OB) { u32x4 w; w.x = cvt_pk_bf16(v0[0], v0[1]); w.y = cvt_pk_bf16(v0[2], v0[3]); w.z = cvt_pk_bf16(v1[0], v1[1]); w.w = cvt_pk_bf16(v1[2], v1[3]); *(u32x4*)(outb + off) = w; }
                        if (WS) ss += ((v0[0] * v0[0] + v0[1] * v0[1]) + (v0[2] * v0[2] + v0[3] * v0[3])) + ((v1[0] * v1[0] + v1[1] * v1[1]) + (v1[2] * v1[2] + v1[3] * v1[3])); }
                    if (WS) { ss += __shfl_xor(ss, 16); ss += __shfl_xor(ss, 32); if (fq == 0) ssq[(size_t)row * 16 + u.pn * 4 + wc] = ss; } }
            }
    }
};
struct EpiProj {
    static constexpr bool PERM = true, AFTER_DRAIN = false;
    bf16_t* O; const float* ssq;
    __device__ __forceinline__ void operator()(const f32x4 (&acc)[2][2][4][2], const pg8::Unit& u, int wr, int wc, int fr, int fq) const {
        const int row0 = u.pm * 256 + wr * 64 + fr, col0 = u.pn * 256 + wc * 32 + 8 * fq;
        float rr[8]; row_rstd8(ssq, row0, fq, rr);
        float fa[4], fr4[4];
#pragma unroll
        for (int j = 0; j < 4; ++j) { fa[j] = 0.15915494309189535f * exp2f(-18.931568569324174f * ((float)(2 * (4 * fq + j)) * (1.0f / 16.0f)));
                                      fr4[j] = 0.15915494309189535f * exp2f(-13.287712379549449f * ((float)(16 * wc + 4 * fq + j) * (1.0f / 63.0f))); }
#pragma unroll
        for (int ai = 0; ai < 2; ++ai)
#pragma unroll
            for (int m = 0; m < 4; ++m) {
                const int row = row0 + ai * 128 + m * 16; const float pos = (float)row_pos(row);
                const float r = rr[ai * 4 + m];
#pragma unroll
                for (int bj = 0; bj < 2; ++bj) {
                    const int seg = 2 * u.pn + bj;
                    float sc = r; if (seg < 4) sc = r * 0.125f; if (seg >= 10 && seg < 14) sc = r * 0.08838834764831845f;
                    f32x4 v0 = acc[ai][bj][m][0] * sc, v1 = acc[ai][bj][m][1] * sc;
                    const bool rotA = (seg <= 4) && ((wc & 1) == 0) && (fq < 2), rotR = (seg >= 6 && seg < 14);
                    if (seg <= 4 || rotR) {
#pragma unroll
                        for (int j = 0; j < 4; ++j) { const float rev = pos * (rotR ? fr4[j] : fa[j]), fv = rev - __builtin_floorf(rev);
                            const float c = (rotA || rotR) ? __builtin_amdgcn_cosf(fv) : 1.0f, sn = (rotA || rotR) ? __builtin_amdgcn_sinf(fv) : 0.0f;
                            const float x1 = v0[j], x2 = v1[j]; v0[j] = x1 * c - x2 * sn; v1[j] = x2 * c + x1 * sn; }
                    }
                    u32x4 w; w.x = cvt_pk_bf16(v0[0], v0[1]); w.y = cvt_pk_bf16(v0[2], v0[3]); w.z = cvt_pk_bf16(v1[0], v1[1]); w.w = cvt_pk_bf16(v1[2], v1[3]);
                    *(u32x4*)(O + (size_t)row * DIN + col0 + bj * 128) = w;
                }
            }
    }
};

struct EpiFinal {
    static constexpr bool PERM = true, AFTER_DRAIN = false;
    const bf16_t* resb; float* out; float* xch; unsigned* cnt; const float* gain;
    __device__ __forceinline__ void operator()(const f32x4 (&acc_)[2][2][4][2], const pg8::Unit& u, int wr, int wc, int fr, int fq) const {
        f32x4 (&A)[2][2][4][2] = const_cast<f32x4 (&)[2][2][4][2]>(acc_);
        const int row0 = u.pm * 256 + wr * 64 + fr, col0 = u.pn * 256 + wc * 32 + 8 * fq, lane = threadIdx.x & 63;
#pragma unroll
        for (int ai = 0; ai < 2; ++ai)
#pragma unroll
            for (int m = 0; m < 4; ++m) {
                const int row = row0 + ai * 128 + m * 16; float ss = 0.f;
#pragma unroll
                for (int bj = 0; bj < 2; ++bj) {
                    const size_t off = (size_t)row * D + col0 + bj * 128;
                    const u32x4 r = *(const u32x4*)(resb + off);
                    const f32x4 x0 = (f32x4){__builtin_bit_cast(float, r.x << 16), __builtin_bit_cast(float, r.x & 0xffff0000u), __builtin_bit_cast(float, r.y << 16), __builtin_bit_cast(float, r.y & 0xffff0000u)};
                    const f32x4 x1 = (f32x4){__builtin_bit_cast(float, r.z << 16), __builtin_bit_cast(float, r.z & 0xffff0000u), __builtin_bit_cast(float, r.w << 16), __builtin_bit_cast(float, r.w & 0xffff0000u)};
                    const f32x4 v0 = x0 + A[ai][bj][m][0] * 0.5f, v1 = x1 + A[ai][bj][m][1] * 0.5f;
                    A[ai][bj][m][0] = v0; A[ai][bj][m][1] = v1;
                    ss += ((v0[0] * v0[0] + v0[1] * v0[1]) + (v0[2] * v0[2] + v0[3] * v0[3])) + ((v1[0] * v1[0] + v1[1] * v1[1]) + (v1[2] * v1[2] + v1[3] * v1[3]));
                }
                ss += __shfl_xor(ss, 16); ss += __shfl_xor(ss, 32);
                if (fq == 0) __hip_atomic_store(xch + (size_t)row * 16 + u.pn * 4 + wc, ss, __ATOMIC_RELAXED, __HIP_MEMORY_SCOPE_AGENT);
            }
        asm volatile("s_waitcnt vmcnt(0)" ::: "memory");
        unsigned* cw = cnt + 64 * u.pm;
        if (lane == 0) __hip_atomic_fetch_add(cw, 1u, __ATOMIC_RELAXED, __HIP_MEMORY_SCOPE_AGENT);
        { unsigned spins = 0;
          while ((unsigned)__builtin_amdgcn_readfirstlane(__hip_atomic_load(cw, __ATOMIC_RELAXED, __HIP_MEMORY_SCOPE_AGENT)) < 32u) { if (++spins > (1u << 22)) break; __builtin_amdgcn_s_sleep(2); } }
        __builtin_amdgcn_fence(__ATOMIC_ACQUIRE, "agent");
        asm volatile("s_waitcnt vmcnt(0)" ::: "memory");
        f32x4 g[2][2];
#pragma unroll
        for (int bj = 0; bj < 2; ++bj) { g[bj][0] = *(const f32x4*)(gain + col0 + bj * 128); g[bj][1] = *(const f32x4*)(gain + col0 + bj * 128 + 4); }
#pragma unroll
        for (int ai = 0; ai < 2; ++ai)
#pragma unroll
            for (int m = 0; m < 4; ++m) {
                const int row = row0 + ai * 128 + m * 16; const float* xp = xch + (size_t)row * 16 + 4 * fq;
                float s = (__hip_atomic_load(xp + 0, __ATOMIC_RELAXED, __HIP_MEMORY_SCOPE_AGENT) + __hip_atomic_load(xp + 1, __ATOMIC_RELAXED, __HIP_MEMORY_SCOPE_AGENT))
                        + (__hip_atomic_load(xp + 2, __ATOMIC_RELAXED, __HIP_MEMORY_SCOPE_AGENT) + __hip_atomic_load(xp + 3, __ATOMIC_RELAXED, __HIP_MEMORY_SCOPE_AGENT));
                s += __shfl_xor(s, 16); s += __shfl_xor(s, 32);
                const float rstd = __builtin_amdgcn_rsqf(s * (1.0f / 1024.0f) + EPS);
#pragma unroll
                for (int bj = 0; bj < 2; ++bj) { const size_t off = (size_t)row * D + col0 + bj * 128;
                    *(f32x4*)(out + off) = A[ai][bj][m][0] * rstd * g[bj][0]; *(f32x4*)(out + off + 4) = A[ai][bj][m][1] * rstd * g[bj][1]; }
            }
    }
};

__device__ __forceinline__ void p0_item(const float* W, int ldw, int sc, const float* gain, int gain_lim, bf16_t* WT, int K, int n0, int k0, LAS float* scr, int lane) {
    const int ng = lane & 7, sc4 = __shfl(sc, 4 * ng);
    f32x4 wv[8];
#pragma unroll
    for (int i = 0; i < 8; ++i) { const int k = k0 + (lane >> 3) + 8 * i; wv[i] = *(const f32x4*)(W + (size_t)k * ldw + sc4); }
#pragma unroll
    for (int i = 0; i < 8; ++i) { const int kk = (lane >> 3) + 8 * i, k = k0 + kk; f32x4 v = wv[i]; if (gain && k < gain_lim) v = v * gain[k];
        scr[kk * 33 + 4 * ng + 0] = v[0]; scr[kk * 33 + 4 * ng + 1] = v[1]; scr[kk * 33 + 4 * ng + 2] = v[2]; scr[kk * 33 + 4 * ng + 3] = v[3]; }
    asm volatile("s_waitcnt lgkmcnt(0)" ::: "memory");
    const int c = lane & 7;
#pragma unroll
    for (int j = 0; j < 4; ++j) { const int n = (lane >> 3) + 8 * j; const LAS float* s = scr + (8 * c) * 33 + n;
        u32x4 o; o.x = pk2(s[0 * 33], s[1 * 33]); o.y = pk2(s[2 * 33], s[3 * 33]); o.z = pk2(s[4 * 33], s[5 * 33]); o.w = pk2(s[6 * 33], s[7 * 33]);
        *(u32x4*)(WT + (size_t)(n0 + n) * K + k0 + 8 * c) = o; }
    asm volatile("s_waitcnt lgkmcnt(0)" ::: "memory");
}
__device__ __forceinline__ int win_srccol(int n) {
    if (n < 640) { const int p = n & 63; if (p < 16) return (n - p) + ((p & 3) | ((p & 4) << 1) | ((p & 8) >> 1)); return n; }
    if (n >= 768 && n < 1792) { const int p = (n - 768) & 127, q = p >> 3, nn = (p >> 2) & 1, j = p & 3; return (n - p) + nn * 64 + 4 * q + j; }
    return n;
}
__device__ __forceinline__ void p0_prologue(const Params& p, LAS unsigned char* lds, int G) {
    const int tid = threadIdx.x, lane = tid & 63, wave = tid >> 6;
    LAS float* scr = (LAS float*)(lds + wave * 16384);
    const int gw = blockIdx.x * 8 + wave, NGW = G * 8;
    constexpr int I_GU = 16 * 176, I_D = 44 * 32, I_IN = 16 * 88, I_OUT = 16 * 32;
    constexpr int NITEMS = 2 * I_GU + 2 * I_D + I_IN + I_OUT;
    for (int it = gw; it < NITEMS; it += NGW) {
        int r = it;
        if (r < 2 * I_GU) {
            const int which = r / I_GU; r -= which * I_GU; const int nb = r % 176, kb = r / 176, n0 = nb * 32;
            const int pn = n0 >> 8, q = n0 & 255, bj = q >> 7, hid = pn * 128 + (q & 127) + (lane & 31);
            const float* W = which == 0 ? (bj ? p.in[4] : p.in[3]) : (bj ? p.in[15] : p.in[14]);
            p0_item(W, FF, hid, which == 0 ? nullptr : p.in[13], 1 << 30, (bf16_t*)(p.ws + (which == 0 ? WS_WGU1 : WS_WGU2)), D, n0, kb * 64, scr, lane); continue; }
        r -= 2 * I_GU;
        if (r < 2 * I_D) {
            const int which = r / I_D; r -= which * I_D; const int nb = r % 32, kb = r / 32, n0 = nb * 32;
            p0_item(which == 0 ? p.in[5] : p.in[16], D, n0 + (lane & 31), nullptr, 0, (bf16_t*)(p.ws + (which == 0 ? WS_WD1 : WS_WD2)), FF, n0, kb * 64, scr, lane); continue; }
        r -= 2 * I_D;
        if (r < I_IN) { const int nb = r % 88, kb = r / 88, n0 = nb * 32;
            p0_item(p.in[7], DIN, win_srccol(n0 + (lane & 31)), p.in[6], 1 << 30, (bf16_t*)(p.ws + WS_WIN), D, n0, kb * 64, scr, lane); continue; }
        r -= I_IN;
        { const int nb = r % 32, kb = r / 32, n0 = nb * 32;
            p0_item(p.in[12], D, n0 + (lane & 31), p.in[9], 512, (bf16_t*)(p.ws + WS_WOUT), D, n0, kb * 64, scr, lane); }
    }
    bf16_t* XN = (bf16_t*)(p.ws + WS_ACTA);
    const f32x4* gp = (const f32x4*)p.in[2] + lane;
    for (int rb = gw * 4; rb < T; rb += NGW * 4) {
        f32x4 v[4][4]; float s[4];
#pragma unroll
        for (int q = 0; q < 4; ++q) { const int row = rb + q; const float* xrow = row < TP ? p.in[0] + (size_t)row * D : p.in[1] + (size_t)(row - TP) * D; const f32x4* xr = (const f32x4*)xrow + lane;
#pragma unroll
            for (int j = 0; j < 4; ++j) v[q][j] = xr[64 * j]; }
#pragma unroll
        for (int q = 0; q < 4; ++q) { float a = 0.f;
#pragma unroll
            for (int j = 0; j < 4; ++j) a += (v[q][j][0] * v[q][j][0] + v[q][j][1] * v[q][j][1]) + (v[q][j][2] * v[q][j][2] + v[q][j][3] * v[q][j][3]);
            s[q] = a; }
#pragma unroll
        for (int q = 0; q < 4; ++q) { const float rstd = __builtin_amdgcn_rsqf(wave_sum(s[q]) * (1.f / D) + EPS);
            u32x2* o8 = (u32x2*)(XN + (size_t)(rb + q) * D) + lane;
#pragma unroll
            for (int j = 0; j < 4; ++j) { const f32x4 g = gp[64 * j]; u32x2 w; w.x = pk2(v[q][j][0] * rstd * g[0], v[q][j][1] * rstd * g[1]); w.y = pk2(v[q][j][2] * rstd * g[2], v[q][j][3] * rstd * g[3]); o8[64 * j] = w; } }
    }
}

#define MMA16(b, a, c) __builtin_amdgcn_mfma_f32_16x16x32_bf16((b), (a), (c), 0, 0, 0)
#define LDS16(ptr) (*(const LAS bf16x8*)(ptr))
typedef short v4i16_t __attribute__((ext_vector_type(4)));
__device__ __forceinline__ bf16x8 tr_frag(const LAS bf16_t* p, int pitch) {
    const v4i16_t lo = __builtin_amdgcn_ds_read_tr16_b64_v4i16((LAS v4i16_t*)p), hi = __builtin_amdgcn_ds_read_tr16_b64_v4i16((LAS v4i16_t*)(p + 4 * pitch));
    return (bf16x8){lo[0], lo[1], lo[2], lo[3], hi[0], hi[1], hi[2], hi[3]};
}

__device__ __forceinline__ void attn_phase(const Params& p, LAS unsigned char* lds, int G) {
    const int tid = threadIdx.x, lane = tid & 63, wave = tid >> 6, fr = lane & 15, fq = lane >> 4;
    const bf16_t* proj = (const bf16_t*)(p.ws + WS_HID); bf16_t* mix = (bf16_t*)(p.ws + WS_ACTB);
    LAS bf16_t* Kl = (LAS bf16_t*)lds;
    LAS bf16_t* Vl = (LAS bf16_t*)(lds + 18432);
    LAS bf16_t* Pl = (LAS bf16_t*)(lds + 36864 + wave * 9216);
    LAS float* stat = (LAS float*)(lds + 110592);
    const int h = wave, kvh = h >> 2;
    const float sink = p.in[8][h];
    const int skey = tid >> 3, sdch = tid & 7;
    const int trb = (8 * fq + (fr >> 2)) * 72 + 4 * (fr & 3);
    u32x4 pk[2], pv[2];
#define ATT_RANGE(r0, lo, hi) do { int ss_, se_; if ((r0) < TP) { ss_ = (r0) & ~8191; se_ = ss_ + 8192; } else { ss_ = TP + (((r0) - TP) & ~2047); se_ = ss_ + 2048; } \
        lo = ((r0) - 128 < ss_) ? ((ss_ - ((r0) - 128)) >> 6) : 0; hi = ((r0) + 128 >= se_) ? (((se_ - 64) - ((r0) - 128)) >> 6) : 4; } while (0)
#define ATT_ISSUE(r0, kb) do { const bf16_t* src_ = proj + (size_t)((r0) - 128 + 64 * (kb) + skey) * DIN + 512 + sdch * 8; \
        pk[0] = *(const u32x4*)src_; pv[0] = *(const u32x4*)(src_ + 128); pk[1] = *(const u32x4*)(src_ + 64); pv[1] = *(const u32x4*)(src_ + 192); } while (0)
    int unit = blockIdx.x;
    if (unit < T / 64) { int lo, hi; ATT_RANGE(unit * 64, lo, hi); ATT_ISSUE(unit * 64, lo); (void)hi; }
    for (; unit < T / 64; unit += G) {
        const int row0 = unit * 64; int kb_lo, kb_hi; ATT_RANGE(row0, kb_lo, kb_hi);
        bf16x8 qf[4][2];
#pragma unroll
        for (int m = 0; m < 4; ++m)
#pragma unroll
            for (int k = 0; k < 2; ++k) qf[m][k] = *(const bf16x8*)(proj + (size_t)(row0 + 16 * m + fr) * DIN + h * 64 + 32 * k + 8 * fq);
        f32x4 o[4][4]; float mrow[4], lrow[4];
#pragma unroll
        for (int m = 0; m < 4; ++m) { mrow[m] = sink; lrow[m] = 1.f;
#pragma unroll
            for (int n = 0; n < 4; ++n) o[m][n] = (f32x4){0.f, 0.f, 0.f, 0.f}; }
        for (int kb = kb_lo; kb <= kb_hi; ++kb) {
            const int kstart = row0 - 128 + 64 * kb;
            __syncthreads();
#pragma unroll
            for (int i = 0; i < 2; ++i) {
                *(LAS u32x4*)(Kl + (i * 64 + skey) * 72 + sdch * 8) = pk[i]; *(LAS u32x4*)(Vl + (i * 64 + skey) * 72 + sdch * 8) = pv[i];
            }
            __syncthreads();
            if (kb < kb_hi) { ATT_ISSUE(row0, kb + 1); }
            else if (unit + G < T / 64) { int lo2, hi2; ATT_RANGE((unit + G) * 64, lo2, hi2); ATT_ISSUE((unit + G) * 64, lo2); (void)hi2; }
            bf16x8 kf[4][2];
#pragma unroll
            for (int n = 0; n < 4; ++n) { kf[n][0] = LDS16(Kl + (kvh * 64 + 16 * n + fr) * 72 + 8 * fq); kf[n][1] = LDS16(Kl + (kvh * 64 + 16 * n + fr) * 72 + 32 + 8 * fq); }
            const bool edge = (kb == 0) || (kb == 4);
#pragma unroll
            for (int m = 0; m < 4; ++m) {
                f32x4 s[4];
#pragma unroll
                for (int n = 0; n < 4; ++n) { f32x4 a = (f32x4){0.f, 0.f, 0.f, 0.f}; a = MMA16(kf[n][0], qf[m][0], a); a = MMA16(kf[n][1], qf[m][1], a); s[n] = a; }
                const int i = row0 + 16 * m + fr; float mx = mrow[m];
                if (edge) {
#pragma unroll
                    for (int n = 0; n < 4; ++n)
#pragma unroll
                        for (int e = 0; e < 4; ++e) { const int j = kstart + 16 * n + 4 * fq + e, dlt = i - j; const bool valid = (dlt <= 128) && (dlt >= -128); s[n][e] = valid ? s[n][e] : -1e30f; }
                }
#pragma unroll
                for (int n = 0; n < 4; ++n) mx = fmaxf(fmaxf(mx, fmaxf(s[n][0], s[n][1])), fmaxf(s[n][2], s[n][3]));
                mx = fmaxf(mx, __shfl_xor(mx, 16)); mx = fmaxf(mx, __shfl_xor(mx, 32));
                const float alpha = fexp(mrow[m] - mx); mrow[m] = mx; float ps = 0.f; const float mxl = mx * 1.4426950408889634f;
#pragma unroll
                for (int n = 0; n < 4; ++n) {
                    f32x4 pvv;
#pragma unroll
                    for (int e = 0; e < 4; ++e) { pvv[e] = __builtin_amdgcn_exp2f(s[n][e] * 1.4426950408889634f - mxl); ps += pvv[e]; }
                    u32x2 w; w.x = cvt_pk_bf16(pvv[0], pvv[1]); w.y = cvt_pk_bf16(pvv[2], pvv[3]);
                    *(LAS u32x2*)(Pl + (16 * m + fr) * 72 + 16 * n + 4 * fq) = w;
                    o[m][n] = o[m][n] * alpha;
                }
                ps += __shfl_xor(ps, 16); ps += __shfl_xor(ps, 32);
                lrow[m] = lrow[m] * alpha + ps;
            }
            asm volatile("s_waitcnt lgkmcnt(0)" ::: "memory");
#pragma unroll
            for (int n = 0; n < 4; ++n) {
                const bf16x8 b0 = tr_frag(Vl + kvh * 64 * 72 + trb + 16 * n, 72), b1 = tr_frag(Vl + (kvh * 64 + 32) * 72 + trb + 16 * n, 72);
#pragma unroll
                for (int m = 0; m < 4; ++m) { const bf16x8 a0 = LDS16(Pl + (16 * m + fr) * 72 + 8 * fq), a1 = LDS16(Pl + (16 * m + fr) * 72 + 32 + 8 * fq);
                    o[m][n] = MMA16(b0, a0, o[m][n]); o[m][n] = MMA16(b1, a1, o[m][n]); }
            }
        }
#pragma unroll
        for (int m = 0; m < 4; ++m) { const float inv = 1.0f / lrow[m]; float ss = 0.f;
#pragma unroll
            for (int n = 0; n < 4; ++n) { o[m][n] = o[m][n] * inv; ss += (o[m][n][0] * o[m][n][0] + o[m][n][1] * o[m][n][1]) + (o[m][n][2] * o[m][n][2] + o[m][n][3] * o[m][n][3]); }
            ss += __shfl_xor(ss, 16); ss += __shfl_xor(ss, 32);
            if (fq == 0) stat[h * 64 + 16 * m + fr] = ss; }
        __syncthreads();
#pragma unroll
        for (int m = 0; m < 4; ++m) { float tot = 0.f;
#pragma unroll
            for (int hh = 0; hh < 8; ++hh) tot += stat[hh * 64 + 16 * m + fr];
            const float rn = __builtin_amdgcn_rsqf(tot * (1.0f / 512.0f) + EPS);
#pragma unroll
            for (int n = 0; n < 4; ++n) { const f32x4 v = o[m][n] * rn; u32x2 w; w.x = cvt_pk_bf16(v[0], v[1]); w.y = cvt_pk_bf16(v[2], v[3]);
                *(u32x2*)(mix + (size_t)(row0 + 16 * m + fr) * D + h * 64 + 16 * n + 4 * fq) = w; } }
    }
#undef ATT_RANGE
#undef ATT_ISSUE
    __syncthreads();
}

__device__ __forceinline__ void ret_kv_phase(const Params& p, LAS unsigned char* lds, int G) {
    const int tid = threadIdx.x, lane = tid & 63, wave = tid >> 6, fr = lane & 15, fq = lane >> 4;
    const bf16_t* proj = (const bf16_t*)(p.ws + WS_HID); bf16_t* kvbuf = (bf16_t*)p.out;
    LAS bf16_t* Vl = (LAS bf16_t*)lds; LAS bf16_t* Kf = (LAS bf16_t*)(lds + 34816); LAS bf16_t* Kb = (LAS bf16_t*)(lds + 69632);
    const int stok = tid >> 4, sdch = tid & 15;
    const int trb = (8 * fq + (fr >> 2)) * 136 + 4 * (fr & 3);
    u32x4 pk[4], pv[4];
#define R1_ISSUE(u_) do { const bf16_t* src_ = proj + (size_t)(((u_) >> 2) * 128 + stok) * DIN + 1280 + ((u_) & 3) * 128 + sdch * 8; \
        _Pragma("unroll") for (int i_ = 0; i_ < 4; ++i_) { pk[i_] = *(const u32x4*)(src_ + (size_t)i_ * 32 * DIN); pv[i_] = *(const u32x4*)(src_ + 512 + (size_t)i_ * 32 * DIN); } } while (0)
    int unit = blockIdx.x;
    if (unit < (T / 128) * 4) R1_ISSUE(unit);
    for (; unit < (T / 128) * 4; unit += G) {
        const int c = unit >> 2, h = unit & 3;
        const float ldf = p.in[10][h], ldb = p.in[11][h];
        __syncthreads();
#pragma unroll
        for (int i = 0; i < 4; ++i) {
            const int tok = stok + 32 * i; const float wf = fexp(ldf * (float)(127 - tok)), wb = fexp(ldb * (float)tok);
            const unsigned kw[4] = {pk[i].x, pk[i].y, pk[i].z, pk[i].w}; u32x4 of, ob; unsigned fo[4], bo[4];
#pragma unroll
            for (int q = 0; q < 4; ++q) { const float k0 = bf2f((unsigned short)(kw[q] & 0xffffu)), k1 = bf2f((unsigned short)(kw[q] >> 16)); fo[q] = cvt_pk_bf16(k0 * wf, k1 * wf); bo[q] = cvt_pk_bf16(k0 * wb, k1 * wb); }
            of.x = fo[0]; of.y = fo[1]; of.z = fo[2]; of.w = fo[3]; ob.x = bo[0]; ob.y = bo[1]; ob.z = bo[2]; ob.w = bo[3];
            *(LAS u32x4*)(Vl + tok * 136 + sdch * 8) = pv[i]; *(LAS u32x4*)(Kf + tok * 136 + sdch * 8) = of; *(LAS u32x4*)(Kb + tok * 136 + sdch * 8) = ob;
        }
        __syncthreads();
        if (unit + G < (T / 128) * 4) R1_ISSUE(unit + G);
        const int dir = wave >> 2, mt0 = (wave & 3) * 2; LAS bf16_t* Kx = dir ? Kb : Kf;
        f32x4 acc[2][8];
#pragma unroll
        for (int mi = 0; mi < 2; ++mi)
#pragma unroll
            for (int n = 0; n < 8; ++n) acc[mi][n] = (f32x4){0.f, 0.f, 0.f, 0.f};
#pragma unroll
        for (int k = 0; k < 4; ++k) {
            const bf16x8 a0 = tr_frag(Vl + 32 * k * 136 + trb + (mt0 + 0) * 16, 136), a1 = tr_frag(Vl + 32 * k * 136 + trb + (mt0 + 1) * 16, 136);
#pragma unroll
            for (int n = 0; n < 8; ++n) { const bf16x8 b = tr_frag(Kx + 32 * k * 136 + trb + 16 * n, 136); acc[0][n] = MMA16(b, a0, acc[0][n]); acc[1][n] = MMA16(b, a1, acc[1][n]); }
        }
        bf16_t* dst = kvbuf + ((size_t)(c * 4 + h) * 2 + dir) * 16384;
#pragma unroll
        for (int mi = 0; mi < 2; ++mi)
#pragma unroll
            for (int n = 0; n < 8; ++n) { u32x2 w; w.x = cvt_pk_bf16(acc[mi][n][0], acc[mi][n][1]); w.y = cvt_pk_bf16(acc[mi][n][2], acc[mi][n][3]);
                *(u32x2*)(dst + ((mt0 + mi) * 16 + fr) * 128 + 16 * n + 4 * fq) = w; }
    }
#undef R1_ISSUE
}

__device__ __forceinline__ void ret_scan_phase(const Params& p, int G) {
    bf16_t* kvbuf = (bf16_t*)p.out;
    const int nthr = G * NTHR;
    for (int t = blockIdx.x * NTHR + threadIdx.x; t < 131072; t += nthr) {
        {
            const int e4 = t & 4095, sdh = t >> 12, dir = sdh & 1, h = (sdh >> 1) & 3, b = sdh >> 3, c0 = 64 * b;
            const float Dk = fexp((dir ? p.in[11][h] : p.in[10][h]) * 128.0f);
            float st[4] = {0.f, 0.f, 0.f, 0.f};
            for (int sb = 0; sb < 64; sb += 16) {
                u32x2 v[16];
#pragma unroll
                for (int i = 0; i < 16; ++i) { const int c = dir ? (c0 + 63 - sb - i) : (c0 + sb + i); v[i] = *(const u32x2*)(kvbuf + ((size_t)(c * 4 + h) * 2 + dir) * 16384 + e4 * 4); }
#pragma unroll
                for (int i = 0; i < 16; ++i) { const int c = dir ? (c0 + 63 - sb - i) : (c0 + sb + i);
                    u32x2 w; w.x = pk2(st[0], st[1]); w.y = pk2(st[2], st[3]); *(u32x2*)(kvbuf + ((size_t)(c * 4 + h) * 2 + dir) * 16384 + e4 * 4) = w;
                    st[0] = st[0] * Dk + bf2f((unsigned short)(v[i].x & 0xffffu)); st[1] = st[1] * Dk + bf2f((unsigned short)(v[i].x >> 16));
                    st[2] = st[2] * Dk + bf2f((unsigned short)(v[i].y & 0xffffu)); st[3] = st[3] * Dk + bf2f((unsigned short)(v[i].y >> 16)); }
            }
        }
        {
            const int e8 = t & 2047, sdh = t >> 11, dir = sdh & 1, h = (sdh >> 1) & 3, b = sdh >> 3, c0 = 256 + 16 * b;
            const float Dk = fexp((dir ? p.in[11][h] : p.in[10][h]) * 128.0f);
            float st[8] = {0.f, 0.f, 0.f, 0.f, 0.f, 0.f, 0.f, 0.f};
            u32x4 v[16];
#pragma unroll
            for (int i = 0; i < 16; ++i) { const int c = dir ? (c0 + 15 - i) : (c0 + i); v[i] = *(const u32x4*)(kvbuf + ((size_t)(c * 4 + h) * 2 + dir) * 16384 + e8 * 8); }
#pragma unroll
            for (int i = 0; i < 16; ++i) { const int c = dir ? (c0 + 15 - i) : (c0 + i);
                u32x4 w; w.x = pk2(st[0], st[1]); w.y = pk2(st[2], st[3]); w.z = pk2(st[4], st[5]); w.w = pk2(st[6], st[7]); *(u32x4*)(kvbuf + ((size_t)(c * 4 + h) * 2 + dir) * 16384 + e8 * 8) = w;
                const unsigned vv[4] = {v[i].x, v[i].y, v[i].z, v[i].w};
#pragma unroll
                for (int q = 0; q < 4; ++q) { st[2 * q] = st[2 * q] * Dk + bf2f((unsigned short)(vv[q] & 0xffffu)); st[2 * q + 1] = st[2 * q + 1] * Dk + bf2f((unsigned short)(vv[q] >> 16)); }
            }
        }
    }
}

__device__ __forceinline__ void ret_out_phase(const Params& p, LAS unsigned char* lds, int G) {
    const int tid = threadIdx.x, lane = tid & 63, wave = tid >> 6, fr = lane & 15, fq = lane >> 4;
    const bf16_t* proj = (const bf16_t*)(p.ws + WS_HID); const bf16_t* kvbuf = (const bf16_t*)p.out; bf16_t* mix = (bf16_t*)(p.ws + WS_ACTB);
    LAS bf16_t* Ql = (LAS bf16_t*)lds; LAS bf16_t* Kl = (LAS bf16_t*)(lds + 34816); LAS bf16_t* Vl = (LAS bf16_t*)(lds + 69632); LAS bf16_t* Pl = (LAS bf16_t*)(lds + 104448);
    const int stok = tid >> 4, sdch = tid & 15;
    const int trb = (8 * fq + (fr >> 2)) * 136 + 4 * (fr & 3);
    const int il = 16 * wave + fr;
    u32x4 pq[4], pk[4], pv[4];
#define R3_ISSUE(u_) do { const bf16_t* src_ = proj + (size_t)(((u_) >> 2) * 128 + stok) * DIN + 768 + ((u_) & 3) * 128 + sdch * 8; \
        _Pragma("unroll") for (int i_ = 0; i_ < 4; ++i_) { pq[i_] = *(const u32x4*)(src_ + (size_t)i_ * 32 * DIN); pk[i_] = *(const u32x4*)(src_ + 512 + (size_t)i_ * 32 * DIN); pv[i_] = *(const u32x4*)(src_ + 1024 + (size_t)i_ * 32 * DIN); } } while (0)
    int unit = blockIdx.x;
    if (unit < (T / 128) * 4) R3_ISSUE(unit);
    for (; unit < (T / 128) * 4; unit += G) {
        const int c = unit >> 2, h = unit & 3, row0 = c * 128;
        const float ldf = p.in[10][h], ldb = p.in[11][h];
        __syncthreads();
#pragma unroll
        for (int i = 0; i < 4; ++i) {
            const int tok = stok + 32 * i;
            *(LAS u32x4*)(Ql + tok * 136 + sdch * 8) = pq[i]; *(LAS u32x4*)(Kl + tok * 136 + sdch * 8) = pk[i]; *(LAS u32x4*)(Vl + tok * 136 + sdch * 8) = pv[i];
        }
        __syncthreads();
        u32x4 sfr[4], sbr[4];
        {
            const bf16_t* sf = kvbuf + ((size_t)(c * 4 + h) * 2) * 16384 + stok * 128 + sdch * 8;
#pragma unroll
            for (int i = 0; i < 4; ++i) { sfr[i] = *(const u32x4*)(sf + i * 32 * 128); sbr[i] = *(const u32x4*)(sf + 16384 + i * 32 * 128); }
        }
        bf16x8 qa[4];
#pragma unroll
        for (int k = 0; k < 4; ++k) qa[k] = LDS16(Ql + il * 136 + 32 * k + 8 * fq);
        f32x4 o1[8];
        {
            f32x4 s[8];
#pragma unroll
            for (int n = 0; n < 8; ++n) { s[n] = (f32x4){0.f, 0.f, 0.f, 0.f};
#pragma unroll
                for (int k = 0; k < 4; ++k) s[n] = MMA16(LDS16(Kl + (16 * n + fr) * 136 + 32 * k + 8 * fq), qa[k], s[n]); }
#pragma unroll
            for (int n = 0; n < 8; ++n) { f32x4 pvv;
#pragma unroll
                for (int e = 0; e < 4; ++e) { const int j = 16 * n + 4 * fq + e, dlt = il - j; const float mk = dlt > 0 ? fexp(ldf * (float)dlt) : (dlt < 0 ? fexp(ldb * (float)(-dlt)) : 2.0f); pvv[e] = s[n][e] * mk; }
                u32x2 w; w.x = cvt_pk_bf16(pvv[0], pvv[1]); w.y = cvt_pk_bf16(pvv[2], pvv[3]);
                *(LAS u32x2*)(Pl + il * 136 + 16 * n + 4 * fq) = w; }
            asm volatile("s_waitcnt lgkmcnt(0)" ::: "memory");
            bf16x8 pa[4];
#pragma unroll
            for (int k = 0; k < 4; ++k) pa[k] = LDS16(Pl + il * 136 + 32 * k + 8 * fq);
#pragma unroll
            for (int n = 0; n < 8; ++n) { o1[n] = (f32x4){0.f, 0.f, 0.f, 0.f};
#pragma unroll
                for (int k = 0; k < 4; ++k) o1[n] = MMA16(tr_frag(Vl + 32 * k * 136 + trb + 16 * n, 136), pa[k], o1[n]); }
        }
        __syncthreads();
#pragma unroll
        for (int i = 0; i < 4; ++i) { const int dv = stok + 32 * i; *(LAS u32x4*)(Kl + dv * 136 + sdch * 8) = sfr[i]; *(LAS u32x4*)(Pl + dv * 136 + sdch * 8) = sbr[i]; }
        __syncthreads();
        if (unit + G < (T / 128) * 4) R3_ISSUE(unit + G);
        u32x2 gv[8];
        { const bf16_t* gsrc = proj + (size_t)(row0 + il) * DIN + 2304 + h * 128 + 4 * fq;
#pragma unroll
            for (int n = 0; n < 8; ++n) gv[n] = *(const u32x2*)(gsrc + 16 * n); }
        {
            const float ef = fexp(ldf * (float)(il + 1)), eb = fexp(ldb * (float)(128 - il));
#pragma unroll
            for (int n = 0; n < 8; ++n) { f32x4 a = (f32x4){0.f, 0.f, 0.f, 0.f}, b = (f32x4){0.f, 0.f, 0.f, 0.f};
#pragma unroll
                for (int k = 0; k < 4; ++k) { a = MMA16(LDS16(Kl + (16 * n + fr) * 136 + 32 * k + 8 * fq), qa[k], a); b = MMA16(LDS16(Pl + (16 * n + fr) * 136 + 32 * k + 8 * fq), qa[k], b); }
                o1[n] = o1[n] + a * ef + b * eb; }
        }
        float sm = 0.f;
#pragma unroll
        for (int n = 0; n < 8; ++n) sm += (o1[n][0] + o1[n][1]) + (o1[n][2] + o1[n][3]);
        sm += __shfl_xor(sm, 16); sm += __shfl_xor(sm, 32);
        const float mu = sm * (1.0f / 128.0f); float sq = 0.f;
#pragma unroll
        for (int n = 0; n < 8; ++n) { o1[n] = o1[n] - mu; sq += (o1[n][0] * o1[n][0] + o1[n][1] * o1[n][1]) + (o1[n][2] * o1[n][2] + o1[n][3] * o1[n][3]); }
        sq += __shfl_xor(sq, 16); sq += __shfl_xor(sq, 32);
        const float rs = __builtin_amdgcn_rsqf(sq * (1.0f / 128.0f) + EPS);
        bf16_t* dst = mix + (size_t)(row0 + il) * D + 512 + h * 128 + 4 * fq;
#pragma unroll
        for (int n = 0; n < 8; ++n) { const u32x2 g = gv[n];
            const float g0 = bf2f((unsigned short)(g.x & 0xffffu)), g1 = bf2f((unsigned short)(g.x >> 16)), g2 = bf2f((unsigned short)(g.y & 0xffffu)), g3 = bf2f((unsigned short)(g.y >> 16));
            u32x2 w; w.x = cvt_pk_bf16(silu_f(g0) * o1[n][0] * rs, silu_f(g1) * o1[n][1] * rs); w.y = cvt_pk_bf16(silu_f(g2) * o1[n][2] * rs, silu_f(g3) * o1[n][3] * rs);
            *(u32x2*)(dst + 16 * n) = w; }
    }
#undef R3_ISSUE
}

__device__ __forceinline__ void final_norm_phase(const Params& p, int G) {
    const int lane = threadIdx.x & 63, wave = threadIdx.x >> 6; const int gw = blockIdx.x * 8 + wave, NGW = G * 8;
    const f32x4* gp = (const f32x4*)p.in[17] + lane;
    for (int row = gw; row < T; row += NGW) {
        f32x4* xr = (f32x4*)(p.out + (size_t)row * D) + lane; f32x4 v[4]; float s = 0.f;
#pragma unroll
        for (int j = 0; j < 4; ++j) { v[j] = xr[64 * j]; s += (v[j][0] * v[j][0] + v[j][1] * v[j][1]) + (v[j][2] * v[j][2] + v[j][3] * v[j][3]); }
        const float rstd = __builtin_amdgcn_rsqf(wave_sum(s) * (1.f / D) + EPS);
#pragma unroll
        for (int j = 0; j < 4; ++j) xr[64 * j] = v[j] * rstd * gp[64 * j];
    }
}

#define XB_TMO      128
#define XB_XCNT(j)  (256  + 64 * (j))
#define XB_XSUB(j)  (1280 + 64 * (j))
#define XB_XGEN(j)  (2304 + 64 * (j))
#define XB_TOP      3328
#define XB_TOPGEN   3392
#define XCD_BAR_WORDS 3456
#define XB_SPIN_CAP (1u << 18)

__device__ __forceinline__ unsigned xb_ld(unsigned* p)              { return __hip_atomic_load(p, __ATOMIC_RELAXED, __HIP_MEMORY_SCOPE_AGENT); }
__device__ __forceinline__ unsigned xb_add(unsigned* p, unsigned v) { return __hip_atomic_fetch_add(p, v, __ATOMIC_RELAXED, __HIP_MEMORY_SCOPE_AGENT); }
__device__ __forceinline__ unsigned xb_xcc_id() { return (unsigned)__builtin_amdgcn_s_getreg((3 << 11) | 20) & 0xFu; }
#define XB_SPIN(cond, bar) do { unsigned _sp = 0; while (cond) { __builtin_amdgcn_s_sleep(1); \
    if ((++_sp & 255u) == 0u) { if (xb_ld(&(bar)[XB_TMO])) break; if (_sp > XB_SPIN_CAP) { atomicAdd(&(bar)[XB_TMO], 1u); break; } } } } while (0)

struct XcdBarrier {
    unsigned* bar; unsigned x;
    volatile LAS unsigned* st;
};

__device__ __forceinline__ XcdBarrier xcd_barrier_post(unsigned* bar, volatile LAS unsigned* st) {
    XcdBarrier b; b.bar = bar; b.x = xb_xcc_id(); b.st = st;
    if (threadIdx.x == 0) (void)xb_add(&bar[XB_XCNT(b.x)], 1u);
    return b;
}
__device__ __forceinline__ void xcd_barrier_complete(unsigned* bar, unsigned x, unsigned& nloc, unsigned& nx) {
    const unsigned G = gridDim.x * gridDim.y * gridDim.z;
    unsigned sum, cnt, mine, sp = 0u;
    for (;;) {
        sum = 0u; cnt = 0u; mine = 0u;
#pragma unroll
        for (unsigned j = 0; j < 16; ++j) { const unsigned c = xb_ld(&bar[XB_XCNT(j)]); sum += c; cnt += (c > 0u) ? 1u : 0u; mine = (j == x) ? c : mine; }
        if (sum == G) break;
        __builtin_amdgcn_s_sleep(1);
        if ((++sp & 255u) == 0u) { if (xb_ld(&bar[XB_TMO])) break; if (sp > XB_SPIN_CAP) { atomicAdd(&bar[XB_TMO], 1u); break; } }
    }
    nloc = mine > 0u ? mine : 1u; nx = cnt > 0u ? cnt : 1u;
}

__device__ __forceinline__ void xcd_barrier(const XcdBarrier& b) {
    asm volatile("s_waitcnt vmcnt(0)" ::: "memory");
    __syncthreads();
    if (threadIdx.x == 0) {
        unsigned* bar = b.bar;
        __builtin_amdgcn_s_waitcnt(0);
        unsigned nloc = b.st[0], nx = b.st[1];
        if (nloc == 0u) { xcd_barrier_complete(bar, b.x, nloc, nx); b.st[0] = nloc; b.st[1] = nx; }
        const unsigned old = xb_add(&bar[XB_XSUB(b.x)], 1u);
        const unsigned gen = old / nloc;
        if (old + 1u == (gen + 1u) * nloc) {
            __builtin_amdgcn_fence(__ATOMIC_RELEASE, "agent");
            asm volatile("s_waitcnt vmcnt(0)" ::: "memory");
            const unsigned og = xb_add(&bar[XB_TOP], 1u);
            const unsigned tg = og / nx;
            if (og + 1u == (tg + 1u) * nx) xb_add(&bar[XB_TOPGEN], 1u);
            else XB_SPIN(xb_ld(&bar[XB_TOPGEN]) == tg, bar);
            __builtin_amdgcn_fence(__ATOMIC_ACQUIRE, "agent");
            xb_add(&bar[XB_XGEN(b.x)], 1u);
            asm volatile("s_waitcnt vmcnt(0)" ::: "memory");
        } else {
            XB_SPIN(xb_ld(&bar[XB_XGEN(b.x)]) == gen, bar);
            __builtin_amdgcn_fence(__ATOMIC_ACQUIRE, "agent");
            asm volatile("s_waitcnt vmcnt(0)" ::: "memory");
        }
    }
    __syncthreads();
}

constexpr int NPHASE = 11;
__global__ void __launch_bounds__(NTHR, 2) mk_fwd(Params p) {
    extern __shared__ __attribute__((aligned(16))) unsigned char lds_raw[];
    LAS unsigned char* lds = (LAS unsigned char*)lds_raw;
    const int G = gridDim.x, lo = p.ph_lo, hi = p.ph_hi;
    cg::grid_group grid = cg::this_grid();
#define IN(k) (lo <= (k) && (k) < hi)
    volatile LAS unsigned* bst = (volatile LAS unsigned*)(lds + 147392);
    if (threadIdx.x == 0) { bst[0] = 0u; bst[1] = 0u; }
    __syncthreads();
    XcdBarrier xbar = xcd_barrier_post((unsigned*)(p.ws + WS_TABR) + 192 * 64, bst);
    unsigned* rankw = (unsigned*)(p.ws + WS_TABR) + 192 * 64 + 3584;
    if (threadIdx.x == 0) { const unsigned x = xb_xcc_id() & 7u; const unsigned r = __hip_atomic_fetch_add(rankw + 8 * x, 1u, __ATOMIC_RELAXED, __HIP_MEMORY_SCOPE_AGENT); bst[2] = r * 8u + x; }
    if (p.ph_lo < -1000) grid.sync();
#define SEAM(k) do { if (IN(k) && IN((k) + 1)) xcd_barrier(xbar); } while (0)
    bf16_t* ACTA = (bf16_t*)(p.ws + WS_ACTA); bf16_t* ACTB = (bf16_t*)(p.ws + WS_ACTB); bf16_t* HID = (bf16_t*)(p.ws + WS_HID);
    float* SSQ = (float*)(p.ws + WS_SSQ);
    if (IN(0)) { p0_prologue(p, lds, G); if (DUP & 1) { __syncthreads(); p0_prologue(p, lds, G); } }
    SEAM(0);
    int vc = (int)blockIdx.x;
    if (IN(0) && IN(1) && G == 256) {
        if (threadIdx.x == 0) { unsigned ok = 1u; for (int j = 0; j < 8; ++j) ok &= (__hip_atomic_load(rankw + 8 * j, __ATOMIC_RELAXED, __HIP_MEMORY_SCOPE_AGENT) == 32u) ? 1u : 0u; bst[3] = ok; }
        __syncthreads();
        if (bst[3]) vc = (int)bst[2];
    }
    if (IN(1)) {
        pg8::Gemm g{ACTA, (const bf16_t*)(p.ws + WS_WGU1), T, 2 * FF, D}; pg8::StaticOrder S; S.init(T, 2 * FF, G, vc);
        EpiSwiGLU<false> E{HID, nullptr};
        pg8::gemm_phase<EpiSwiGLU<false>, pg8::StaticOrder, PG8_ALIGN, PG8_SP2>(lds, g, S, E);
        if (DUP & 16) { __syncthreads(); pg8::gemm_phase<EpiSwiGLU<false>, pg8::StaticOrder, PG8_ALIGN, PG8_SP2>(lds, g, S, E); }
    }
    SEAM(1);
    if (IN(2)) {
        pg8::Gemm g{HID, (const bf16_t*)(p.ws + WS_WD1), T, D, FF}; pg8::StaticOrder S; S.init(T, D, G, vc);
        EpiResid<false, false, true, true> E{p.in[0], p.in[1] - (size_t)TP * D, nullptr, nullptr, ACTA, SSQ, 0.5f};
        pg8::gemm_phase<EpiResid<false, false, true, true>, pg8::StaticOrder, PG8_ALIGN, PG8_SP2>(lds, g, S, E);
    }
    SEAM(2);
    if (IN(3)) {
        pg8::Gemm g{ACTA, (const bf16_t*)(p.ws + WS_WIN), T, DIN, D}; pg8::StaticOrder S; S.init(T, DIN, G, vc);
        EpiProj E{HID, SSQ};
        pg8::gemm_phase<EpiProj, pg8::StaticOrder, PG8_ALIGN, PG8_SP2>(lds, g, S, E);
        if (DUP & 32) { __syncthreads(); pg8::gemm_phase<EpiProj, pg8::StaticOrder, PG8_ALIGN, PG8_SP2>(lds, g, S, E); }
    }
    SEAM(3);
    if (IN(4)) { attn_phase(p, lds, G); ret_kv_phase(p, lds, G); if (DUP & 2) { attn_phase(p, lds, G); } if (DUP & 4) { ret_kv_phase(p, lds, G); } }
    SEAM(4);
    if (IN(5)) { ret_scan_phase(p, G); }
    SEAM(5);
    if (IN(6)) { ret_out_phase(p, lds, G); if (DUP & 8) { ret_out_phase(p, lds, G); } }
    SEAM(6);
    if (IN(7)) {
        __syncthreads();
        pg8::Gemm g{ACTB, (const bf16_t*)(p.ws + WS_WOUT), T, D, D}; pg8::StaticOrder S; S.init(T, D, G, vc);
        EpiResid<true, false, true, true> E{nullptr, nullptr, ACTA, nullptr, ACTA, SSQ, 1.0f};
        pg8::gemm_phase<EpiResid<true, false, true, true>, pg8::StaticOrder, PG8_ALIGN, PG8_SP2>(lds, g, S, E);
    }
    SEAM(7);
    if (IN(8)) {
        pg8::Gemm g{ACTA, (const bf16_t*)(p.ws + WS_WGU2), T, 2 * FF, D}; pg8::StaticOrder S; S.init(T, 2 * FF, G, vc);
        EpiSwiGLU<true> E{HID, SSQ};
        pg8::gemm_phase<EpiSwiGLU<true>, pg8::StaticOrder, PG8_ALIGN, PG8_SP2>(lds, g, S, E);
    }
    SEAM(8);
    const bool fused_final = (G == 256) && IN(10);
    if (IN(9)) {
        pg8::Gemm g{HID, (const bf16_t*)(p.ws + WS_WD2), T, D, FF}; pg8::StaticOrder S; S.init(T, D, G, vc);
        if (fused_final) { EpiFinal E{ACTA, p.out, SSQ, (unsigned*)(p.ws + WS_TABR), p.in[17]};
            pg8::gemm_phase<EpiFinal, pg8::StaticOrder, PG8_ALIGN, PG8_SP2>(lds, g, S, E); }
        else { EpiResid<true, true, false, false> E{nullptr, nullptr, ACTA, p.out, nullptr, nullptr, 0.5f};
            pg8::gemm_phase<EpiResid<true, true, false, false>, pg8::StaticOrder, PG8_ALIGN, PG8_SP2>(lds, g, S, E); }
    }
    if (!fused_final) { SEAM(9); if (IN(10)) { final_norm_phase(p, G); } }
#undef IN
#undef SEAM
}

extern "C" void kernel_launch(void* const* d_in, const int* in_sizes, int n_in, void* d_out, int out_size, void* d_ws, size_t ws_size, hipStream_t stream) {
    static int grid = 0;
    if (grid == 0) {
        if (n_in != 18 || out_size != T * D || ws_size < WS_END) { fprintf(stderr, "kernel_launch: unexpected shapes (n_in %d, out %d, ws %zu)\n", n_in, out_size, ws_size); grid = -1; return; }
        int dev = 0, cus = 0, per_cu = 0;
        if (hipGetDevice(&dev) != hipSuccess || hipDeviceGetAttribute(&cus, hipDeviceAttributeMultiprocessorCount, dev) != hipSuccess) { grid = -1; return; }
        if (hipFuncSetAttribute((const void*)mk_fwd, hipFuncAttributeMaxDynamicSharedMemorySize, LDS_BYTES) != hipSuccess) { fprintf(stderr, "kernel_launch: hipFuncSetAttribute failed\n"); grid = -1; return; }
        if (hipOccupancyMaxActiveBlocksPerMultiprocessor(&per_cu, (const void*)mk_fwd, NTHR, LDS_BYTES) != hipSuccess || per_cu < 1) { fprintf(stderr, "kernel_launch: occupancy query says %d\n", per_cu); per_cu = 1; }
        (void)hipGetLastError();
        grid = cus;
    }
    if (grid < 0) return;
    if (hipMemsetAsync((unsigned char*)d_ws + WS_TABR, 0, (192 * 64 + 4096) * 4, stream) != hipSuccess) { fprintf(stderr, "kernel_launch: memset of the control words failed\n"); return; }
    Params a{};
    for (int i = 0; i < 18; ++i) a.in[i] = (const float*)d_in[i];
    a.out = (float*)d_out; a.ws = (unsigned char*)d_ws;
#if MK_ONE_LAUNCH
    a.ph_lo = 0; a.ph_hi = NPHASE;
    void* args[] = {&a};
    hipError_t e = hipLaunchCooperativeKernel((const void*)mk_fwd, dim3(grid), dim3(NTHR), args, LDS_BYTES, stream);
    if (e != hipSuccess) fprintf(stderr, "kernel_launch: cooperative launch failed: %s (grid %d)\n", hipGetErrorString(e), grid);
#else
    for (int ph = 0; ph < NPHASE; ++ph) { a.ph_lo = ph; a.ph_hi = ph + 1; hipLaunchKernelGGL(mk_fwd, dim3(grid), dim3(NTHR), LDS_BYTES, stream, a); }
#endif
}
```

```cpp
#include <hip/hip_runtime.h>
#include <hip/hip_cooperative_groups.h>
#include <cstdio>
#include <cstdint>
namespace cg = cooperative_groups;
#ifndef DUP
#define DUP 0
#endif
#ifndef MK_ONE_LAUNCH
#define MK_ONE_LAUNCH 1
#endif
namespace pg8 {
#define PG8_LAS __attribute__((address_space(3)))
typedef unsigned short bf16_t;
typedef short bf16x8 __attribute__((ext_vector_type(8)));
typedef float f32x4 __attribute__((ext_vector_type(4)));
typedef unsigned u32x4 __attribute__((ext_vector_type(4)));
constexpr int BM = 256, BK = 64, HALF = 128, HTB = HALF * BK * 2  , STAGE_BYTES = 8 * HTB, NXCD = 8, WGM = 8;

__host__ __device__ __forceinline__ int lds_byte(int r, int c) { const int st = (r >> 4) * 2 + (c >> 5), rr = r & 15, cc = c & 31, ob = rr * 64 + cc * 2; return st * 1024 + (ob ^ (((ob >> 9) & 1) << 5)); }
__host__ __device__ __forceinline__ void stage_rc(int b, int& R, int& C) { const int st = b / 1024, sb = b % 1024, swz = sb ^ (((sb >> 9) & 1) << 5); R = (st >> 1) * 16 + swz / 64; C = (st & 1) * 32 + (swz % 64) / 2; }
__host__ __device__ __forceinline__ int perm32(int rho) { const int n = rho >> 4, i = rho & 15; return 8 * (i >> 2) + 4 * n + (i & 3); }

struct Unit { int pm, pn; };
struct Gemm { const bf16_t* A; const bf16_t* Bt; int M, N, K; };

struct StaticOrder {
    int nM, nN, nwg, G, c;
    __host__ __device__ void init(int M, int N, int G_, int c_) { nM = M / BM; nN = N / BM; nwg = nM * nN; G = G_; c = c_; }
    __host__ __device__ bool next(int i, Unit& u) const {
        const long L = (long)i * G + c; if (L >= nwg) return false;
        int wgid = (int)L; { const int q = nwg / NXCD, r = nwg % NXCD, xcd = wgid % NXCD, off = wgid / NXCD; wgid = (xcd < r ? xcd * (q + 1) : r * (q + 1) + (xcd - r) * q) + off; }
        const int nig = WGM * nN, gid = wgid / nig, fm = gid * WGM, gsz = (nM - fm) < WGM ? (nM - fm) : WGM;
        u.pm = fm + ((wgid % nig) % gsz); u.pn = (wgid % nig) / gsz; return true;
    }
    __device__ __forceinline__ void a_ready(const Unit&) const {}
    __device__ __forceinline__ void done(const Unit&) const {}
};

__device__ __forceinline__ unsigned cvt_pk_bf16(float lo, float hi) { unsigned r; asm volatile("v_cvt_pk_bf16_f32 %0, %1, %2" : "=v"(r) : "v"(lo), "v"(hi)); return r; }
typedef float f32x2 __attribute__((ext_vector_type(2)));
template <class Epi, class Sched, bool ALIGN_EPI = false, bool SP2 = false>
__device__ __forceinline__ void gemm_phase(PG8_LAS unsigned char* lds, const Gemm g, const Sched& S, const Epi& E) {
    const int tid = threadIdx.x, wid = __builtin_amdgcn_readfirstlane(tid >> 6), lane = tid & 63, wr = wid >> 2, wc = wid & 3, fr = lane & 15, fq = lane >> 4;
    const int K = g.K, nt = K / BK;
    unsigned voffA[2], voffB[2];
#pragma unroll
    for (int i = 0; i < 2; ++i) { int R, C; stage_rc(tid * 16 + i * 8192, R, C); const int Rb = Epi::PERM ? ((R & ~31) + perm32(R & 31)) : R;
        voffA[i] = (unsigned)(R * K + C) * 2u; voffB[i] = (unsigned)(Rb * K + C) * 2u; }
    const size_t kstep = (size_t)(BK * 2);
    const size_t hstep = (size_t)HALF * K * 2;
    const size_t tstep = 2 * hstep;
    const unsigned ldsw = (unsigned)wid * 1024u;
    const int aoff = lds_byte(wr * 64 + fr, fq * 8), boff = lds_byte(wc * 32 + fr, fq * 8);
#define PG8_SA(b, h) (((b) * 2 + (h)) * HTB)
#define PG8_SB(b, h) ((4 + (b) * 2 + (h)) * HTB)
#define PG8_STAGE(bufoff, gbase, voff) do { _Pragma("unroll") for (int _i = 0; _i < 2; ++_i) \
        __builtin_amdgcn_global_load_lds((const unsigned*)((const char*)(gbase) + (voff)[_i]), (PG8_LAS unsigned*)(lds + (bufoff) + ldsw + _i * 8192), 16, 0, 0); } while (0)
#define PG8_LDA(dst, b, h) do { _Pragma("unroll") for (int m = 0; m < 4; ++m) _Pragma("unroll") for (int k = 0; k < 2; ++k) dst[m][k] = *(const PG8_LAS bf16x8*)(lds + PG8_SA(b, h) + aoff + m * 2048 + k * 1024); } while (0)
#define PG8_LDB(dst, b, h) do { _Pragma("unroll") for (int n = 0; n < 2; ++n) _Pragma("unroll") for (int k = 0; k < 2; ++k) dst[n][k] = *(const PG8_LAS bf16x8*)(lds + PG8_SB(b, h) + boff + n * 2048 + k * 1024); } while (0)
#define PG8_MMA(ai, bj, At, Bt) do { __builtin_amdgcn_s_setprio(1); _Pragma("unroll") for (int m = 0; m < 4; ++m) _Pragma("unroll") for (int n = 0; n < 2; ++n) _Pragma("unroll") for (int k = 0; k < 2; ++k) \
        acc[ai][bj][m][n] = __builtin_amdgcn_mfma_f32_16x16x32_bf16(Bt[n][k], At[m][k], acc[ai][bj][m][n], 0, 0, 0); __builtin_amdgcn_s_setprio(0); } while (0)
#define PG8_WAIT_V(n) asm volatile("s_waitcnt vmcnt(" #n ")" ::: "memory")
#define PG8_WAIT_L(n) asm volatile("s_waitcnt lgkmcnt(" #n ")" ::: "memory")
#define PG8_BAR __builtin_amdgcn_s_barrier()
#define PG8_SCHED __builtin_amdgcn_sched_barrier(0)
    Unit cur, nxt; int ui = 0;
    if (!S.next(0, cur)) return;
    f32x4 acc[2][2][4][2];
#pragma unroll
    for (int a = 0; a < 2; ++a)
#pragma unroll
        for (int b = 0; b < 2; ++b)
#pragma unroll
            for (int m = 0; m < 4; ++m)
#pragma unroll
                for (int n = 0; n < 2; ++n) acc[a][b][m][n] = (f32x4){0.f, 0.f, 0.f, 0.f};
    bf16x8 At[4][2], B0[2][2], B1[2][2];
    const char* cA = (const char*)g.A + (size_t)cur.pm * tstep; const char* cB = (const char*)g.Bt + (size_t)cur.pn * tstep;
    S.a_ready(cur);
    if constexpr (SP2) {
        PG8_STAGE(PG8_SB(0, 0), cB, voffB); PG8_STAGE(PG8_SB(0, 1), cB + hstep, voffB); PG8_STAGE(PG8_SA(0, 0), cA, voffA); PG8_STAGE(PG8_SA(0, 1), cA + hstep, voffA);
        if (wr == 1) PG8_BAR;
        PG8_WAIT_V(2); PG8_BAR;
        PG8_STAGE(PG8_SB(1, 0), cB + kstep, voffB); PG8_STAGE(PG8_SA(1, 0), cA + kstep, voffA); PG8_STAGE(PG8_SB(1, 1), cB + hstep + kstep, voffB);
        PG8_WAIT_V(6); PG8_BAR;
    } else {
        PG8_STAGE(PG8_SB(0, 0), cB, voffB); PG8_STAGE(PG8_SA(0, 0), cA, voffA); PG8_STAGE(PG8_SB(0, 1), cB + hstep, voffB); PG8_STAGE(PG8_SA(0, 1), cA + hstep, voffA);
        if (wr == 1) PG8_BAR;
        PG8_WAIT_V(4); PG8_BAR;
        PG8_STAGE(PG8_SB(1, 0), cB + kstep, voffB); PG8_STAGE(PG8_SA(1, 0), cA + kstep, voffA); PG8_STAGE(PG8_SB(1, 1), cB + hstep + kstep, voffB);
        PG8_WAIT_V(6); PG8_BAR;
    }
    for (;;) {
        const bool has_next = S.next(ui + 1, nxt);
        const char* nA = has_next ? (const char*)g.A + (size_t)nxt.pm * tstep : cA; const char* nB = has_next ? (const char*)g.Bt + (size_t)nxt.pn * tstep : cB;
        for (int t = 0; t < nt; t += 2) {
            const bool last = (t == nt - 2);
            const char* a1 = cA + (size_t)(t + 1) * kstep;
            const char* a2 = last ? nA : cA + (size_t)(t + 2) * kstep; const char* b2 = last ? nB : cB + (size_t)(t + 2) * kstep;
            const char* a3 = a2 + kstep; const char* b3 = b2 + kstep;
            if (last && has_next) S.a_ready(nxt);
            if constexpr (SP2) {
            PG8_LDB(B0, 0, 0); PG8_LDB(B1, 0, 1); PG8_SCHED; PG8_LDA(At, 0, 0); PG8_STAGE(PG8_SA(1, 1), a1 + hstep, voffA);
            PG8_WAIT_V(8); PG8_WAIT_L(0); PG8_BAR; PG8_MMA(0, 0, At, B0); PG8_MMA(0, 1, At, B1); PG8_BAR; PG8_SCHED;
            PG8_LDA(At, 0, 1); PG8_STAGE(PG8_SB(0, 0), b2, voffB); PG8_STAGE(PG8_SB(0, 1), b2 + hstep, voffB); PG8_STAGE(PG8_SA(0, 0), a2, voffA);
            PG8_WAIT_V(8); PG8_WAIT_L(0); PG8_BAR; PG8_MMA(1, 0, At, B0); PG8_MMA(1, 1, At, B1); PG8_BAR; PG8_SCHED;
            PG8_LDB(B0, 1, 0); PG8_LDB(B1, 1, 1); PG8_SCHED; PG8_LDA(At, 1, 0); PG8_STAGE(PG8_SA(0, 1), a2 + hstep, voffA);
            PG8_WAIT_V(8); PG8_WAIT_L(0); PG8_BAR; PG8_MMA(0, 0, At, B0); PG8_MMA(0, 1, At, B1); PG8_BAR; PG8_SCHED;
            PG8_LDA(At, 1, 1); PG8_STAGE(PG8_SB(1, 0), b3, voffB); PG8_STAGE(PG8_SB(1, 1), b3 + hstep, voffB); PG8_STAGE(PG8_SA(1, 0), a3, voffA);
            PG8_WAIT_V(8); PG8_WAIT_L(0); PG8_BAR; PG8_MMA(1, 0, At, B0); PG8_MMA(1, 1, At, B1); PG8_BAR; PG8_SCHED;
            } else {
            PG8_LDB(B0, 0, 0); PG8_SCHED; PG8_LDA(At, 0, 0); PG8_STAGE(PG8_SA(1, 1), a1 + hstep, voffA);
            PG8_WAIT_L(8); PG8_BAR; PG8_WAIT_L(0); PG8_MMA(0, 0, At, B0); PG8_BAR; PG8_SCHED;
            PG8_LDB(B1, 0, 1); PG8_STAGE(PG8_SB(0, 0), b2, voffB);
            PG8_BAR; PG8_WAIT_L(0); PG8_MMA(0, 1, At, B1); PG8_BAR;
            PG8_LDA(At, 0, 1); PG8_STAGE(PG8_SA(0, 0), a2, voffA);
            PG8_BAR; PG8_WAIT_L(0); PG8_MMA(1, 0, At, B0); PG8_BAR; PG8_SCHED;
            PG8_STAGE(PG8_SB(0, 1), b2 + hstep, voffB);
            PG8_WAIT_V(6); PG8_BAR; PG8_MMA(1, 1, At, B1); PG8_BAR;
            PG8_LDB(B0, 1, 0); PG8_SCHED; PG8_LDA(At, 1, 0); PG8_STAGE(PG8_SA(0, 1), a2 + hstep, voffA);
            PG8_WAIT_L(8); PG8_BAR; PG8_WAIT_L(0); PG8_MMA(0, 0, At, B0); PG8_BAR; PG8_SCHED;
            PG8_LDB(B1, 1, 1); PG8_STAGE(PG8_SB(1, 0), b3, voffB);
            PG8_BAR; PG8_WAIT_L(0); PG8_MMA(0, 1, At, B1); PG8_BAR;
            PG8_LDA(At, 1, 1); PG8_STAGE(PG8_SA(1, 0), a3, voffA);
            PG8_BAR; PG8_WAIT_L(0); PG8_MMA(1, 0, At, B0); PG8_BAR; PG8_SCHED;
            PG8_STAGE(PG8_SB(1, 1), b3 + hstep, voffB);
            PG8_WAIT_V(6); PG8_BAR; PG8_MMA(1, 1, At, B1); PG8_BAR;
            }
        }
        if constexpr (ALIGN_EPI) { if (wr == 0) PG8_BAR; }
        if constexpr (!Epi::AFTER_DRAIN) { E(acc, cur, wr, wc, fr, fq); S.done(cur); }
        if (!has_next) break;
#pragma unroll
        for (int a = 0; a < 2; ++a)
#pragma unroll
            for (int b = 0; b < 2; ++b)
#pragma unroll
                for (int m = 0; m < 4; ++m)
#pragma unroll
                    for (int n = 0; n < 2; ++n) acc[a][b][m][n] = (f32x4){0.f, 0.f, 0.f, 0.f};
        cur = nxt; cA = nA; cB = nB; ++ui;
        if constexpr (ALIGN_EPI) { if (wr == 1) PG8_BAR; }
    }
    PG8_WAIT_V(0);
    if constexpr (!ALIGN_EPI) { if (wr == 0) PG8_BAR; }
    PG8_BAR;
    if constexpr (Epi::AFTER_DRAIN) { E.fused(acc, cur, wr, wc, fr, fq, lds, wid, lane); S.done(cur); }
#undef PG8_SA
#undef PG8_SB
#undef PG8_STAGE
#undef PG8_LDA
#undef PG8_LDB
#undef PG8_MMA
#undef PG8_WAIT_V
#undef PG8_WAIT_L
#undef PG8_BAR
#undef PG8_SCHED
}
}

#ifndef PG8_SP2
#define PG8_SP2 true
#endif
#ifndef PG8_ALIGN
#define PG8_ALIGN true
#endif

#define LAS __attribute__((address_space(3)))
using pg8::bf16_t; using pg8::bf16x8; using pg8::f32x4; using pg8::u32x4;
typedef float f32x2_t __attribute__((ext_vector_type(2)));
typedef __bf16 bf16x2_t __attribute__((ext_vector_type(2)));
__device__ __forceinline__ unsigned cvt_pk_bf16(float lo, float hi) { f32x2_t v = {lo, hi}; bf16x2_t b = __builtin_convertvector(v, bf16x2_t); return __builtin_bit_cast(unsigned, b); }
typedef unsigned u32x2 __attribute__((ext_vector_type(2)));
constexpr int T = 49152, TP = 32768, D = 1024, FF = 2816, DIN = 2816, NTHR = 512;
constexpr float EPS = 1e-6f;
constexpr size_t MiB = 1u << 20;
constexpr size_t WU = (size_t)2816 * 1024 * 2;
constexpr size_t WS_WGU1 = 0, WS_WD1 = 2 * WU, WS_WIN = 3 * WU, WS_WOUT = 4 * WU, WS_WGU2 = WS_WOUT + 2 * MiB, WS_WD2 = WS_WGU2 + 2 * WU;
constexpr size_t WS_TABR = WS_WD2 + WU, WS_TABA = WS_TABR + 8192 * 64 * 8, WS_SSQ = WS_TABA + 8192 * 8 * 8;
constexpr size_t WS_ACTA = 48 * MiB, WS_ACTB = 144 * MiB, WS_HID = 240 * MiB, WS_END = 504 * MiB;
static_assert(WS_SSQ + (size_t)T * 16 * 4 <= WS_ACTA, "ws map");
static_assert(WS_ACTA + (size_t)T * D * 2 <= WS_ACTB && WS_ACTB + (size_t)T * D * 2 <= WS_HID && WS_HID + (size_t)T * FF * 2 <= WS_END, "ws map");
constexpr int LDS_BYTES = 147456;

struct Params { const float* in[18]; float* out; unsigned char* ws; int ph_lo, ph_hi; };

__device__ __forceinline__ float silu_f(float x) { return x * __builtin_amdgcn_rcpf(1.0f + __builtin_amdgcn_exp2f(-1.4426950408889634f * x)); }
__device__ __forceinline__ float fexp(float x) { return __builtin_amdgcn_exp2f(1.4426950408889634f * x); }
__device__ __forceinline__ float bf2f(unsigned short b) { return __builtin_bit_cast(float, ((unsigned)b) << 16); }
__device__ __forceinline__ unsigned f2bf(float f) { unsigned u = __builtin_bit_cast(unsigned, f); return (u + 0x7fffu + ((u >> 16) & 1u)) >> 16; }
__device__ __forceinline__ unsigned pk2(float lo, float hi) { return f2bf(lo) | (f2bf(hi) << 16); }
__device__ __forceinline__ float wave_sum(float v) {
#pragma unroll
    for (int o = 1; o < 64; o <<= 1) v += __shfl_xor(v, o);
    return v;
}
__device__ __forceinline__ int row_pos(int row) { return row < TP ? (row & 8191) : (row & 2047); }
__device__ __forceinline__ float row_rstd(const float* ssq, int row, int fq) {
    const f32x4 p = *(const f32x4*)(ssq + (size_t)row * 16 + 4 * fq);
    float s = (p[0] + p[1]) + (p[2] + p[3]);
    s += __shfl_xor(s, 16); s += __shfl_xor(s, 32);
    return __builtin_amdgcn_rsqf(s * (1.0f / 1024.0f) + EPS);
}

__device__ __forceinline__ void row_rstd8(const float* ssq, int row0, int fq, float (&r)[8]) {
    f32x4 pp[8];
#pragma unroll
    for (int q = 0; q < 8; ++q) pp[q] = *(const f32x4*)(ssq + (size_t)(row0 + (q >> 2) * 128 + (q & 3) * 16) * 16 + 4 * fq);
#pragma unroll
    for (int q = 0; q < 8; ++q) { float s = (pp[q][0] + pp[q][1]) + (pp[q][2] + pp[q][3]); s += __shfl_xor(s, 16); s += __shfl_xor(s, 32); r[q] = __builtin_amdgcn_rsqf(s * (1.0f / 1024.0f) + EPS); }
}
template <bool SCALE> struct EpiSwiGLU {
    static constexpr bool PERM = true, AFTER_DRAIN = false;
    bf16_t* O; const float* ssq;
    __device__ __forceinline__ void operator()(const f32x4 (&acc)[2][2][4][2], const pg8::Unit& u, int wr, int wc, int fr, int fq) const {
        const int row0 = u.pm * 256 + wr * 64 + fr, col0 = u.pn * 128 + wc * 32 + 8 * fq;
        float rr[8]; if (SCALE) row_rstd8(ssq, row0, fq, rr);
#pragma unroll
        for (int ai = 0; ai < 2; ++ai)
#pragma unroll
            for (int m = 0; m < 4; ++m) {
                const int row = row0 + ai * 128 + m * 16;
                float r = 1.f; if (SCALE) r = rr[ai * 4 + m];
                const f32x4 g0 = acc[ai][0][m][0] * r, g1 = acc[ai][0][m][1] * r, u0 = acc[ai][1][m][0] * r, u1 = acc[ai][1][m][1] * r;
                u32x4 w;
                w.x = cvt_pk_bf16(silu_f(g0[0]) * u0[0], silu_f(g0[1]) * u0[1]); w.y = cvt_pk_bf16(silu_f(g0[2]) * u0[2], silu_f(g0[3]) * u0[3]);
                w.z = cvt_pk_bf16(silu_f(g1[0]) * u1[0], silu_f(g1[1]) * u1[1]); w.w = cvt_pk_bf16(silu_f(g1[2]) * u1[2], silu_f(g1[3]) * u1[3]);
                *(u32x4*)(O + (size_t)row * FF + col0) = w;
            }
    }
};
template <bool RB, bool OF, bool OB, bool WS> struct EpiResid {
    static constexpr bool PERM = true, AFTER_DRAIN = false;
    const float* res0; const float* res1; const bf16_t* resb; float* out; bf16_t* outb; float* ssq; float scale;
    __device__ __forceinline__ void operator()(const f32x4 (&acc)[2][2][4][2], const pg8::Unit& u, int wr, int wc, int fr, int fq) const {
        const int row0 = u.pm * 256 + wr * 64 + fr, col0 = u.pn * 256 + wc * 32 + 8 * fq;
        const float* rb = (u.pm * 256 < TP) ? res0 : res1;
#pragma unroll
        for (int ai = 0; ai < 2; ++ai)
#pragma unroll
            for (int mp = 0; mp < 2; ++mp) {
                f32x4 x[2][2][2];
#pragma unroll
                for (int mq = 0; mq < 2; ++mq)
#pragma unroll
                    for (int bj = 0; bj < 2; ++bj) { const size_t off = (size_t)(row0 + ai * 128 + (2 * mp + mq) * 16) * D + col0 + bj * 128;
                        if (RB) { const u32x4 r = *(const u32x4*)(resb + off);
                            x[mq][bj][0] = (f32x4){__builtin_bit_cast(float, r.x << 16), __builtin_bit_cast(float, r.x & 0xffff0000u), __builtin_bit_cast(float, r.y << 16), __builtin_bit_cast(float, r.y & 0xffff0000u)};
                            x[mq][bj][1] = (f32x4){__builtin_bit_cast(float, r.z << 16), __builtin_bit_cast(float, r.z & 0xffff0000u), __builtin_bit_cast(float, r.w << 16), __builtin_bit_cast(float, r.w & 0xffff0000u)}; }
                        else { x[mq][bj][0] = __builtin_nontemporal_load((const f32x4*)(rb + off)); x[mq][bj][1] = __builtin_nontemporal_load((const f32x4*)(rb + off + 4)); } }
#pragma unroll
                for (int mq = 0; mq < 2; ++mq) { const int m = 2 * mp + mq, row = row0 + ai * 128 + m * 16; float ss = 0.f;
#pragma unroll
                    for (int bj = 0; bj < 2; ++bj) { const size_t off = (size_t)row * D + col0 + bj * 128;
                        const f32x4 v0 = x[mq][bj][0] + acc[ai][bj][m][0] * scale, v1 = x[mq][bj][1] + acc[ai][bj][m][1] * scale;
                        if (OF) { *(f32x4*)(out + off) = v0; *(f32x4*)(out + off + 4) = v1; }
                        if (OB) { u32x4 w; w.x = cvt_pk_bf16(v0[0], v0[1]); w.y = cvt_pk_bf16(v0[2], v0[3]); w.z = cvt_pk_bf16(v1[0], v1[1]); w.w = cvt_pk_bf16(v1[2], v1[3]); *(u32x4*)(outb + off) = w; }
                        if (WS) ss += ((v0[0] * v0[0] + v0[1] * v0[1]) + (v0[2] * v0[2] + v0[3] * v0[3])) + ((v1[0] * v1[0] + v1[1] * v1[1]) + (v1[2] * v1[2] + v1[3] * v1[3])); }
                    if (WS) { ss += __shfl_xor(ss, 16); ss += __shfl_xor(ss, 32); if (fq == 0) ssq[(size_t)row * 16 + u.pn * 4 + wc] = ss; } }
            }
    }
};
struct EpiProj {
    static constexpr bool PERM = true, AFTER_DRAIN = false;
    bf16_t* O; const float* ssq;
    __device__ __forceinline__ void operator()(const f32x4 (&acc)[2][2][4][2], const pg8::Unit& u, int wr, int wc, int fr, int fq) const {
        const int row0 = u.pm * 256 + wr * 64 + fr, col0 = u.pn * 256 + wc * 32 + 8 * fq;
        float rr[8]; row_rstd8(ssq, row0, fq, rr);
        float fa[4], fr4[4];
#pragma unroll
        for (int j = 0; j < 4; ++j) { fa[j] = 0.15915494309189535f * exp2f(-18.931568569324174f * ((float)(2 * (4 * fq + j)) * (1.0f / 16.0f)));
                                      fr4[j] = 0.15915494309189535f * exp2f(-13.287712379549449f * ((float)(16 * wc + 4 * fq + j) * (1.0f / 63.0f))); }
#pragma unroll
        for (int ai = 0; ai < 2; ++ai)
#pragma unroll
            for (int m = 0; m < 4; ++m) {
                const int row = row0 + ai * 128 + m * 16; const float pos = (float)row_pos(row);
                const float r = rr[ai * 4 + m];
#pragma unroll
                for (int bj = 0; bj < 2; ++bj) {
                    const int seg = 2 * u.pn + bj;
                    float sc = r; if (seg < 4) sc = r * 0.125f; if (seg >= 10 && seg < 14) sc = r * 0.08838834764831845f;
                    f32x4 v0 = acc[ai][bj][m][0] * sc, v1 = acc[ai][bj][m][1] * sc;
                    const bool rotA = (seg <= 4) && ((wc & 1) == 0) && (fq < 2), rotR = (seg >= 6 && seg < 14);
                    if (seg <= 4 || rotR) {
#pragma unroll
                        for (int j = 0; j < 4; ++j) { const float rev = pos * (rotR ? fr4[j] : fa[j]), fv = rev - __builtin_floorf(rev);
                            const float c = (rotA || rotR) ? __builtin_amdgcn_cosf(fv) : 1.0f, sn = (rotA || rotR) ? __builtin_amdgcn_sinf(fv) : 0.0f;
                            const float x1 = v0[j], x2 = v1[j]; v0[j] = x1 * c - x2 * sn; v1[j] = x2 * c + x1 * sn; }
                    }
                    u32x4 w; w.x = cvt_pk_bf16(v0[0], v0[1]); w.y = cvt_pk_bf16(v0[2], v0[3]); w.z = cvt_pk_bf16(v1[0], v1[1]); w.w = cvt_pk_bf16(v1[2], v1[3]);
                    *(u32x4*)(O + (size_t)row * DIN + col0 + bj * 128) = w;
                }
            }
    }
};

struct EpiFinal {
    static constexpr bool PERM = true, AFTER_DRAIN = false;
    const bf16_t* resb; float* out; float* xch; unsigned* cnt; const float* gain;
    __device__ __forceinline__ void operator()(const f32x4 (&acc_)[2][2][4][2], const pg8::Unit& u, int wr, int wc, int fr, int fq) const {
        f32x4 (&A)[2][2][4][2] = const_cast<f32x4 (&)[2][2][4][2]>(acc_);
        const int row0 = u.pm * 256 + wr * 64 + fr, col0 = u.pn * 256 + wc * 32 + 8 * fq, lane = threadIdx.x & 63;
#pragma unroll
        for (int ai = 0; ai < 2; ++ai)
#pragma unroll
            for (int m = 0; m < 4; ++m) {
                const int row = row0 + ai * 128 + m * 16; float ss = 0.f;
#pragma unroll
                for (int bj = 0; bj < 2; ++bj) {
                    const size_t off = (size_t)row * D + col0 + bj * 128;
                    const u32x4 r = *(const u32x4*)(resb + off);
                    const f32x4 x0 = (f32x4){__builtin_bit_cast(float, r.x << 16), __builtin_bit_cast(float, r.x & 0xffff0000u), __builtin_bit_cast(float, r.y << 16), __builtin_bit_cast(float, r.y & 0xffff0000u)};
                    const f32x4 x1 = (f32x4){__builtin_bit_cast(float, r.z << 16), __builtin_bit_cast(float, r.z & 0xffff0000u), __builtin_bit_cast(float, r.w << 16), __builtin_bit_cast(float, r.w & 0xffff0000u)};
                    const f32x4 v0 = x0 + A[ai][bj][m][0] * 0.5f, v1 = x1 + A[ai][bj][m][1] * 0.5f;
                    A[ai][bj][m][0] = v0; A[ai][bj][m][1] = v1;
                    ss += ((v0[0] * v0[0] + v0[1] * v0[1]) + (v0[2] * v0[2] + v0[3] * v0[3])) + ((v1[0] * v1[0] + v1[1] * v1[1]) + (v1[2] * v1[2] + v1[3] * v1[3]));
                }
                ss += __shfl_xor(ss, 16); ss += __shfl_xor(ss, 32);
                if (fq == 0) __hip_atomic_store(xch + (size_t)row * 16 + u.pn * 4 + wc, ss, __ATOMIC_RELAXED, __HIP_MEMORY_SCOPE_AGENT);
            }
        asm volatile("s_waitcnt vmcnt(0)" ::: "memory");
        unsigned* cw = cnt + 64 * u.pm;
        if (lane == 0) __hip_atomic_fetch_add(cw, 1u, __ATOMIC_RELAXED, __HIP_MEMORY_SCOPE_AGENT);
        { unsigned spins = 0;
          while ((unsigned)__builtin_amdgcn_readfirstlane(__hip_atomic_load(cw, __ATOMIC_RELAXED, __HIP_MEMORY_SCOPE_AGENT)) < 32u) { if (++spins > (1u << 22)) break; __builtin_amdgcn_s_sleep(2); } }
        __builtin_amdgcn_fence(__ATOMIC_ACQUIRE, "agent");
        asm volatile("s_waitcnt vmcnt(0)" ::: "memory");
        f32x4 g[2][2];
#pragma unroll
        for (int bj = 0; bj < 2; ++bj) { g[bj][0] = *(const f32x4*)(gain + col0 + bj * 128); g[bj][1] = *(const f32x4*)(gain + col0 + bj * 128 + 4); }
#pragma unroll
        for (int ai = 0; ai < 2; ++ai)
#pragma unroll
            for (int m = 0; m < 4; ++m) {
                const int row = row0 + ai * 128 + m * 16; const float* xp = xch + (size_t)row * 16 + 4 * fq;
                float s = (__hip_atomic_load(xp + 0, __ATOMIC_RELAXED, __HIP_MEMORY_SCOPE_AGENT) + __hip_atomic_load(xp + 1, __ATOMIC_RELAXED, __HIP_MEMORY_SCOPE_AGENT))
                        + (__hip_atomic_load(xp + 2, __ATOMIC_RELAXED, __HIP_MEMORY_SCOPE_AGENT) + __hip_atomic_load(xp + 3, __ATOMIC_RELAXED, __HIP_MEMORY_SCOPE_AGENT));
                s += __shfl_xor(s, 16); s += __shfl_xor(s, 32);
                const float rstd = __builtin_amdgcn_rsqf(s * (1.0f / 1024.0f) + EPS);
#pragma unroll
                for (int bj = 0; bj < 2; ++bj) { const size_t off = (size_t)row * D + col0 + bj * 128;
                    __builtin_nontemporal_store(A[ai][bj][m][0] * rstd * g[bj][0], (f32x4*)(out + off)); __builtin_nontemporal_store(A[ai][bj][m][1] * rstd * g[bj][1], (f32x4*)(out + off + 4)); }
            }
    }
};

__device__ __forceinline__ void p0_item(const float* W, int ldw, int sc, const float* gain, int gain_lim, bf16_t* WT, int K, int n0, int k0, LAS float* scr, int lane) {
    float wv[32];
#pragma unroll
    for (int i = 0; i < 32; ++i) { const int k = k0 + 2 * i + (lane >> 5); wv[i] = W[(size_t)k * ldw + sc]; }
#pragma unroll
    for (int i = 0; i < 32; ++i) { const int kk = 2 * i + (lane >> 5), k = k0 + kk; float v = wv[i]; if (gain && k < gain_lim) v *= gain[k]; scr[kk * 33 + (lane & 31)] = v; }
    asm volatile("s_waitcnt lgkmcnt(0)" ::: "memory");
    const int c = lane & 7;
#pragma unroll
    for (int j = 0; j < 4; ++j) { const int n = (lane >> 3) + 8 * j; const LAS float* s = scr + (8 * c) * 33 + n;
        u32x4 o; o.x = pk2(s[0 * 33], s[1 * 33]); o.y = pk2(s[2 * 33], s[3 * 33]); o.z = pk2(s[4 * 33], s[5 * 33]); o.w = pk2(s[6 * 33], s[7 * 33]);
        *(u32x4*)(WT + (size_t)(n0 + n) * K + k0 + 8 * c) = o; }
    asm volatile("s_waitcnt lgkmcnt(0)" ::: "memory");
}
__device__ __forceinline__ int win_srccol(int n) {
    if (n < 640) { const int p = n & 63; if (p < 16) return (n - p) + ((p & 3) | ((p & 4) << 1) | ((p & 8) >> 1)); return n; }
    if (n >= 768 && n < 1792) { const int p = (n - 768) & 127, q = p >> 3, nn = (p >> 2) & 1, j = p & 3; return (n - p) + nn * 64 + 4 * q + j; }
    return n;
}
__device__ __forceinline__ void p0_prologue(const Params& p, LAS unsigned char* lds, int G) {
    const int tid = threadIdx.x, lane = tid & 63, wave = tid >> 6;
    LAS float* scr = (LAS float*)(lds + wave * 16384);
    const int gw = blockIdx.x * 8 + wave, NGW = G * 8;
    constexpr int I_GU = 16 * 176, I_D = 44 * 32, I_IN = 16 * 88, I_OUT = 16 * 32;
    constexpr int NITEMS = 2 * I_GU + 2 * I_D + I_IN + I_OUT;
    for (int it = gw; it < NITEMS; it += NGW) {
        int r = it;
        if (r < 2 * I_GU) {
            const int which = r / I_GU; r -= which * I_GU; const int nb = r % 176, kb = r / 176, n0 = nb * 32;
            const int pn = n0 >> 8, q = n0 & 255, bj = q >> 7, hid = pn * 128 + (q & 127) + (lane & 31);
            const float* W = which == 0 ? (bj ? p.in[4] : p.in[3]) : (bj ? p.in[15] : p.in[14]);
            p0_item(W, FF, hid, which == 0 ? nullptr : p.in[13], 1 << 30, (bf16_t*)(p.ws + (which == 0 ? WS_WGU1 : WS_WGU2)), D, n0, kb * 64, scr, lane); continue; }
        r -= 2 * I_GU;
        if (r < 2 * I_D) {
            const int which = r / I_D; r -= which * I_D; const int nb = r % 32, kb = r / 32, n0 = nb * 32;
            p0_item(which == 0 ? p.in[5] : p.in[16], D, n0 + (lane & 31), nullptr, 0, (bf16_t*)(p.ws + (which == 0 ? WS_WD1 : WS_WD2)), FF, n0, kb * 64, scr, lane); continue; }
        r -= 2 * I_D;
        if (r < I_IN) { const int nb = r % 88, kb = r / 88, n0 = nb * 32;
            p0_item(p.in[7], DIN, win_srccol(n0 + (lane & 31)), p.in[6], 1 << 30, (bf16_t*)(p.ws + WS_WIN), D, n0, kb * 64, scr, lane); continue; }
        r -= I_IN;
        { const int nb = r % 32, kb = r / 32, n0 = nb * 32;
            p0_item(p.in[12], D, n0 + (lane & 31), p.in[9], 512, (bf16_t*)(p.ws + WS_WOUT), D, n0, kb * 64, scr, lane); }
    }
    bf16_t* XN = (bf16_t*)(p.ws + WS_ACTA);
    const f32x4* gp = (const f32x4*)p.in[2] + lane;
    for (int rb = gw * 4; rb < T; rb += NGW * 4) {
        f32x4 v[4][4]; float s[4];
#pragma unroll
        for (int q = 0; q < 4; ++q) { const int row = rb + q; const float* xrow = row < TP ? p.in[0] + (size_t)row * D : p.in[1] + (size_t)(row - TP) * D; const f32x4* xr = (const f32x4*)xrow + lane;
#pragma unroll
            for (int j = 0; j < 4; ++j) v[q][j] = __builtin_nontemporal_load(xr + 64 * j); }
#pragma unroll
        for (int q = 0; q < 4; ++q) { float a = 0.f;
#pragma unroll
            for (int j = 0; j < 4; ++j) a += (v[q][j][0] * v[q][j][0] + v[q][j][1] * v[q][j][1]) + (v[q][j][2] * v[q][j][2] + v[q][j][3] * v[q][j][3]);
            s[q] = a; }
#pragma unroll
        for (int q = 0; q < 4; ++q) { const float rstd = __builtin_amdgcn_rsqf(wave_sum(s[q]) * (1.f / D) + EPS);
            u32x2* o8 = (u32x2*)(XN + (size_t)(rb + q) * D) + lane;
#pragma unroll
            for (int j = 0; j < 4; ++j) { const f32x4 g = gp[64 * j]; u32x2 w; w.x = pk2(v[q][j][0] * rstd * g[0], v[q][j][1] * rstd * g[1]); w.y = pk2(v[q][j][2] * rstd * g[2], v[q][j][3] * rstd * g[3]); o8[64 * j] = w; } }
    }
}

#define MMA16(b, a, c) __builtin_amdgcn_mfma_f32_16x16x32_bf16((b), (a), (c), 0, 0, 0)
#define LDS16(ptr) (*(const LAS bf16x8*)(ptr))
typedef short v4i16_t __attribute__((ext_vector_type(4)));
__device__ __forceinline__ bf16x8 tr_frag(const LAS bf16_t* p, int pitch) {
    const v4i16_t lo = __builtin_amdgcn_ds_read_tr16_b64_v4i16((LAS v4i16_t*)p), hi = __builtin_amdgcn_ds_read_tr16_b64_v4i16((LAS v4i16_t*)(p + 4 * pitch));
    return (bf16x8){lo[0], lo[1], lo[2], lo[3], hi[0], hi[1], hi[2], hi[3]};
}

__device__ __forceinline__ void attn_phase(const Params& p, LAS unsigned char* lds, int G) {
    const int tid = threadIdx.x, lane = tid & 63, wave = tid >> 6, fr = lane & 15, fq = lane >> 4;
    const bf16_t* proj = (const bf16_t*)(p.ws + WS_HID); bf16_t* mix = (bf16_t*)(p.ws + WS_ACTB);
    LAS bf16_t* Kl = (LAS bf16_t*)lds;
    LAS bf16_t* Vl = (LAS bf16_t*)(lds + 18432);
    LAS bf16_t* Pl = (LAS bf16_t*)(lds + 36864 + wave * 9216);
    LAS float* stat = (LAS float*)(lds + 110592);
    const int h = wave, kvh = h >> 2;
    const float sink = p.in[8][h];
    const int skey = tid >> 3, sdch = tid & 7;
    const int trb = (8 * fq + (fr >> 2)) * 72 + 4 * (fr & 3);
    u32x4 pk[2], pv[2];
#define ATT_RANGE(r0, lo, hi) do { int ss_, se_; if ((r0) < TP) { ss_ = (r0) & ~8191; se_ = ss_ + 8192; } else { ss_ = TP + (((r0) - TP) & ~2047); se_ = ss_ + 2048; } \
        lo = ((r0) - 128 < ss_) ? ((ss_ - ((r0) - 128)) >> 6) : 0; hi = ((r0) + 128 >= se_) ? (((se_ - 64) - ((r0) - 128)) >> 6) : 4; } while (0)
#define ATT_ISSUE(r0, kb) do { const bf16_t* src_ = proj + (size_t)((r0) - 128 + 64 * (kb) + skey) * DIN + 512 + sdch * 8; \
        pk[0] = *(const u32x4*)src_; pv[0] = *(const u32x4*)(src_ + 128); pk[1] = *(const u32x4*)(src_ + 64); pv[1] = *(const u32x4*)(src_ + 192); } while (0)
    int unit = blockIdx.x;
    if (unit < T / 64) { int lo, hi; ATT_RANGE(unit * 64, lo, hi); ATT_ISSUE(unit * 64, lo); (void)hi; }
    for (; unit < T / 64; unit += G) {
        const int row0 = unit * 64; int kb_lo, kb_hi; ATT_RANGE(row0, kb_lo, kb_hi);
        bf16x8 qf[4][2];
#pragma unroll
        for (int m = 0; m < 4; ++m)
#pragma unroll
            for (int k = 0; k < 2; ++k) qf[m][k] = *(const bf16x8*)(proj + (size_t)(row0 + 16 * m + fr) * DIN + h * 64 + 32 * k + 8 * fq);
        f32x4 o[4][4]; float mrow[4], lrow[4];
#pragma unroll
        for (int m = 0; m < 4; ++m) { mrow[m] = sink; lrow[m] = 1.f;
#pragma unroll
            for (int n = 0; n < 4; ++n) o[m][n] = (f32x4){0.f, 0.f, 0.f, 0.f}; }
        for (int kb = kb_lo; kb <= kb_hi; ++kb) {
            const int kstart = row0 - 128 + 64 * kb;
            __syncthreads();
#pragma unroll
            for (int i = 0; i < 2; ++i) {
                *(LAS u32x4*)(Kl + (i * 64 + skey) * 72 + sdch * 8) = pk[i]; *(LAS u32x4*)(Vl + (i * 64 + skey) * 72 + sdch * 8) = pv[i];
            }
            __syncthreads();
            if (kb < kb_hi) { ATT_ISSUE(row0, kb + 1); }
            else if (unit + G < T / 64) { int lo2, hi2; ATT_RANGE((unit + G) * 64, lo2, hi2); ATT_ISSUE((unit + G) * 64, lo2); (void)hi2; }
            bf16x8 kf[4][2];
#pragma unroll
            for (int n = 0; n < 4; ++n) { kf[n][0] = LDS16(Kl + (kvh * 64 + 16 * n + fr) * 72 + 8 * fq); kf[n][1] = LDS16(Kl + (kvh * 64 + 16 * n + fr) * 72 + 32 + 8 * fq); }
            const bool edge = (kb == 0) || (kb == 4);
#pragma unroll
            for (int m = 0; m < 4; ++m) {
                f32x4 s[4];
#pragma unroll
                for (int n = 0; n < 4; ++n) { f32x4 a = (f32x4){0.f, 0.f, 0.f, 0.f}; a = MMA16(kf[n][0], qf[m][0], a); a = MMA16(kf[n][1], qf[m][1], a); s[n] = a; }
                const int i = row0 + 16 * m + fr; float mx = mrow[m];
                if (edge) {
#pragma unroll
                    for (int n = 0; n < 4; ++n)
#pragma unroll
                        for (int e = 0; e < 4; ++e) { const int j = kstart + 16 * n + 4 * fq + e, dlt = i - j; const bool valid = (dlt <= 128) && (dlt >= -128); s[n][e] = valid ? s[n][e] : -1e30f; }
                }
#pragma unroll
                for (int n = 0; n < 4; ++n) mx = fmaxf(fmaxf(mx, fmaxf(s[n][0], s[n][1])), fmaxf(s[n][2], s[n][3]));
                mx = fmaxf(mx, __shfl_xor(mx, 16)); mx = fmaxf(mx, __shfl_xor(mx, 32));
                const float alpha = fexp(mrow[m] - mx); mrow[m] = mx; float ps = 0.f; const float mxl = mx * 1.4426950408889634f;
#pragma unroll
                for (int n = 0; n < 4; ++n) {
                    f32x4 pvv;
#pragma unroll
                    for (int e = 0; e < 4; ++e) { pvv[e] = __builtin_amdgcn_exp2f(s[n][e] * 1.4426950408889634f - mxl); ps += pvv[e]; }
                    u32x2 w; w.x = cvt_pk_bf16(pvv[0], pvv[1]); w.y = cvt_pk_bf16(pvv[2], pvv[3]);
                    *(LAS u32x2*)(Pl + (16 * m + fr) * 72 + 16 * n + 4 * fq) = w;
                    o[m][n] = o[m][n] * alpha;
                }
                ps += __shfl_xor(ps, 16); ps += __shfl_xor(ps, 32);
                lrow[m] = lrow[m] * alpha + ps;
            }
            asm volatile("s_waitcnt lgkmcnt(0)" ::: "memory");
#pragma unroll
            for (int n = 0; n < 4; ++n) {
                const bf16x8 b0 = tr_frag(Vl + kvh * 64 * 72 + trb + 16 * n, 72), b1 = tr_frag(Vl + (kvh * 64 + 32) * 72 + trb + 16 * n, 72);
#pragma unroll
                for (int m = 0; m < 4; ++m) { const bf16x8 a0 = LDS16(Pl + (16 * m + fr) * 72 + 8 * fq), a1 = LDS16(Pl + (16 * m + fr) * 72 + 32 + 8 * fq);
                    o[m][n] = MMA16(b0, a0, o[m][n]); o[m][n] = MMA16(b1, a1, o[m][n]); }
            }
        }
#pragma unroll
        for (int m = 0; m < 4; ++m) { const float inv = 1.0f / lrow[m]; float ss = 0.f;
#pragma unroll
            for (int n = 0; n < 4; ++n) { o[m][n] = o[m][n] * inv; ss += (o[m][n][0] * o[m][n][0] + o[m][n][1] * o[m][n][1]) + (o[m][n][2] * o[m][n][2] + o[m][n][3] * o[m][n][3]); }
            ss += __shfl_xor(ss, 16); ss += __shfl_xor(ss, 32);
            if (fq == 0) stat[h * 64 + 16 * m + fr] = ss; }
        __syncthreads();
#pragma unroll
        for (int m = 0; m < 4; ++m) { float tot = 0.f;
#pragma unroll
            for (int hh = 0; hh < 8; ++hh) tot += stat[hh * 64 + 16 * m + fr];
            const float rn = __builtin_amdgcn_rsqf(tot * (1.0f / 512.0f) + EPS);
#pragma unroll
            for (int n = 0; n < 4; ++n) { const f32x4 v = o[m][n] * rn; u32x2 w; w.x = cvt_pk_bf16(v[0], v[1]); w.y = cvt_pk_bf16(v[2], v[3]);
                *(u32x2*)(mix + (size_t)(row0 + 16 * m + fr) * D + h * 64 + 16 * n + 4 * fq) = w; } }
    }
#undef ATT_RANGE
#undef ATT_ISSUE
    __syncthreads();
}

__device__ __forceinline__ void ret_kv_phase(const Params& p, LAS unsigned char* lds, int G) {
    const int tid = threadIdx.x, lane = tid & 63, wave = tid >> 6, fr = lane & 15, fq = lane >> 4;
    const bf16_t* proj = (const bf16_t*)(p.ws + WS_HID); bf16_t* kvbuf = (bf16_t*)p.out;
    LAS bf16_t* Vl = (LAS bf16_t*)lds; LAS bf16_t* Kf = (LAS bf16_t*)(lds + 34816); LAS bf16_t* Kb = (LAS bf16_t*)(lds + 69632);
    const int stok = tid >> 4, sdch = tid & 15;
    const int trb = (8 * fq + (fr >> 2)) * 136 + 4 * (fr & 3);
    u32x4 pk[4], pv[4];
#define R1_ISSUE(u_) do { const bf16_t* src_ = proj + (size_t)(((u_) >> 2) * 128 + stok) * DIN + 1280 + ((u_) & 3) * 128 + sdch * 8; \
        _Pragma("unroll") for (int i_ = 0; i_ < 4; ++i_) { pk[i_] = *(const u32x4*)(src_ + (size_t)i_ * 32 * DIN); pv[i_] = *(const u32x4*)(src_ + 512 + (size_t)i_ * 32 * DIN); } } while (0)
    int unit = blockIdx.x;
    if (unit < (T / 128) * 4) R1_ISSUE(unit);
    for (; unit < (T / 128) * 4; unit += G) {
        const int c = unit >> 2, h = unit & 3;
        const float ldf = p.in[10][h], ldb = p.in[11][h];
        __syncthreads();
#pragma unroll
        for (int i = 0; i < 4; ++i) {
            const int tok = stok + 32 * i; const float wf = fexp(ldf * (float)(127 - tok)), wb = fexp(ldb * (float)tok);
            const unsigned kw[4] = {pk[i].x, pk[i].y, pk[i].z, pk[i].w}; u32x4 of, ob; unsigned fo[4], bo[4];
#pragma unroll
            for (int q = 0; q < 4; ++q) { const float k0 = bf2f((unsigned short)(kw[q] & 0xffffu)), k1 = bf2f((unsigned short)(kw[q] >> 16)); fo[q] = cvt_pk_bf16(k0 * wf, k1 * wf); bo[q] = cvt_pk_bf16(k0 * wb, k1 * wb); }
            of.x = fo[0]; of.y = fo[1]; of.z = fo[2]; of.w = fo[3]; ob.x = bo[0]; ob.y = bo[1]; ob.z = bo[2]; ob.w = bo[3];
            *(LAS u32x4*)(Vl + tok * 136 + sdch * 8) = pv[i]; *(LAS u32x4*)(Kf + tok * 136 + sdch * 8) = of; *(LAS u32x4*)(Kb + tok * 136 + sdch * 8) = ob;
        }
        __syncthreads();
        if (unit + G < (T / 128) * 4) R1_ISSUE(unit + G);
        const int dir = wave >> 2, mt0 = (wave & 3) * 2; LAS bf16_t* Kx = dir ? Kb : Kf;
        f32x4 acc[2][8];
#pragma unroll
        for (int mi = 0; mi < 2; ++mi)
#pragma unroll
            for (int n = 0; n < 8; ++n) acc[mi][n] = (f32x4){0.f, 0.f, 0.f, 0.f};
#pragma unroll
        for (int k = 0; k < 4; ++k) {
            const bf16x8 a0 = tr_frag(Vl + 32 * k * 136 + trb + (mt0 + 0) * 16, 136), a1 = tr_frag(Vl + 32 * k * 136 + trb + (mt0 + 1) * 16, 136);
#pragma unroll
            for (int n = 0; n < 8; ++n) { const bf16x8 b = tr_frag(Kx + 32 * k * 136 + trb + 16 * n, 136); acc[0][n] = MMA16(b, a0, acc[0][n]); acc[1][n] = MMA16(b, a1, acc[1][n]); }
        }
        bf16_t* dst = kvbuf + ((size_t)(c * 4 + h) * 2 + dir) * 16384;
#pragma unroll
        for (int mi = 0; mi < 2; ++mi)
#pragma unroll
            for (int n = 0; n < 8; ++n) { u32x2 w; w.x = cvt_pk_bf16(acc[mi][n][0], acc[mi][n][1]); w.y = cvt_pk_bf16(acc[mi][n][2], acc[mi][n][3]);
                *(u32x2*)(dst + ((mt0 + mi) * 16 + fr) * 128 + 16 * n + 4 * fq) = w; }
    }
#undef R1_ISSUE
}

__device__ __forceinline__ void ret_scan_phase(const Params& p, int G) {
    bf16_t* kvbuf = (bf16_t*)p.out;
    const int nthr = G * NTHR;
    for (int t = blockIdx.x * NTHR + threadIdx.x; t < 131072; t += nthr) {
        {
            const int e4 = t & 4095, sdh = t >> 12, dir = sdh & 1, h = (sdh >> 1) & 3, b = sdh >> 3, c0 = 64 * b;
            const float Dk = fexp((dir ? p.in[11][h] : p.in[10][h]) * 128.0f);
            float st[4] = {0.f, 0.f, 0.f, 0.f};
            for (int sb = 0; sb < 64; sb += 16) {
                u32x2 v[16];
#pragma unroll
                for (int i = 0; i < 16; ++i) { const int c = dir ? (c0 + 63 - sb - i) : (c0 + sb + i); v[i] = *(const u32x2*)(kvbuf + ((size_t)(c * 4 + h) * 2 + dir) * 16384 + e4 * 4); }
#pragma unroll
                for (int i = 0; i < 16; ++i) { const int c = dir ? (c0 + 63 - sb - i) : (c0 + sb + i);
                    u32x2 w; w.x = pk2(st[0], st[1]); w.y = pk2(st[2], st[3]); *(u32x2*)(kvbuf + ((size_t)(c * 4 + h) * 2 + dir) * 16384 + e4 * 4) = w;
                    st[0] = st[0] * Dk + bf2f((unsigned short)(v[i].x & 0xffffu)); st[1] = st[1] * Dk + bf2f((unsigned short)(v[i].x >> 16));
                    st[2] = st[2] * Dk + bf2f((unsigned short)(v[i].y & 0xffffu)); st[3] = st[3] * Dk + bf2f((unsigned short)(v[i].y >> 16)); }
            }
        }
        {
            const int e8 = t & 2047, sdh = t >> 11, dir = sdh & 1, h = (sdh >> 1) & 3, b = sdh >> 3, c0 = 256 + 16 * b;
            const float Dk = fexp((dir ? p.in[11][h] : p.in[10][h]) * 128.0f);
            float st[8] = {0.f, 0.f, 0.f, 0.f, 0.f, 0.f, 0.f, 0.f};
            u32x4 v[16];
#pragma unroll
            for (int i = 0; i < 16; ++i) { const int c = dir ? (c0 + 15 - i) : (c0 + i); v[i] = *(const u32x4*)(kvbuf + ((size_t)(c * 4 + h) * 2 + dir) * 16384 + e8 * 8); }
#pragma unroll
            for (int i = 0; i < 16; ++i) { const int c = dir ? (c0 + 15 - i) : (c0 + i);
                u32x4 w; w.x = pk2(st[0], st[1]); w.y = pk2(st[2], st[3]); w.z = pk2(st[4], st[5]); w.w = pk2(st[6], st[7]); *(u32x4*)(kvbuf + ((size_t)(c * 4 + h) * 2 + dir) * 16384 + e8 * 8) = w;
                const unsigned vv[4] = {v[i].x, v[i].y, v[i].z, v[i].w};
#pragma unroll
                for (int q = 0; q < 4; ++q) { st[2 * q] = st[2 * q] * Dk + bf2f((unsigned short)(vv[q] & 0xffffu)); st[2 * q + 1] = st[2 * q + 1] * Dk + bf2f((unsigned short)(vv[q] >> 16)); }
            }
        }
    }
}

__device__ __forceinline__ void ret_out_phase(const Params& p, LAS unsigned char* lds, int G) {
    const int tid = threadIdx.x, lane = tid & 63, wave = tid >> 6, fr = lane & 15, fq = lane >> 4;
    const bf16_t* proj = (const bf16_t*)(p.ws + WS_HID); const bf16_t* kvbuf = (const bf16_t*)p.out; bf16_t* mix = (bf16_t*)(p.ws + WS_ACTB);
    LAS bf16_t* Ql = (LAS bf16_t*)lds; LAS bf16_t* Kl = (LAS bf16_t*)(lds + 34816); LAS bf16_t* Vl = (LAS bf16_t*)(lds + 69632); LAS bf16_t* Pl = (LAS bf16_t*)(lds + 104448);
    const int stok = tid >> 4, sdch = tid & 15;
    const int trb = (8 * fq + (fr >> 2)) * 136 + 4 * (fr & 3);
    const int il = 16 * wave + fr;
    u32x4 pq[4], pk[4], pv[4];
#define R3_ISSUE(u_) do { const bf16_t* src_ = proj + (size_t)(((u_) >> 2) * 128 + stok) * DIN + 768 + ((u_) & 3) * 128 + sdch * 8; \
        _Pragma("unroll") for (int i_ = 0; i_ < 4; ++i_) { pq[i_] = *(const u32x4*)(src_ + (size_t)i_ * 32 * DIN); pk[i_] = *(const u32x4*)(src_ + 512 + (size_t)i_ * 32 * DIN); pv[i_] = *(const u32x4*)(src_ + 1024 + (size_t)i_ * 32 * DIN); } } while (0)
    int unit = blockIdx.x;
    if (unit < (T / 128) * 4) R3_ISSUE(unit);
    for (; unit < (T / 128) * 4; unit += G) {
        const int c = unit >> 2, h = unit & 3, row0 = c * 128;
        const float ldf = p.in[10][h], ldb = p.in[11][h];
        __syncthreads();
#pragma unroll
        for (int i = 0; i < 4; ++i) {
            const int tok = stok + 32 * i;
            *(LAS u32x4*)(Ql + tok * 136 + sdch * 8) = pq[i]; *(LAS u32x4*)(Kl + tok * 136 + sdch * 8) = pk[i]; *(LAS u32x4*)(Vl + tok * 136 + sdch * 8) = pv[i];
        }
        __syncthreads();
        u32x4 sfr[4], sbr[4];
        {
            const bf16_t* sf = kvbuf + ((size_t)(c * 4 + h) * 2) * 16384 + stok * 128 + sdch * 8;
#pragma unroll
            for (int i = 0; i < 4; ++i) { sfr[i] = *(const u32x4*)(sf + i * 32 * 128); sbr[i] = *(const u32x4*)(sf + 16384 + i * 32 * 128); }
        }
        bf16x8 qa[4];
#pragma unroll
        for (int k = 0; k < 4; ++k) qa[k] = LDS16(Ql + il * 136 + 32 * k + 8 * fq);
        f32x4 o1[8];
        {
            f32x4 s[8];
#pragma unroll
            for (int n = 0; n < 8; ++n) { s[n] = (f32x4){0.f, 0.f, 0.f, 0.f};
#pragma unroll
                for (int k = 0; k < 4; ++k) s[n] = MMA16(LDS16(Kl + (16 * n + fr) * 136 + 32 * k + 8 * fq), qa[k], s[n]); }
#pragma unroll
            for (int n = 0; n < 8; ++n) { f32x4 pvv;
#pragma unroll
                for (int e = 0; e < 4; ++e) { const int j = 16 * n + 4 * fq + e, dlt = il - j; const float mk = dlt > 0 ? fexp(ldf * (float)dlt) : (dlt < 0 ? fexp(ldb * (float)(-dlt)) : 2.0f); pvv[e] = s[n][e] * mk; }
                u32x2 w; w.x = cvt_pk_bf16(pvv[0], pvv[1]); w.y = cvt_pk_bf16(pvv[2], pvv[3]);
                *(LAS u32x2*)(Pl + il * 136 + 16 * n + 4 * fq) = w; }
            asm volatile("s_waitcnt lgkmcnt(0)" ::: "memory");
            bf16x8 pa[4];
#pragma unroll
            for (int k = 0; k < 4; ++k) pa[k] = LDS16(Pl + il * 136 + 32 * k + 8 * fq);
#pragma unroll
            for (int n = 0; n < 8; ++n) { o1[n] = (f32x4){0.f, 0.f, 0.f, 0.f};
#pragma unroll
                for (int k = 0; k < 4; ++k) o1[n] = MMA16(tr_frag(Vl + 32 * k * 136 + trb + 16 * n, 136), pa[k], o1[n]); }
        }
        __syncthreads();
#pragma unroll
        for (int i = 0; i < 4; ++i) { const int dv = stok + 32 * i; *(LAS u32x4*)(Kl + dv * 136 + sdch * 8) = sfr[i]; *(LAS u32x4*)(Pl + dv * 136 + sdch * 8) = sbr[i]; }
        __syncthreads();
        if (unit + G < (T / 128) * 4) R3_ISSUE(unit + G);
        u32x2 gv[8];
        { const bf16_t* gsrc = proj + (size_t)(row0 + il) * DIN + 2304 + h * 128 + 4 * fq;
#pragma unroll
            for (int n = 0; n < 8; ++n) gv[n] = *(const u32x2*)(gsrc + 16 * n); }
        {
            const float ef = fexp(ldf * (float)(il + 1)), eb = fexp(ldb * (float)(128 - il));
#pragma unroll
            for (int n = 0; n < 8; ++n) { f32x4 a = (f32x4){0.f, 0.f, 0.f, 0.f}, b = (f32x4){0.f, 0.f, 0.f, 0.f};
#pragma unroll
                for (int k = 0; k < 4; ++k) { a = MMA16(LDS16(Kl + (16 * n + fr) * 136 + 32 * k + 8 * fq), qa[k], a); b = MMA16(LDS16(Pl + (16 * n + fr) * 136 + 32 * k + 8 * fq), qa[k], b); }
                o1[n] = o1[n] + a * ef + b * eb; }
        }
        float sm = 0.f;
#pragma unroll
        for (int n = 0; n < 8; ++n) sm += (o1[n][0] + o1[n][1]) + (o1[n][2] + o1[n][3]);
        sm += __shfl_xor(sm, 16); sm += __shfl_xor(sm, 32);
        const float mu = sm * (1.0f / 128.0f); float sq = 0.f;
#pragma unroll
        for (int n = 0; n < 8; ++n) { o1[n] = o1[n] - mu; sq += (o1[n][0] * o1[n][0] + o1[n][1] * o1[n][1]) + (o1[n][2] * o1[n][2] + o1[n][3] * o1[n][3]); }
        sq += __shfl_xor(sq, 16); sq += __shfl_xor(sq, 32);
        const float rs = __builtin_amdgcn_rsqf(sq * (1.0f / 128.0f) + EPS);
        bf16_t* dst = mix + (size_t)(row0 + il) * D + 512 + h * 128 + 4 * fq;
#pragma unroll
        for (int n = 0; n < 8; ++n) { const u32x2 g = gv[n];
            const float g0 = bf2f((unsigned short)(g.x & 0xffffu)), g1 = bf2f((unsigned short)(g.x >> 16)), g2 = bf2f((unsigned short)(g.y & 0xffffu)), g3 = bf2f((unsigned short)(g.y >> 16));
            u32x2 w; w.x = cvt_pk_bf16(silu_f(g0) * o1[n][0] * rs, silu_f(g1) * o1[n][1] * rs); w.y = cvt_pk_bf16(silu_f(g2) * o1[n][2] * rs, silu_f(g3) * o1[n][3] * rs);
            *(u32x2*)(dst + 16 * n) = w; }
    }
#undef R3_ISSUE
}

__device__ __forceinline__ void final_norm_phase(const Params& p, int G) {
    const int lane = threadIdx.x & 63, wave = threadIdx.x >> 6; const int gw = blockIdx.x * 8 + wave, NGW = G * 8;
    const f32x4* gp = (const f32x4*)p.in[17] + lane;
    for (int row = gw; row < T; row += NGW) {
        f32x4* xr = (f32x4*)(p.out + (size_t)row * D) + lane; f32x4 v[4]; float s = 0.f;
#pragma unroll
        for (int j = 0; j < 4; ++j) { v[j] = xr[64 * j]; s += (v[j][0] * v[j][0] + v[j][1] * v[j][1]) + (v[j][2] * v[j][2] + v[j][3] * v[j][3]); }
        const float rstd = __builtin_amdgcn_rsqf(wave_sum(s) * (1.f / D) + EPS);
#pragma unroll
        for (int j = 0; j < 4; ++j) xr[64 * j] = v[j] * rstd * gp[64 * j];
    }
}

#define XB_TMO      128
#define XB_XCNT(j)  (256  + 64 * (j))
#define XB_XSUB(j)  (1280 + 64 * (j))
#define XB_XGEN(j)  (2304 + 64 * (j))
#define XB_TOP      3328
#define XB_TOPGEN   3392
#define XCD_BAR_WORDS 3456
#define XB_SPIN_CAP (1u << 18)

__device__ __forceinline__ unsigned xb_ld(unsigned* p)              { return __hip_atomic_load(p, __ATOMIC_RELAXED, __HIP_MEMORY_SCOPE_AGENT); }
__device__ __forceinline__ unsigned xb_add(unsigned* p, unsigned v) { return __hip_atomic_fetch_add(p, v, __ATOMIC_RELAXED, __HIP_MEMORY_SCOPE_AGENT); }
__device__ __forceinline__ unsigned xb_xcc_id() { return (unsigned)__builtin_amdgcn_s_getreg((3 << 11) | 20) & 0xFu; }
#define XB_SPIN(cond, bar) do { unsigned _sp = 0; while (cond) { __builtin_amdgcn_s_sleep(1); \
    if ((++_sp & 255u) == 0u) { if (xb_ld(&(bar)[XB_TMO])) break; if (_sp > XB_SPIN_CAP) { atomicAdd(&(bar)[XB_TMO], 1u); break; } } } } while (0)

struct XcdBarrier {
    unsigned* bar; unsigned x;
    volatile LAS unsigned* st;
};

__device__ __forceinline__ XcdBarrier xcd_barrier_post(unsigned* bar, volatile LAS unsigned* st) {
    XcdBarrier b; b.bar = bar; b.x = xb_xcc_id(); b.st = st;
    if (threadIdx.x == 0) (void)xb_add(&bar[XB_XCNT(b.x)], 1u);
    return b;
}
__device__ __forceinline__ void xcd_barrier_complete(unsigned* bar, unsigned x, unsigned& nloc, unsigned& nx) {
    const unsigned G = gridDim.x * gridDim.y * gridDim.z;
    unsigned sum, cnt, mine, sp = 0u;
    for (;;) {
        sum = 0u; cnt = 0u; mine = 0u;
#pragma unroll
        for (unsigned j = 0; j < 16; ++j) { const unsigned c = xb_ld(&bar[XB_XCNT(j)]); sum += c; cnt += (c > 0u) ? 1u : 0u; mine = (j == x) ? c : mine; }
        if (sum == G) break;
        __builtin_amdgcn_s_sleep(1);
        if ((++sp & 255u) == 0u) { if (xb_ld(&bar[XB_TMO])) break; if (sp > XB_SPIN_CAP) { atomicAdd(&bar[XB_TMO], 1u); break; } }
    }
    nloc = mine > 0u ? mine : 1u; nx = cnt > 0u ? cnt : 1u;
}

__device__ __forceinline__ void xcd_barrier(const XcdBarrier& b) {
    asm volatile("s_waitcnt vmcnt(0)" ::: "memory");
    __syncthreads();
    if (threadIdx.x == 0) {
        unsigned* bar = b.bar;
        __builtin_amdgcn_s_waitcnt(0);
        unsigned nloc = b.st[0], nx = b.st[1];
        if (nloc == 0u) { xcd_barrier_complete(bar, b.x, nloc, nx); b.st[0] = nloc; b.st[1] = nx; }
        const unsigned old = xb_add(&bar[XB_XSUB(b.x)], 1u);
        const unsigned gen = old / nloc;
        if (old + 1u == (gen + 1u) * nloc) {
            __builtin_amdgcn_fence(__ATOMIC_RELEASE, "agent");
            asm volatile("s_waitcnt vmcnt(0)" ::: "memory");
            const unsigned og = xb_add(&bar[XB_TOP], 1u);
            const unsigned tg = og / nx;
            if (og + 1u == (tg + 1u) * nx) xb_add(&bar[XB_TOPGEN], 1u);
            else XB_SPIN(xb_ld(&bar[XB_TOPGEN]) == tg, bar);
            __builtin_amdgcn_fence(__ATOMIC_ACQUIRE, "agent");
            xb_add(&bar[XB_XGEN(b.x)], 1u);
            asm volatile("s_waitcnt vmcnt(0)" ::: "memory");
        } else {
            XB_SPIN(xb_ld(&bar[XB_XGEN(b.x)]) == gen, bar);
            __builtin_amdgcn_fence(__ATOMIC_ACQUIRE, "agent");
            asm volatile("s_waitcnt vmcnt(0)" ::: "memory");
        }
    }
    __syncthreads();
}

constexpr int NPHASE = 11;
__global__ void __launch_bounds__(NTHR, 2) mk_fwd(Params p) {
    extern __shared__ __attribute__((aligned(16))) unsigned char lds_raw[];
    LAS unsigned char* lds = (LAS unsigned char*)lds_raw;
    const int G = gridDim.x, lo = p.ph_lo, hi = p.ph_hi;
    cg::grid_group grid = cg::this_grid();
#define IN(k) (lo <= (k) && (k) < hi)
    volatile LAS unsigned* bst = (volatile LAS unsigned*)(lds + 147392);
    if (threadIdx.x == 0) { bst[0] = 0u; bst[1] = 0u; }
    __syncthreads();
    XcdBarrier xbar = xcd_barrier_post((unsigned*)(p.ws + WS_TABR) + 192 * 64, bst);
    unsigned* rankw = (unsigned*)(p.ws + WS_TABR) + 192 * 64 + 3584;
    if (threadIdx.x == 0) { const unsigned x = xb_xcc_id() & 7u; const unsigned r = __hip_atomic_fetch_add(rankw + 8 * x, 1u, __ATOMIC_RELAXED, __HIP_MEMORY_SCOPE_AGENT); bst[2] = r * 8u + x; }
    if (p.ph_lo < -1000) grid.sync();
#define SEAM(k) do { if (IN(k) && IN((k) + 1)) xcd_barrier(xbar); } while (0)
    bf16_t* ACTA = (bf16_t*)(p.ws + WS_ACTA); bf16_t* ACTB = (bf16_t*)(p.ws + WS_ACTB); bf16_t* HID = (bf16_t*)(p.ws + WS_HID);
    float* SSQ = (float*)(p.ws + WS_SSQ);
    if (IN(0)) { p0_prologue(p, lds, G); if (DUP & 1) { __syncthreads(); p0_prologue(p, lds, G); } }
    SEAM(0);
    int vc = (int)blockIdx.x;
    if (IN(0) && IN(1) && G == 256) {
        if (threadIdx.x == 0) { unsigned ok = 1u; for (int j = 0; j < 8; ++j) ok &= (__hip_atomic_load(rankw + 8 * j, __ATOMIC_RELAXED, __HIP_MEMORY_SCOPE_AGENT) == 32u) ? 1u : 0u; bst[3] = ok; }
        __syncthreads();
        if (bst[3]) vc = (int)bst[2];
    }
    if (IN(1)) {
        pg8::Gemm g{ACTA, (const bf16_t*)(p.ws + WS_WGU1), T, 2 * FF, D}; pg8::StaticOrder S; S.init(T, 2 * FF, G, vc);
        EpiSwiGLU<false> E{HID, nullptr};
        pg8::gemm_phase<EpiSwiGLU<false>, pg8::StaticOrder, PG8_ALIGN, PG8_SP2>(lds, g, S, E);
        if (DUP & 16) { __syncthreads(); pg8::gemm_phase<EpiSwiGLU<false>, pg8::StaticOrder, PG8_ALIGN, PG8_SP2>(lds, g, S, E); }
    }
    SEAM(1);
    if (IN(2)) {
        pg8::Gemm g{HID, (const bf16_t*)(p.ws + WS_WD1), T, D, FF}; pg8::StaticOrder S; S.init(T, D, G, vc);
        EpiResid<false, false, true, true> E{p.in[0], p.in[1] - (size_t)TP * D, nullptr, nullptr, ACTA, SSQ, 0.5f};
        pg8::gemm_phase<EpiResid<false, false, true, true>, pg8::StaticOrder, PG8_ALIGN, PG8_SP2>(lds, g, S, E);
    }
    SEAM(2);
    if (IN(3)) {
        pg8::Gemm g{ACTA, (const bf16_t*)(p.ws + WS_WIN), T, DIN, D}; pg8::StaticOrder S; S.init(T, DIN, G, vc);
        EpiProj E{HID, SSQ};
        pg8::gemm_phase<EpiProj, pg8::StaticOrder, PG8_ALIGN, PG8_SP2>(lds, g, S, E);
        if (DUP & 32) { __syncthreads(); pg8::gemm_phase<EpiProj, pg8::StaticOrder, PG8_ALIGN, PG8_SP2>(lds, g, S, E); }
    }
    SEAM(3);
    if (IN(4)) { attn_phase(p, lds, G); ret_kv_phase(p, lds, G); if (DUP & 2) { attn_phase(p, lds, G); } if (DUP & 4) { ret_kv_phase(p, lds, G); } }
    SEAM(4);
    if (IN(5)) { ret_scan_phase(p, G); }
    SEAM(5);
    if (IN(6)) { ret_out_phase(p, lds, G); if (DUP & 8) { ret_out_phase(p, lds, G); } }
    SEAM(6);
    if (IN(7)) {
        __syncthreads();
        pg8::Gemm g{ACTB, (const bf16_t*)(p.ws + WS_WOUT), T, D, D}; pg8::StaticOrder S; S.init(T, D, G, vc);
        EpiResid<true, false, true, true> E{nullptr, nullptr, ACTA, nullptr, ACTA, SSQ, 1.0f};
        pg8::gemm_phase<EpiResid<true, false, true, true>, pg8::StaticOrder, PG8_ALIGN, PG8_SP2>(lds, g, S, E);
    }
    SEAM(7);
    if (IN(8)) {
        pg8::Gemm g{ACTA, (const bf16_t*)(p.ws + WS_WGU2), T, 2 * FF, D}; pg8::StaticOrder S; S.init(T, 2 * FF, G, vc);
        EpiSwiGLU<true> E{HID, SSQ};
        pg8::gemm_phase<EpiSwiGLU<true>, pg8::StaticOrder, PG8_ALIGN, PG8_SP2>(lds, g, S, E);
    }
    SEAM(8);
    const bool fused_final = (G == 256) && IN(10);
    if (IN(9)) {
        pg8::Gemm g{HID, (const bf16_t*)(p.ws + WS_WD2), T, D, FF}; pg8::StaticOrder S; S.init(T, D, G, vc);
        if (fused_final) { EpiFinal E{ACTA, p.out, SSQ, (unsigned*)(p.ws + WS_TABR), p.in[17]};
            pg8::gemm_phase<EpiFinal, pg8::StaticOrder, PG8_ALIGN, PG8_SP2>(lds, g, S, E); }
        else { EpiResid<true, true, false, false> E{nullptr, nullptr, ACTA, p.out, nullptr, nullptr, 0.5f};
            pg8::gemm_phase<EpiResid<true, true, false, false>, pg8::StaticOrder, PG8_ALIGN, PG8_SP2>(lds, g, S, E); }
    }
    if (!fused_final) { SEAM(9); if (IN(10)) { final_norm_phase(p, G); } }
#undef IN
#undef SEAM
}

extern "C" void kernel_launch(void* const* d_in, const int* in_sizes, int n_in, void* d_out, int out_size, void* d_ws, size_t ws_size, hipStream_t stream) {
    static int grid = 0;
    if (grid == 0) {
        if (n_in != 18 || out_size != T * D || ws_size < WS_END) { fprintf(stderr, "kernel_launch: unexpected shapes (n_in %d, out %d, ws %zu)\n", n_in, out_size, ws_size); grid = -1; return; }
        int dev = 0, cus = 0, per_cu = 0;
        if (hipGetDevice(&dev) != hipSuccess || hipDeviceGetAttribute(&cus, hipDeviceAttributeMultiprocessorCount, dev) != hipSuccess) { grid = -1; return; }
        if (hipFuncSetAttribute((const void*)mk_fwd, hipFuncAttributeMaxDynamicSharedMemorySize, LDS_BYTES) != hipSuccess) { fprintf(stderr, "kernel_launch: hipFuncSetAttribute failed\n"); grid = -1; return; }
        if (hipOccupancyMaxActiveBlocksPerMultiprocessor(&per_cu, (const void*)mk_fwd, NTHR, LDS_BYTES) != hipSuccess || per_cu < 1) { fprintf(stderr, "kernel_launch: occupancy query says %d\n", per_cu); per_cu = 1; }
        (void)hipGetLastError();
        grid = cus;
    }
    if (grid < 0) return;
    if (hipMemsetAsync((unsigned char*)d_ws + WS_TABR, 0, (192 * 64 + 4096) * 4, stream) != hipSuccess) { fprintf(stderr, "kernel_launch: memset of the control words failed\n"); return; }
    Params a{};
    for (int i = 0; i < 18; ++i) a.in[i] = (const float*)d_in[i];
    a.out = (float*)d_out; a.ws = (unsigned char*)d_ws;
#if MK_ONE_LAUNCH
    a.ph_lo = 0; a.ph_hi = NPHASE;
    void* args[] = {&a};
    hipError_t e = hipLaunchCooperativeKernel((const void*)mk_fwd, dim3(grid), dim3(NTHR), args, LDS_BYTES, stream);
    if (e != hipSuccess) fprintf(stderr, "kernel_launch: cooperative launch failed: %s (grid %d)\n", hipGetErrorString(e), grid);
#else
    for (int ph = 0; ph < NPHASE; ++ph) { a.ph_lo = ph; a.ph_hi = ph + 1; hipLaunchKernelGGL(mk_fwd, dim3(grid), dim3(NTHR), LDS_BYTES, stream, a); }
#endif
}
```
